# Optimizing an MI355X kernel written in HIP

```python
import math
import numpy as np
import jax
import jax.numpy as jnp
from jax import lax


D_MODEL = 1024
BATCH = 8
SEQ = 2048
DEPTH = 2

SB_HEADS = 8
SB_HEAD_DIM = 64
SB_WIDTH = SB_HEADS * SB_HEAD_DIM
SSM_WIDTH = D_MODEL - SB_WIDTH
SSM_GROUP = 16
SSM_GROUPS = SSM_WIDTH // SSM_GROUP
SSM_STATE = 64
Q_BLOCK = 128

NSA_HEADS = 16
NSA_KV_HEADS = 4
NSA_HEAD_DIM = 64
CMP_LEN = 32
CMP_STRIDE = 16
CMP_HIDDEN = 256
SEL_LEN = 64
SEL_TOP = 8
WINDOW = 512
SEL_Q_CHUNK = 32
ROPE_THETA = 10000.0
FORCE_BONUS = 1e4
NEG = -1e30

N_EXPERTS = 16
N_GROUPS = 4
EXPERTS_PER_GROUP = N_EXPERTS // N_GROUPS
TOP_K = 2
D_EXPERT = 512

ALPHA = (2 * DEPTH) ** 0.25
BETA = (8 * DEPTH) ** -0.25
LN_EPS = 1e-5

kernel_name = 'hybrid_stickbreak_s5_nsa_grouped_moe_deepnorm'


def layer_norm(x, g, b):
    xf = x.astype(jnp.float32)
    mu = jnp.mean(xf, axis=-1, keepdims=True)
    var = jnp.mean(jnp.square(xf - mu), axis=-1, keepdims=True)
    return ((xf - mu) * lax.rsqrt(var + LN_EPS) * g + b).astype(x.dtype)


def rope_tables(pos, dim):
    inv = ROPE_THETA ** (-jnp.arange(0, dim, 2, dtype=jnp.float32) / dim)
    ang = pos.astype(jnp.float32)[:, None] * inv[None, :]
    return jnp.cos(ang), jnp.sin(ang)


def apply_rope(x, cos, sin):
    x1, x2 = jnp.split(x.astype(jnp.float32), 2, axis=-1)
    c = cos[None, :, None, :]
    s = sin[None, :, None, :]
    return jnp.concatenate([x1 * c - x2 * s, x1 * s + x2 * c], axis=-1).astype(x.dtype)


def stick_breaking_attention(q, k, v):
    B, L, H, d = q.shape
    scale = d ** -0.5
    outs = []
    for i in range(L // Q_BLOCK):
        q0 = i * Q_BLOCK
        kend = q0 + Q_BLOCK
        z = jnp.einsum('bqhd,bkhd->bhqk', q[:, q0:kend], k[:, :kend]).astype(jnp.float32) * scale
        t = q0 + jnp.arange(Q_BLOCK)
        s = jnp.arange(kend)
        mask = s[None, :] < t[:, None]
        log_1mb = jnp.where(mask, -jax.nn.softplus(z), 0.0)
        after = lax.cumsum(log_1mb, axis=3, reverse=True) - log_1mb
        w = jnp.where(mask, jnp.exp(jax.nn.log_sigmoid(z) + after), 0.0)
        outs.append(jnp.einsum('bhqk,bkhd->bqhd', w.astype(v.dtype), v[:, :kend]))
    return jnp.concatenate(outs, axis=1)


def _ssm_combine(e1, e2):
    a1r, a1i, b1r, b1i = e1
    a2r, a2i, b2r, b2i = e2
    return (a2r * a1r - a2i * a1i,
            a2r * a1i + a2i * a1r,
            a2r * b1r - a2i * b1i + b2r,
            a2r * b1i + a2i * b1r + b2i)


def s5_ssm(u, lam_re, lam_im, log_dt, b_re, b_im, c_re, c_im, d_skip):
    Bsz, L, W = u.shape
    uf = u.astype(jnp.float32).reshape(Bsz, L, SSM_GROUPS, SSM_GROUP)
    dt = jnp.exp(log_dt.astype(jnp.float32))[:, None]
    lr = lam_re.astype(jnp.float32)
    li = lam_im.astype(jnp.float32)
    mag = jnp.exp(lr * dt)
    a_re = mag * jnp.cos(li * dt)
    a_im = mag * jnp.sin(li * dt)
    den = lr * lr + li * li
    nr = a_re - 1.0
    f_re = (nr * lr + a_im * li) / den
    f_im = (a_im * lr - nr * li) / den
    br = b_re.astype(jnp.float32)
    bi = b_im.astype(jnp.float32)
    bb_re = f_re[..., None] * br - f_im[..., None] * bi
    bb_im = f_re[..., None] * bi + f_im[..., None] * br
    bu_re = jnp.einsum('blgh,gph->lbgp', uf, bb_re)
    bu_im = jnp.einsum('blgh,gph->lbgp', uf, bb_im)
    shp = (L, 1, SSM_GROUPS, SSM_STATE)
    elems = (jnp.broadcast_to(a_re[None, None], shp), jnp.broadcast_to(a_im[None, None], shp), bu_re, bu_im)
    _, _, xr, xi = lax.associative_scan(_ssm_combine, elems, axis=0)
    y = (jnp.einsum('ghp,lbgp->blgh', c_re.astype(jnp.float32), xr)
         - jnp.einsum('ghp,lbgp->blgh', c_im.astype(jnp.float32), xi))
    y = y.reshape(Bsz, L, W) + d_skip.astype(jnp.float32) * u.astype(jnp.float32)
    return y.astype(u.dtype)


def even_mixer(x, w_in, lam_re, lam_im, log_dt, b_re, b_im, c_re, c_im, d_skip, w_glu, w_out):
    B, L, _ = x.shape
    proj = x @ w_in
    q, k, v, u = jnp.split(proj, [SB_WIDTH, 2 * SB_WIDTH, 3 * SB_WIDTH], axis=-1)
    shp = (B, L, SB_HEADS, SB_HEAD_DIM)
    o_a = stick_breaking_attention(q.reshape(shp), k.reshape(shp), v.reshape(shp)).reshape(B, L, SB_WIDTH)
    y = s5_ssm(u, lam_re, lam_im, log_dt, b_re, b_im, c_re, c_im, d_skip)
    h = jax.nn.gelu(y)
    o_b = h * jax.nn.sigmoid(h @ w_glu)
    return jnp.concatenate([o_a, o_b], axis=-1) @ w_out


def compress_blocks(t, pos_emb, w1, w2, starts):
    B, L, G, d = t.shape
    idx = jnp.asarray((starts[:, None] + np.arange(CMP_LEN)[None, :]).astype(np.int32))
    blk = t[:, idx] + pos_emb[:, None, :]
    flat = jnp.moveaxis(blk, 3, 2).reshape(B, idx.shape[0], G, CMP_LEN * d)
    return jax.nn.gelu(flat @ w1) @ w2


def nsa_mixer(x, w_in, cmp_pos_k, cmp_w1_k, cmp_w2_k, cmp_pos_v, cmp_w1_v, cmp_w2_v, w_out):
    B, L, _ = x.shape
    H, G, d = NSA_HEADS, NSA_KV_HEADS, NSA_HEAD_DIM
    R = H // G
    scale = d ** -0.5
    kvw = G * d
    proj = x @ w_in
    cuts = [H * d + i * kvw for i in range(7)]
    q, kc, vc, ks, vs, kw, vw, gate = jnp.split(proj, cuts, axis=-1)
    pos = jnp.arange(L)
    cos, sin = rope_tables(pos, d)
    q = apply_rope(q.reshape(B, L, H, d), cos, sin).reshape(B, L, G, R, d)
    kc, vc, ks, vs, kw, vw = [a.reshape(B, L, G, d) for a in (kc, vc, ks, vs, kw, vw)]
    ks = apply_rope(ks, cos, sin)
    kw = apply_rope(kw, cos, sin)

    M = (L - CMP_LEN) // CMP_STRIDE + 1
    cmp_start = np.arange(M) * CMP_STRIDE
    cmp_end = cmp_start + CMP_LEN - 1
    k_cmp = compress_blocks(kc, cmp_pos_k, cmp_w1_k, cmp_w2_k, cmp_start)
    c_cos, c_sin = rope_tables(jnp.asarray(cmp_end.astype(np.int32)), d)
    k_cmp = apply_rope(k_cmp, c_cos, c_sin)
    v_cmp = compress_blocks(vc, cmp_pos_v, cmp_w1_v, cmp_w2_v, cmp_start)
    s_c = jnp.einsum('blgrd,bmgd->blgrm', q, k_cmp).astype(jnp.float32) * scale
    valid_c = (jnp.asarray(cmp_end.astype(np.int32))[None, :] <= pos[:, None])[None, :, None, None, :]
    p_c = jnp.where(valid_c, jax.nn.softmax(jnp.where(valid_c, s_c, NEG), axis=-1), 0.0)
    o_c = jnp.einsum('blgrm,bmgd->blgrd', p_c.astype(v_cmp.dtype), v_cmp)

    NB = L // SEL_LEN
    n_sel = min(SEL_TOP, NB)
    sel_start = np.arange(NB) * SEL_LEN
    ov = ((cmp_start[:, None] < sel_start[None, :] + SEL_LEN)
          & (cmp_start[:, None] + CMP_LEN > sel_start[None, :])).astype(np.float32)
    imp = jnp.einsum('blgrm,mn->blgn', p_c, jnp.asarray(ov))
    blk = jnp.arange(NB)
    cur = pos // SEL_LEN
    valid_s = blk[None, :] * SEL_LEN <= pos[:, None]
    forced = (blk[None, :] == 0) | (blk[None, :] == cur[:, None]) | (blk[None, :] == cur[:, None] - 1)
    score = jnp.where(valid_s[None, :, None, :],
                      imp + jnp.where(forced, FORCE_BONUS, 0.0)[None, :, None, :], NEG)
    _, sel_idx = lax.top_k(score, n_sel)

    ks_t = ks.reshape(B, NB, SEL_LEN, G, d).transpose(0, 3, 1, 2, 4)
    vs_t = vs.reshape(B, NB, SEL_LEN, G, d).transpose(0, 3, 1, 2, 4)
    b_ix = jnp.arange(B)[:, None, None, None]
    g_ix = jnp.arange(G)[None, None, :, None]

    def sel_chunk(c):
        q0 = c * SEL_Q_CHUNK
        qc = lax.dynamic_slice_in_dim(q, q0, SEL_Q_CHUNK, axis=1)
        ic = lax.dynamic_slice_in_dim(sel_idx, q0, SEL_Q_CHUNK, axis=1)
        kg = ks_t[b_ix, g_ix, ic]
        vg = vs_t[b_ix, g_ix, ic]
        s = jnp.einsum('bcgrd,bcgnsd->bcgrns', qc, kg).astype(jnp.float32) * scale
        kpos = ic[..., None] * SEL_LEN + jnp.arange(SEL_LEN)
        tq = q0 + jnp.arange(SEL_Q_CHUNK)
        mask = (kpos <= tq[None, :, None, None, None])[:, :, :, None]
        s = jnp.where(mask, s, NEG).reshape(B, SEL_Q_CHUNK, G, R, n_sel * SEL_LEN)
        p = jax.nn.softmax(s, axis=-1).reshape(B, SEL_Q_CHUNK, G, R, n_sel, SEL_LEN)
        return jnp.einsum('bcgrns,bcgnsd->bcgrd', p.astype(vg.dtype), vg)

    o_s = lax.map(sel_chunk, jnp.arange(L // SEL_Q_CHUNK))
    o_s = jnp.moveaxis(o_s, 0, 1).reshape(B, L, G, R, d)

    span = WINDOW + Q_BLOCK
    kw_pad = jnp.pad(kw, ((0, 0), (WINDOW, 0), (0, 0), (0, 0)))
    vw_pad = jnp.pad(vw, ((0, 0), (WINDOW, 0), (0, 0), (0, 0)))

    def win_block(i):
        q0 = i * Q_BLOCK
        qb = lax.dynamic_slice_in_dim(q, q0, Q_BLOCK, axis=1)
        kb = lax.dynamic_slice_in_dim(kw_pad, q0, span, axis=1)
        vb = lax.dynamic_slice_in_dim(vw_pad, q0, span, axis=1)
        s = jnp.einsum('bqgrd,bkgd->bqgrk', qb, kb).astype(jnp.float32) * scale
        kpos = q0 - WINDOW + jnp.arange(span)
        tq = q0 + jnp.arange(Q_BLOCK)
        mask = ((kpos[None, :] <= tq[:, None]) & (kpos[None, :] > tq[:, None] - WINDOW)
                & (kpos[None, :] >= 0))
        s = jnp.where(mask[None, :, None, None, :], s, NEG)
        p = jax.nn.softmax(s, axis=-1)
        return jnp.einsum('bqgrk,bkgd->bqgrd', p.astype(vb.dtype), vb)

    o_w = lax.map(win_block, jnp.arange(L // Q_BLOCK))
    o_w = jnp.moveaxis(o_w, 0, 1).reshape(B, L, G, R, d)

    g = jax.nn.sigmoid(gate.astype(jnp.float32)).reshape(B, L, G, R, 3).astype(x.dtype)
    o = g[..., 0:1] * o_c + g[..., 1:2] * o_s + g[..., 2:3] * o_w
    return o.reshape(B, L, H * d) @ w_out


def moe_ffn(x, w_router, b_router, w1, w3, w2):
    B, L, D = x.shape
    xt = x.reshape(B * L, D)
    n_tok = xt.shape[0]
    aff = jax.nn.sigmoid((xt @ w_router).astype(jnp.float32))
    sel = aff + b_router.astype(jnp.float32)
    grp = sel.reshape(n_tok, N_GROUPS, EXPERTS_PER_GROUP)
    grp_score = lax.top_k(grp, 2)[0].sum(-1)
    g_idx = jnp.argmax(grp_score, axis=-1)
    in_grp = jnp.take_along_axis(grp, g_idx[:, None, None], axis=1)[:, 0]
    _, loc = lax.top_k(in_grp, TOP_K)
    e_idx = g_idx[:, None] * EXPERTS_PER_GROUP + loc
    w_sel = jnp.take_along_axis(aff, e_idx, axis=1)
    w_sel = w_sel / jnp.sum(w_sel, axis=-1, keepdims=True)
    gates = jnp.sum(jax.nn.one_hot(e_idx, N_EXPERTS, dtype=jnp.float32) * w_sel[..., None], axis=1).astype(x.dtype)
    y = jnp.zeros_like(xt)
    for e in range(N_EXPERTS):
        h = jax.nn.silu(xt @ w1[e]) * (xt @ w3[e])
        y = y + gates[:, e:e + 1] * (h @ w2[e])
    return y.reshape(B, L, D)


def setup_inputs(seed: int = 0) -> dict:
    key = jax.random.key(seed)
    keys = iter(jax.random.split(key, 48))

    def nrm(shape, scale):
        return jax.random.normal(next(keys), shape, jnp.float32) * scale

    def gain():
        return 1.0 + nrm((D_MODEL,), 0.02)

    def bias():
        return nrm((D_MODEL,), 0.02)

    D = D_MODEL
    nsa_in = NSA_HEADS * NSA_HEAD_DIM + 6 * NSA_KV_HEADS * NSA_HEAD_DIM + 3 * NSA_HEADS
    inp = {}
    inp['x'] = nrm((BATCH, SEQ, D), 1.0)
    inp['w_in_0'] = nrm((D, 3 * SB_WIDTH + SSM_WIDTH), D ** -0.5)
    inp['ssm_lam_re'] = -0.5 + nrm((SSM_GROUPS, SSM_STATE), 0.01)
    inp['ssm_lam_im'] = math.pi * jnp.arange(SSM_STATE, dtype=jnp.float32)[None, :] + nrm((SSM_GROUPS, SSM_STATE), 0.01)
    inp['ssm_log_dt'] = jax.random.uniform(next(keys), (SSM_GROUPS,), jnp.float32, math.log(1e-3), math.log(1e-1))
    inp['ssm_b_re'] = nrm((SSM_GROUPS, SSM_STATE, SSM_GROUP), (2 * SSM_GROUP) ** -0.5)
    inp['ssm_b_im'] = nrm((SSM_GROUPS, SSM_STATE, SSM_GROUP), (2 * SSM_GROUP) ** -0.5)
    inp['ssm_c_re'] = nrm((SSM_GROUPS, SSM_GROUP, SSM_STATE), SSM_STATE ** -0.5)
    inp['ssm_c_im'] = nrm((SSM_GROUPS, SSM_GROUP, SSM_STATE), SSM_STATE ** -0.5)
    inp['ssm_d'] = 1.0 + nrm((SSM_WIDTH,), 0.1)
    inp['w_glu'] = nrm((SSM_WIDTH, SSM_WIDTH), SSM_WIDTH ** -0.5)
    inp['w_out_0'] = nrm((D, D), BETA * D ** -0.5)
    inp['ln_mix_g_0'] = gain()
    inp['ln_mix_b_0'] = bias()
    inp['ln_ffn_g_0'] = gain()
    inp['ln_ffn_b_0'] = bias()
    inp['w1_0'] = nrm((N_EXPERTS, D, D_EXPERT), D ** -0.5)
    inp['w3_0'] = nrm((N_EXPERTS, D, D_EXPERT), D ** -0.5)
    inp['w2_0'] = nrm((N_EXPERTS, D_EXPERT, D), BETA * D_EXPERT ** -0.5)
    inp['w_in_1'] = nrm((D, nsa_in), D ** -0.5)
    inp['cmp_pos_k'] = nrm((CMP_LEN, NSA_HEAD_DIM), 0.1)
    inp['cmp_w1_k'] = nrm((CMP_LEN * NSA_HEAD_DIM, CMP_HIDDEN), (CMP_LEN * NSA_HEAD_DIM) ** -0.5)
    inp['cmp_w2_k'] = nrm((CMP_HIDDEN, NSA_HEAD_DIM), CMP_HIDDEN ** -0.5)
    inp['cmp_pos_v'] = nrm((CMP_LEN, NSA_HEAD_DIM), 0.1)
    inp['cmp_w1_v'] = nrm((CMP_LEN * NSA_HEAD_DIM, CMP_HIDDEN), (CMP_LEN * NSA_HEAD_DIM) ** -0.5)
    inp['cmp_w2_v'] = nrm((CMP_HIDDEN, NSA_HEAD_DIM), CMP_HIDDEN ** -0.5)
    inp['w_out_1'] = nrm((NSA_HEADS * NSA_HEAD_DIM, D), BETA * (NSA_HEADS * NSA_HEAD_DIM) ** -0.5)
    inp['ln_mix_g_1'] = gain()
    inp['ln_mix_b_1'] = bias()
    inp['ln_ffn_g_1'] = gain()
    inp['ln_ffn_b_1'] = bias()
    inp['w1_1'] = nrm((N_EXPERTS, D, D_EXPERT), D ** -0.5)
    inp['w3_1'] = nrm((N_EXPERTS, D, D_EXPERT), D ** -0.5)
    inp['w2_1'] = nrm((N_EXPERTS, D_EXPERT, D), BETA * D_EXPERT ** -0.5)
    inp['w_router'] = nrm((D, N_EXPERTS), D ** -0.5)
    inp['b_router'] = nrm((N_EXPERTS,), 0.01)
    return inp


def reference(x, w_in_0, ssm_lam_re, ssm_lam_im, ssm_log_dt, ssm_b_re, ssm_b_im, ssm_c_re, ssm_c_im, ssm_d,
              w_glu, w_out_0, ln_mix_g_0, ln_mix_b_0, ln_ffn_g_0, ln_ffn_b_0, w1_0, w3_0, w2_0,
              w_in_1, cmp_pos_k, cmp_w1_k, cmp_w2_k, cmp_pos_v, cmp_w1_v, cmp_w2_v, w_out_1,
              ln_mix_g_1, ln_mix_b_1, ln_ffn_g_1, ln_ffn_b_1, w1_1, w3_1, w2_1,
              w_router, b_router):
    even_params = (w_in_0, ssm_lam_re, ssm_lam_im, ssm_log_dt, ssm_b_re, ssm_b_im, ssm_c_re, ssm_c_im,
                   ssm_d, w_glu, w_out_0)
    odd_params = (w_in_1, cmp_pos_k, cmp_w1_k, cmp_w2_k, cmp_pos_v, cmp_w1_v, cmp_w2_v, w_out_1)
    ln_params = ((ln_mix_g_0, ln_mix_b_0, ln_ffn_g_0, ln_ffn_b_0),
                 (ln_mix_g_1, ln_mix_b_1, ln_ffn_g_1, ln_ffn_b_1))
    experts = ((w1_0, w3_0, w2_0), (w1_1, w3_1, w2_1))
    h = x
    for layer in range(DEPTH):
        if layer % 2 == 0:
            m = even_mixer(h, *even_params)
        else:
            m = nsa_mixer(h, *odd_params)
        g_m, b_m, g_f, b_f = ln_params[layer]
        h = layer_norm(ALPHA * h + m, g_m, b_m)
        h = layer_norm(ALPHA * h + moe_ffn(h, w_router, b_router, *experts[layer]), g_f, b_f)
    return h
```

```cpp
#include <hip/hip_runtime.h>
#include <cstdio>
#include <cstdint>

#define GAS __attribute__((address_space(1)))
#define LAS __attribute__((address_space(3)))
typedef unsigned short bf16_t;
typedef short bf16x8 __attribute__((ext_vector_type(8)));
typedef short s16x4 __attribute__((ext_vector_type(4)));
typedef float f32x2 __attribute__((ext_vector_type(2)));
typedef float f32x4 __attribute__((ext_vector_type(4)));
typedef float f32x16 __attribute__((ext_vector_type(16)));
typedef unsigned u32x2 __attribute__((ext_vector_type(2)));
typedef unsigned u32x4 __attribute__((ext_vector_type(4)));
typedef int i32x4 __attribute__((ext_vector_type(4)));
typedef __bf16 bf16x2_t __attribute__((ext_vector_type(2)));

constexpr int NB = 8, SEQ = 2048, DM = 1024, NTOK = NB * SEQ;
constexpr int NE = 16, DE = 512;
constexpr float ALPHA = 1.41421356237309515f;
constexpr float LN_EPS = 1e-5f;
constexpr int NWAVES = 8, NTHR = 512;
constexpr int MOE_ROWS = 36864;

constexpr size_t MiB = 1u << 20;
constexpr size_t WS_CTL = 0, CTL_ZERO_BYTES = 1 * MiB;
constexpr size_t WS_MISC = 1 * MiB;
constexpr size_t WS_TOKES = WS_MISC;
constexpr size_t WS_TOKW = WS_TOKES + 256 * 1024;
constexpr size_t WS_TOKROW = WS_TOKW + 128 * 1024;
constexpr size_t WS_APOW = WS_MISC + 512 * 1024;
constexpr size_t WS_FTAB = WS_APOW + 1088 * 1024;
constexpr size_t WS_ROPE = WS_FTAB + 64 * 1024;
constexpr size_t WS_GATE = WS_ROPE + 512 * 1024;
constexpr size_t WS_KCMP = WS_GATE + 3 * MiB;
constexpr size_t WS_CBIAS = WS_KCMP + 512 * 1024;
constexpr size_t WS_CW2T = WS_CBIAS + 4096;
constexpr size_t WS_SSMTAB = 9 * MiB;
constexpr size_t SSM_KF = WS_SSMTAB, SSM_WF = WS_SSMTAB + 2 * MiB, SSM_VF = WS_SSMTAB + 10 * MiB;
constexpr size_t WS_WDENSE = 27 * MiB;
constexpr size_t WS_W0T = WS_WDENSE;
constexpr size_t WS_WGLUT = WS_W0T + 4 * MiB;
constexpr size_t WS_WOUT0T = WS_WGLUT + 512 * 1024;
constexpr size_t WS_WIN1T = WS_WOUT0T + 2 * MiB;
constexpr size_t WS_WOUT1T = WS_WIN1T + 5632 * 1024;
constexpr size_t WS_CW1T = WS_WOUT1T + 2 * MiB;
constexpr size_t WS_WEXP = 43 * MiB;
constexpr size_t WEXP_LAYER = 48 * MiB, WEXP_W2 = 32 * MiB;
constexpr size_t WS_ARENA = 139 * MiB;
constexpr size_t WS_CAT = 219 * MiB;
constexpr size_t WS_H = 251 * MiB;
constexpr size_t WS_END = 287 * MiB;
constexpr int CW_BAR = 4096;
constexpr int CW_CNT = 8192;
constexpr int CW_QUEUE = 16384;

constexpr int RING_BYTES = 131072;
constexpr int LDSCTL_OFF = 163840 - 1024;
constexpr int LC_BAR = 0;
constexpr int LC_Q = 4;
constexpr int LC_TSTART = 16;
constexpr int LDS_BYTES = 163840;

__device__ __forceinline__ unsigned cvtpk(float lo, float hi) { f32x2 v = {lo, hi}; bf16x2_t b = __builtin_convertvector(v, bf16x2_t); return __builtin_bit_cast(unsigned, b); }
__device__ __forceinline__ float bf_lo(unsigned u) { return __uint_as_float(u << 16); }
__device__ __forceinline__ float bf_hi(unsigned u) { return __uint_as_float(u & 0xffff0000u); }
__device__ __forceinline__ float wave_sum(float v) {
#pragma unroll
    for (int o = 1; o < 64; o <<= 1) v += __shfl_xor(v, o);
    return v;
}
__device__ __forceinline__ float fast_exp(float x) { return __builtin_amdgcn_exp2f(x * 1.4426950408889634f); }
__device__ __forceinline__ float fast_sigmoid(float x) { return __builtin_amdgcn_rcpf(1.0f + fast_exp(-x)); }
__device__ __forceinline__ float gelu_tanh(float x) {
    const float u = 0.7978845608028654f * (x + 0.044715f * x * x * x);
    return x * fast_sigmoid(2.0f * u);
}
#define LDS_WAIT() asm volatile("s_waitcnt lgkmcnt(0)" ::: "memory")
#define VM_WAIT() asm volatile("s_waitcnt vmcnt(0)" ::: "memory")
#define RLX_AGENT __ATOMIC_RELAXED, __HIP_MEMORY_SCOPE_AGENT

namespace pg8 {
constexpr int BM = 256, BK = 64, HALF = 128, HTB = HALF * BK * 2, STAGE_BYTES = 8 * HTB, NXCD = 8, WGM = 8;
__host__ __device__ __forceinline__ int lds_byte(int r, int c) { const int st = (r >> 4) * 2 + (c >> 5), rr = r & 15, cc = c & 31, ob = rr * 64 + cc * 2; return st * 1024 + (ob ^ (((ob >> 9) & 1) << 5)); }
__host__ __device__ __forceinline__ void stage_rc(int b, int& R, int& C) { const int st = b / 1024, sb = b % 1024, swz = sb ^ (((sb >> 9) & 1) << 5); R = (st >> 1) * 16 + swz / 64; C = (st & 1) * 32 + (swz % 64) / 2; }
__host__ __device__ __forceinline__ int perm32(int rho) { const int n = rho >> 4, i = rho & 15; return 8 * (i >> 2) + 4 * n + (i & 3); }

struct Unit { int pm, pn, pb; };
struct Gemm { const bf16_t* A; const bf16_t* Bt; int K; };

struct StaticOrder {
    int nM, nN, nwg, G, c;
    __device__ void init(int M, int N, int G_, int c_) { nM = M / BM; nN = N / BM; nwg = nM * nN; G = G_; c = c_; }
    __device__ bool next(int i, Unit& u) const {
        const long L = (long)i * G + c; if (L >= nwg) return false;
        int wgid = (int)L; { const int q = nwg / NXCD, r = nwg % NXCD, xcd = wgid % NXCD, off = wgid / NXCD; wgid = (xcd < r ? xcd * (q + 1) : r * (q + 1) + (xcd - r) * q) + off; }
        const int nig = WGM * nN, gid = wgid / nig, fm = gid * WGM, gsz = (nM - fm) < WGM ? (nM - fm) : WGM;
        u.pm = fm + ((wgid % nig) % gsz); u.pn = (wgid % nig) / gsz; u.pb = u.pn; return true;
    }
};
struct MoeOrder {
    const LAS int* tstart; int G, c;
    __device__ bool next(int i, Unit& u) const {
        const int total = tstart[16] * 4; const long L = (long)i * G + c; if (L >= total) return false;
        const int rt = (int)L >> 2, pn = (int)L & 3; int e = 0;
#pragma unroll
        for (int k = 1; k < 16; ++k) e += (rt >= tstart[k]) ? 1 : 0;
        u.pm = rt; u.pn = pn; u.pb = e * 4 + pn; return true;
    }
};

template <class Epi, class Sched>
__device__ __forceinline__ void gemm_phase(LAS unsigned char* lds, const Gemm g, const Sched& S, const Epi& E) {
    const int tid = threadIdx.x, wid = __builtin_amdgcn_readfirstlane(tid >> 6), lane = tid & 63, wr = wid >> 2, wc = wid & 3, fr = lane & 15, fq = lane >> 4;
    const int K = g.K, nt = K / BK;
    unsigned voffA[2], voffB[2];
#pragma unroll
    for (int i = 0; i < 2; ++i) { int R, C; stage_rc(tid * 16 + i * 8192, R, C); const int Rb = Epi::PERM ? ((R & ~31) + perm32(R & 31)) : R;
        voffA[i] = (unsigned)(R * K + C) * 2u; voffB[i] = (unsigned)(Rb * K + C) * 2u; }
    const size_t kstep = (size_t)(BK * 2);
    const size_t hstep = (size_t)HALF * K * 2;
    const size_t tstep = 2 * hstep;
    const unsigned ldsw = (unsigned)wid * 1024u;
    const int aoff = lds_byte(wr * 64 + fr, fq * 8), boff = lds_byte(wc * 32 + fr, fq * 8);
#define PG8_SA(b, h) (((b) * 2 + (h)) * HTB)
#define PG8_SB(b, h) ((4 + (b) * 2 + (h)) * HTB)
#define PG8_STAGE(bufoff, gbase, voff) do { _Pragma("unroll") for (int _i = 0; _i < 2; ++_i) \
        __builtin_amdgcn_global_load_lds((const unsigned*)((const char*)(gbase) + (voff)[_i]), (LAS unsigned*)(lds + (bufoff) + ldsw + _i * 8192), 16, 0, 0); } while (0)
#define PG8_LDA(dst, b, h) do { _Pragma("unroll") for (int m = 0; m < 4; ++m) _Pragma("unroll") for (int k = 0; k < 2; ++k) dst[m][k] = *(const LAS bf16x8*)(lds + PG8_SA(b, h) + aoff + m * 2048 + k * 1024); } while (0)
#define PG8_LDB(dst, b, h) do { _Pragma("unroll") for (int n = 0; n < 2; ++n) _Pragma("unroll") for (int k = 0; k < 2; ++k) dst[n][k] = *(const LAS bf16x8*)(lds + PG8_SB(b, h) + boff + n * 2048 + k * 1024); } while (0)
#define PG8_MMA(ai, bj, At, Bt) do { __builtin_amdgcn_s_setprio(1); _Pragma("unroll") for (int m = 0; m < 4; ++m) _Pragma("unroll") for (int n = 0; n < 2; ++n) _Pragma("unroll") for (int k = 0; k < 2; ++k) \
        acc[ai][bj][m][n] = __builtin_amdgcn_mfma_f32_16x16x32_bf16(Bt[n][k], At[m][k], acc[ai][bj][m][n], 0, 0, 0); __builtin_amdgcn_s_setprio(0); } while (0)
#define PG8_WAIT_V(n) asm volatile("s_waitcnt vmcnt(" #n ")" ::: "memory")
#define PG8_WAIT_L(n) asm volatile("s_waitcnt lgkmcnt(" #n ")" ::: "memory")
#define PG8_BAR __builtin_amdgcn_s_barrier()
#define PG8_SCHED __builtin_amdgcn_sched_barrier(0)
    Unit cur, nxt; int ui = 0;
    if (!S.next(0, cur)) return;
    f32x4 acc[2][2][4][2];
#pragma unroll
    for (int a = 0; a < 2; ++a)
#pragma unroll
        for (int b = 0; b < 2; ++b)
#pragma unroll
            for (int m = 0; m < 4; ++m)
#pragma unroll
                for (int n = 0; n < 2; ++n) acc[a][b][m][n] = (f32x4){0.f, 0.f, 0.f, 0.f};
    bf16x8 At[4][2], B0[2][2], B1[2][2];
    const char* cA = (const char*)g.A + (size_t)cur.pm * tstep; const char* cB = (const char*)g.Bt + (size_t)cur.pb * tstep;
    PG8_STAGE(PG8_SB(0, 0), cB, voffB); PG8_STAGE(PG8_SB(0, 1), cB + hstep, voffB); PG8_STAGE(PG8_SA(0, 0), cA, voffA); PG8_STAGE(PG8_SA(0, 1), cA + hstep, voffA);
    if (wr == 1) PG8_BAR;
    PG8_WAIT_V(2); PG8_BAR;
    PG8_STAGE(PG8_SB(1, 0), cB + kstep, voffB); PG8_STAGE(PG8_SA(1, 0), cA + kstep, voffA); PG8_STAGE(PG8_SB(1, 1), cB + hstep + kstep, voffB);
    PG8_WAIT_V(6); PG8_BAR;
    for (;;) {
        const bool has_next = S.next(ui + 1, nxt);
        const char* nA = has_next ? (const char*)g.A + (size_t)nxt.pm * tstep : cA; const char* nB = has_next ? (const char*)g.Bt + (size_t)nxt.pb * tstep : cB;
        for (int t = 0; t < nt; t += 2) {
            const bool last = (t == nt - 2);
            const char* a1 = cA + (size_t)(t + 1) * kstep;
            const char* a2 = last ? nA : cA + (size_t)(t + 2) * kstep; const char* b2 = last ? nB : cB + (size_t)(t + 2) * kstep;
            const char* a3 = a2 + kstep; const char* b3 = b2 + kstep;
            PG8_LDB(B0, 0, 0); PG8_LDB(B1, 0, 1); PG8_SCHED; PG8_LDA(At, 0, 0); PG8_STAGE(PG8_SA(1, 1), a1 + hstep, voffA);
            PG8_WAIT_V(8); PG8_WAIT_L(0); PG8_BAR; PG8_MMA(0, 0, At, B0); PG8_MMA(0, 1, At, B1); PG8_BAR; PG8_SCHED;
            PG8_LDA(At, 0, 1); PG8_STAGE(PG8_SB(0, 0), b2, voffB); PG8_STAGE(PG8_SB(0, 1), b2 + hstep, voffB); PG8_STAGE(PG8_SA(0, 0), a2, voffA);
            PG8_WAIT_V(8); PG8_WAIT_L(0); PG8_BAR; PG8_MMA(1, 0, At, B0); PG8_MMA(1, 1, At, B1); PG8_BAR; PG8_SCHED;
            PG8_LDB(B0, 1, 0); PG8_LDB(B1, 1, 1); PG8_SCHED; PG8_LDA(At, 1, 0); PG8_STAGE(PG8_SA(0, 1), a2 + hstep, voffA);
            PG8_WAIT_V(8); PG8_WAIT_L(0); PG8_BAR; PG8_MMA(0, 0, At, B0); PG8_MMA(0, 1, At, B1); PG8_BAR; PG8_SCHED;
            PG8_LDA(At, 1, 1); PG8_STAGE(PG8_SB(1, 0), b3, voffB); PG8_STAGE(PG8_SB(1, 1), b3 + hstep, voffB); PG8_STAGE(PG8_SA(1, 0), a3, voffA);
            PG8_WAIT_V(8); PG8_WAIT_L(0); PG8_BAR; PG8_MMA(1, 0, At, B0); PG8_MMA(1, 1, At, B1); PG8_BAR; PG8_SCHED;
        }
        if (wr == 0) PG8_BAR;
        E(acc, cur, wr, wc, fr, fq);
        if (!has_next) break;
#pragma unroll
        for (int a = 0; a < 2; ++a)
#pragma unroll
            for (int b = 0; b < 2; ++b)
#pragma unroll
                for (int m = 0; m < 4; ++m)
#pragma unroll
                    for (int n = 0; n < 2; ++n) acc[a][b][m][n] = (f32x4){0.f, 0.f, 0.f, 0.f};
        cur = nxt; cA = nA; cB = nB; ++ui;
        if (wr == 1) PG8_BAR;
    }
    PG8_WAIT_V(0);
    PG8_BAR;
#undef PG8_SA
#undef PG8_SB
#undef PG8_STAGE
#undef PG8_LDA
#undef PG8_LDB
#undef PG8_MMA
#undef PG8_WAIT_V
#undef PG8_WAIT_L
#undef PG8_BAR
#undef PG8_SCHED
}

struct EpiBf16 {
    static constexpr bool PERM = true;
    bf16_t* O; int ldc;
    __device__ __forceinline__ void operator()(const f32x4 (&acc)[2][2][4][2], const Unit& u, int wr, int wc, int fr, int fq) const {
        const int row0 = u.pm * BM + wr * 64 + fr, col0 = u.pn * BM + wc * 32 + 8 * fq;
#pragma unroll
        for (int ai = 0; ai < 2; ++ai)
#pragma unroll
            for (int m = 0; m < 4; ++m) { bf16_t* rowp = O + (size_t)(row0 + ai * HALF + m * 16) * ldc + col0;
#pragma unroll
                for (int bj = 0; bj < 2; ++bj) { const f32x4 v0 = acc[ai][bj][m][0], v1 = acc[ai][bj][m][1];
                    u32x4 w; w.x = cvtpk(v0[0], v0[1]); w.y = cvtpk(v0[2], v0[3]); w.z = cvtpk(v1[0], v1[1]); w.w = cvtpk(v1[2], v1[3]);
                    *(u32x4*)(rowp + bj * HALF) = w; } }
    }
};
struct EpiSwiGLU {
    static constexpr bool PERM = true;
    bf16_t* O; int ldc;
    __device__ __forceinline__ void operator()(const f32x4 (&acc)[2][2][4][2], const Unit& u, int wr, int wc, int fr, int fq) const {
        const int row0 = u.pm * BM + wr * 64 + fr, col0 = u.pn * HALF + wc * 32 + 8 * fq;
#pragma unroll
        for (int ai = 0; ai < 2; ++ai)
#pragma unroll
            for (int m = 0; m < 4; ++m) { bf16_t* rowp = O + (size_t)(row0 + ai * HALF + m * 16) * ldc + col0;
                float h[8];
#pragma unroll
                for (int n = 0; n < 2; ++n)
#pragma unroll
                    for (int i = 0; i < 4; ++i) { const float a = acc[ai][0][m][n][i], b = acc[ai][1][m][n][i]; h[n * 4 + i] = a * fast_sigmoid(a) * b; }
                u32x4 w; w.x = cvtpk(h[0], h[1]); w.y = cvtpk(h[2], h[3]); w.z = cvtpk(h[4], h[5]); w.w = cvtpk(h[6], h[7]);
                *(u32x4*)rowp = w; }
    }
};
struct EpiResid {
    static constexpr bool PERM = false;
    const float* resid; float* out; int ldc;
    __device__ __forceinline__ void operator()(const f32x4 (&acc)[2][2][4][2], const Unit& u, int wr, int wc, int fr, int fq) const {
        const int row0 = u.pm * BM + wr * 64 + fr, col0 = u.pn * BM + wc * 32 + 4 * fq;
#pragma unroll
        for (int ai = 0; ai < 2; ++ai)
#pragma unroll
            for (int m = 0; m < 4; ++m) { const size_t off = (size_t)(row0 + ai * HALF + m * 16) * ldc + col0;
#pragma unroll
                for (int bj = 0; bj < 2; ++bj)
#pragma unroll
                    for (int n = 0; n < 2; ++n) { const f32x4 r = *(const f32x4*)(resid + off + bj * HALF + n * 16); *(f32x4*)(out + off + bj * HALF + n * 16) = r * ALPHA + acc[ai][bj][m][n]; } }
    }
};
struct EpiGlu {
    static constexpr bool PERM = true;
    const bf16_t* h; int ldh; bf16_t* O; int ldc;
    __device__ __forceinline__ void operator()(const f32x4 (&acc)[2][2][4][2], const Unit& u, int wr, int wc, int fr, int fq) const {
        const int row0 = u.pm * BM + wr * 64 + fr, col0 = u.pn * BM + wc * 32 + 8 * fq;
#pragma unroll
        for (int ai = 0; ai < 2; ++ai)
#pragma unroll
            for (int m = 0; m < 4; ++m) { const size_t row = (size_t)(row0 + ai * HALF + m * 16);
#pragma unroll
                for (int bj = 0; bj < 2; ++bj) { const int col = col0 + bj * HALF; const u32x4 hv = *(const u32x4*)(h + row * ldh + col);
                    const f32x4 v0 = acc[ai][bj][m][0], v1 = acc[ai][bj][m][1];
                    u32x4 w; w.x = cvtpk(bf_lo(hv.x) * fast_sigmoid(v0[0]), bf_hi(hv.x) * fast_sigmoid(v0[1])); w.y = cvtpk(bf_lo(hv.y) * fast_sigmoid(v0[2]), bf_hi(hv.y) * fast_sigmoid(v0[3]));
                    w.z = cvtpk(bf_lo(hv.z) * fast_sigmoid(v1[0]), bf_hi(hv.z) * fast_sigmoid(v1[1])); w.w = cvtpk(bf_lo(hv.w) * fast_sigmoid(v1[2]), bf_hi(hv.w) * fast_sigmoid(v1[3]));
                    *(u32x4*)(O + row * ldc + col) = w; } }
    }
};
struct EpiRope {
    static constexpr bool PERM = false;
    bf16_t* O; float* gate; const float* rc; const float* rs;
    __device__ __forceinline__ void operator()(const f32x4 (&acc)[2][2][4][2], const Unit& u, int wr, int wc, int fr, int fq) const {
        const int row0 = u.pm * BM + wr * 64 + fr;
        if (u.pn < 10) {
            const bool rope = (u.pn < 4) || (u.pn == 6) || (u.pn == 8); const float sc = u.pn < 4 ? 0.125f : 1.0f;
            const int j = (wc & 1) * 16 + fq * 4;
#pragma unroll
            for (int ai = 0; ai < 2; ++ai)
#pragma unroll
                for (int m = 0; m < 4; ++m) { const int row = row0 + ai * HALF + m * 16, pos = row & 2047;
                    f32x4 c4 = {1.f, 1.f, 1.f, 1.f}, s4 = {0.f, 0.f, 0.f, 0.f};
                    if (rope) { c4 = *(const f32x4*)(rc + pos * 32 + j); s4 = *(const f32x4*)(rs + pos * 32 + j); }
#pragma unroll
                    for (int bj = 0; bj < 2; ++bj) { const int head = bj * 2 + (wc >> 1); const f32x4 x1 = acc[ai][bj][m][0], x2 = acc[ai][bj][m][1];
                        const f32x4 y1 = (x1 * c4 - x2 * s4) * sc, y2 = (x1 * s4 + x2 * c4) * sc;
                        bf16_t* op = O + (size_t)row * 2560 + u.pn * 256 + head * 64 + j;
                        u32x2 w1; w1.x = cvtpk(y1[0], y1[1]); w1.y = cvtpk(y1[2], y1[3]); *(u32x2*)op = w1;
                        u32x2 w2; w2.x = cvtpk(y2[0], y2[1]); w2.y = cvtpk(y2[2], y2[3]); *(u32x2*)(op + 32) = w2; } }
        } else {
#pragma unroll
            for (int ai = 0; ai < 2; ++ai)
#pragma unroll
                for (int m = 0; m < 4; ++m) { const int row = row0 + ai * HALF + m * 16;
#pragma unroll
                    for (int n = 0; n < 2; ++n) { const int c = 32 * wc + 16 * n + 4 * fq; const f32x4 v = acc[ai][0][m][n];
                        if (c < 48) *(f32x4*)(gate + (size_t)row * 48 + c) = (f32x4){fast_sigmoid(v[0]), fast_sigmoid(v[1]), fast_sigmoid(v[2]), fast_sigmoid(v[3])}; } }
        }
    }
};
}

#define XB_TMO      128
#define XB_XCNT(j)  (256  + 64 * (j))
#define XB_XSUB(j)  (1280 + 64 * (j))
#define XB_XGEN(j)  (2304 + 64 * (j))
#define XB_TOP      3328
#define XB_TOPGEN   3392
#define XCD_BAR_WORDS 3456
#define XB_SPIN_CAP (1u << 22)
__device__ __forceinline__ unsigned xb_ld(unsigned* p)              { return __hip_atomic_load(p, __ATOMIC_RELAXED, __HIP_MEMORY_SCOPE_AGENT); }
__device__ __forceinline__ unsigned xb_add(unsigned* p, unsigned v) { return __hip_atomic_fetch_add(p, v, __ATOMIC_RELAXED, __HIP_MEMORY_SCOPE_AGENT); }
__device__ __forceinline__ unsigned xb_xcc_id() { return (unsigned)__builtin_amdgcn_s_getreg((3 << 11) | 20) & 0xFu; }
#define XB_SPIN(cond, bar) do { unsigned _sp = 0; while (cond) { __builtin_amdgcn_s_sleep(1); \
    if ((++_sp & 255u) == 0u) { if (xb_ld(&(bar)[XB_TMO])) break; if (_sp > XB_SPIN_CAP) { atomicAdd(&(bar)[XB_TMO], 1u); break; } } } } while (0)
struct XcdBarrier { unsigned* bar; unsigned x; volatile LAS unsigned* st; };
__device__ __forceinline__ XcdBarrier xcd_barrier_post(unsigned* bar, volatile LAS unsigned* st) {
    XcdBarrier b; b.bar = bar; b.x = xb_xcc_id(); b.st = st;
    if (threadIdx.x == 0) (void)xb_add(&bar[XB_XCNT(b.x)], 1u);
    return b;
}
__device__ __forceinline__ void xcd_barrier_complete(unsigned* bar, unsigned x, unsigned& nloc, unsigned& nx) {
    const unsigned G = gridDim.x * gridDim.y * gridDim.z;
    unsigned sum, cnt, mine, sp = 0u;
    for (;;) {
        sum = 0u; cnt = 0u; mine = 0u;
#pragma unroll
        for (unsigned j = 0; j < 16; ++j) { const unsigned c = xb_ld(&bar[XB_XCNT(j)]); sum += c; cnt += (c > 0u) ? 1u : 0u; mine = (j == x) ? c : mine; }
        if (sum == G) break;
        __builtin_amdgcn_s_sleep(1);
        if ((++sp & 255u) == 0u) { if (xb_ld(&bar[XB_TMO])) break; if (sp > XB_SPIN_CAP) { atomicAdd(&bar[XB_TMO], 1u); break; } }
    }
    nloc = mine > 0u ? mine : 1u; nx = cnt > 0u ? cnt : 1u;
}
__device__ __forceinline__ void xcd_barrier(const XcdBarrier& b) {
    asm volatile("s_waitcnt vmcnt(0)" ::: "memory");
    __syncthreads();
    if (threadIdx.x == 0) {
        unsigned* bar = b.bar;
        __builtin_amdgcn_s_waitcnt(0);
        unsigned nloc = b.st[0], nx = b.st[1];
        if (nloc == 0u) { xcd_barrier_complete(bar, b.x, nloc, nx); b.st[0] = nloc; b.st[1] = nx; }
        const unsigned old = xb_add(&bar[XB_XSUB(b.x)], 1u);
        const unsigned gen = old / nloc;
        if (old + 1u == (gen + 1u) * nloc) {
            __builtin_amdgcn_fence(__ATOMIC_RELEASE, "agent");
            asm volatile("s_waitcnt vmcnt(0)" ::: "memory");
            const unsigned og = xb_add(&bar[XB_TOP], 1u);
            const unsigned tg = og / nx;
            if (og + 1u == (tg + 1u) * nx) xb_add(&bar[XB_TOPGEN], 1u);
            else XB_SPIN(xb_ld(&bar[XB_TOPGEN]) == tg, bar);
            __builtin_amdgcn_fence(__ATOMIC_ACQUIRE, "agent");
            xb_add(&bar[XB_XGEN(b.x)], 1u);
            asm volatile("s_waitcnt vmcnt(0)" ::: "memory");
        } else {
            XB_SPIN(xb_ld(&bar[XB_XGEN(b.x)]) == gen, bar);
            __builtin_amdgcn_fence(__ATOMIC_ACQUIRE, "agent");
            asm volatile("s_waitcnt vmcnt(0)" ::: "memory");
        }
    }
    __syncthreads();
}

struct Args { const float* in[36]; float* out; unsigned char* ws; int ph_lo, ph_hi; };
struct Frame {
    LAS unsigned char* lds;
    volatile LAS unsigned* LC;
    unsigned* ctl;
    int tid, lane, wave, vcu, G;
};
enum { I_X = 0, I_WIN0, I_LAMRE, I_LAMIM, I_LOGDT, I_BRE, I_BIM, I_CRE, I_CIM, I_SSMD, I_WGLU, I_WOUT0, I_LNMG0, I_LNMB0, I_LNFG0, I_LNFB0, I_W1_0, I_W3_0, I_W2_0,
       I_WIN1, I_CPK, I_CW1K, I_CW2K, I_CPV, I_CW1V, I_CW2V, I_WOUT1, I_LNMG1, I_LNMB1, I_LNFG1, I_LNFB1, I_W1_1, I_W3_1, I_W2_1, I_WR, I_BR };

template <class RowMap>
__device__ __forceinline__ void p0_transpose_item(const float* W, int K, int ldw, int ncols_valid, int nblk, bf16_t* WT, const RowMap& rm, LAS float* scr, int item, int lane) {
    const int kb = item / nblk, nb = item % nblk, k0 = 64 * kb, n0 = 32 * nb;
    const int nsrc = (n0 + (lane & 31)) < ncols_valid ? (n0 + (lane & 31)) : (ncols_valid - 1);
#pragma unroll 8
    for (int i = 0; i < 32; ++i) { const int kk = 2 * i + (lane >> 5); scr[kk * 33 + (lane & 31)] = W[(size_t)(k0 + kk) * ldw + nsrc]; }
    LDS_WAIT(); asm volatile("" ::: "memory");
    const int c = lane & 7;
#pragma unroll
    for (int j = 0; j < 4; ++j) { const int n = (lane >> 3) + 8 * j; const LAS float* s = scr + (8 * c) * 33 + n;
        u32x4 o; o.x = cvtpk(s[0 * 33], s[1 * 33]); o.y = cvtpk(s[2 * 33], s[3 * 33]); o.z = cvtpk(s[4 * 33], s[5 * 33]); o.w = cvtpk(s[6 * 33], s[7 * 33]);
        *(u32x4*)(WT + (size_t)rm(n0 + n) * K + k0 + 8 * c) = o; }
    LDS_WAIT(); asm volatile("" ::: "memory");
}
struct RmId { int off; __device__ __forceinline__ int operator()(int n) const { return off + n; } };
struct RmW13 { int half; __device__ __forceinline__ int operator()(int n) const { return (n >> 7) * 256 + half * 128 + (n & 127); } };
struct RmRope {
    __device__ __forceinline__ int operator()(int n) const {
        if (n >= 2560) return n;
        const int tile = n >> 8, o = n & 255, head = o >> 6, half = (o >> 5) & 1, j = o & 31;
        const int bj = head >> 1, wc = (head & 1) * 2 + (j >> 4), fq = (j >> 2) & 3, i = j & 3;
        return tile * 256 + 128 * bj + 32 * wc + 16 * half + 4 * fq + i;
    }
};

__device__ __forceinline__ void p0_prologue(Frame& F, const Args& A) {
    LAS float* scr = (LAS float*)(F.lds + F.wave * 16384);
    const int gw = F.vcu * NWAVES + F.wave, NGW = F.G * NWAVES;
    unsigned char* ws = A.ws;
    constexpr int IT_W0 = (1024 / 64) * (2048 / 32);
    constexpr int IT_GLU = (512 / 64) * (512 / 32);
    constexpr int IT_SQ = (1024 / 64) * (1024 / 32);
    constexpr int IT_IN1 = (1024 / 64) * (2816 / 32);
    constexpr int IT_CW1 = (2048 / 64) * (256 / 32);
    constexpr int IT_E13 = (1024 / 64) * (512 / 32);
    constexpr int IT_E2 = (512 / 64) * (1024 / 32);
    constexpr int IT_DENSE = IT_W0 + IT_GLU + IT_SQ + IT_IN1 + IT_SQ + 2 * IT_CW1;
    constexpr int IT_EXPL = 16 * (2 * IT_E13 + IT_E2);
    constexpr int NITEMS = IT_DENSE + 2 * IT_EXPL;
    for (int it = gw; it < NITEMS; it += NGW) {
        int r = it;
        if (r < IT_W0) { p0_transpose_item(A.in[I_WIN0], 1024, 2048, 2048, 64, (bf16_t*)(ws + WS_W0T), RmId{0}, scr, r, F.lane); continue; } r -= IT_W0;
        if (r < IT_GLU) { p0_transpose_item(A.in[I_WGLU], 512, 512, 512, 16, (bf16_t*)(ws + WS_WGLUT), RmId{0}, scr, r, F.lane); continue; } r -= IT_GLU;
        if (r < IT_SQ) { p0_transpose_item(A.in[I_WOUT0], 1024, 1024, 1024, 32, (bf16_t*)(ws + WS_WOUT0T), RmId{0}, scr, r, F.lane); continue; } r -= IT_SQ;
        if (r < IT_IN1) { p0_transpose_item(A.in[I_WIN1], 1024, 2608, 2608, 88, (bf16_t*)(ws + WS_WIN1T), RmRope{}, scr, r, F.lane); continue; } r -= IT_IN1;
        if (r < IT_SQ) { p0_transpose_item(A.in[I_WOUT1], 1024, 1024, 1024, 32, (bf16_t*)(ws + WS_WOUT1T), RmId{0}, scr, r, F.lane); continue; } r -= IT_SQ;
        if (r < IT_CW1) { p0_transpose_item(A.in[I_CW1K], 2048, 256, 256, 8, (bf16_t*)(ws + WS_CW1T), RmId{0}, scr, r, F.lane); continue; } r -= IT_CW1;
        if (r < IT_CW1) { p0_transpose_item(A.in[I_CW1V], 2048, 256, 256, 8, (bf16_t*)(ws + WS_CW1T) + 256 * 2048, RmId{0}, scr, r, F.lane); continue; } r -= IT_CW1;
        const int layer = r / IT_EXPL; r -= layer * IT_EXPL;
        const int e = r / (2 * IT_E13 + IT_E2); r -= e * (2 * IT_E13 + IT_E2);
        bf16_t* w13t = (bf16_t*)(ws + WS_WEXP + layer * WEXP_LAYER) + (size_t)e * 1024 * 1024;
        bf16_t* w2t = (bf16_t*)(ws + WS_WEXP + layer * WEXP_LAYER + WEXP_W2) + (size_t)e * 1024 * 512;
        const float* w1 = A.in[layer ? I_W1_1 : I_W1_0] + (size_t)e * 1024 * 512;
        const float* w3 = A.in[layer ? I_W3_1 : I_W3_0] + (size_t)e * 1024 * 512;
        const float* w2 = A.in[layer ? I_W2_1 : I_W2_0] + (size_t)e * 512 * 1024;
        if (r < IT_E13) { p0_transpose_item(w1, 1024, 512, 512, 16, w13t, RmW13{0}, scr, r, F.lane); continue; } r -= IT_E13;
        if (r < IT_E13) { p0_transpose_item(w3, 1024, 512, 512, 16, w13t, RmW13{1}, scr, r, F.lane); continue; } r -= IT_E13;
        p0_transpose_item(w2, 512, 1024, 1024, 32, w2t, RmId{0}, scr, r, F.lane);
    }
    bf16_t* xb = (bf16_t*)(ws + WS_H);
    for (int m = gw; m < NTOK; m += NGW) {
        const f32x4* xr = (const f32x4*)(A.in[I_X] + (size_t)m * DM) + F.lane; u32x2* o = (u32x2*)(xb + (size_t)m * DM) + F.lane;
#pragma unroll
        for (int j = 0; j < 4; ++j) { const f32x4 v = xr[64 * j]; u32x2 w; w.x = cvtpk(v[0], v[1]); w.y = cvtpk(v[2], v[3]); o[64 * j] = w; }
    }
}

__device__ __forceinline__ void ln_a_phase(Frame& F, const Args& A, int layer) {
    float* xres = A.out; bf16_t* xb = (bf16_t*)(A.ws + WS_H);
    const float* gam = A.in[layer ? I_LNMG1 : I_LNMG0]; const float* bet = A.in[layer ? I_LNMB1 : I_LNMB0];
    const float* wr = A.in[I_WR]; const float* br = A.in[I_BR];
    LAS float* wrT = (LAS float*)F.lds;
    for (int i = F.tid; i < DM * NE; i += NTHR) { const int k = i >> 4, e = i & 15; wrT[e * DM + k] = wr[i]; }
    __syncthreads();
    f32x4 gv[4], bv[4];
#pragma unroll
    for (int j = 0; j < 4; ++j) { gv[j] = ((const f32x4*)gam)[F.lane + 64 * j]; bv[j] = ((const f32x4*)bet)[F.lane + 64 * j]; }
    float brv = br[F.lane & 15];
    i32x4* tokes = (i32x4*)(A.ws + WS_TOKES); f32x2* tokw = (f32x2*)(A.ws + WS_TOKW);
    unsigned* cnt = F.ctl + CW_CNT + layer * 16 * 64;
    const int gw = F.vcu * NWAVES + F.wave, NGW = F.G * NWAVES;
    for (int m = gw; m < NTOK; m += NGW) {
        f32x4* xr = (f32x4*)(xres + (size_t)m * DM) + F.lane;
        f32x4 v[4]; float s = 0.f;
#pragma unroll
        for (int j = 0; j < 4; ++j) { v[j] = xr[64 * j]; s += (v[j][0] + v[j][1]) + (v[j][2] + v[j][3]); }
        const float mean = wave_sum(s) * (1.f / DM); float s2 = 0.f;
#pragma unroll
        for (int j = 0; j < 4; ++j) { v[j] = v[j] - mean; s2 += (v[j][0] * v[j][0] + v[j][1] * v[j][1]) + (v[j][2] * v[j][2] + v[j][3] * v[j][3]); }
        const float rstd = 1.f / sqrtf(wave_sum(s2) * (1.f / DM) + LN_EPS);
        u32x2* o8 = (u32x2*)(xb + (size_t)m * DM) + F.lane;
#pragma unroll
        for (int j = 0; j < 4; ++j) { v[j] = v[j] * rstd * gv[j] + bv[j]; xr[64 * j] = v[j]; u32x2 w; w.x = cvtpk(v[j][0], v[j][1]); w.y = cvtpk(v[j][2], v[j][3]); o8[64 * j] = w; }
        float lg = 0.f;
#pragma unroll 1
        for (int e = 0; e < NE; ++e) {
            float p = 0.f;
#pragma unroll
            for (int j = 0; j < 4; ++j) { const f32x4 w = *(const LAS f32x4*)(wrT + e * DM + 4 * F.lane + 256 * j); p += (v[j][0] * w[0] + v[j][1] * w[1]) + (v[j][2] * w[2] + v[j][3] * w[3]); }
            p = wave_sum(p);
            lg = ((F.lane & 15) == e) ? p : lg;
        }
        const float aff = 1.0f / (1.0f + expf(-lg));
        const float sel = aff + brv;
        float sv[16], av[16];
#pragma unroll
        for (int e = 0; e < NE; ++e) { sv[e] = __shfl(sel, e); av[e] = __shfl(aff, e); }
        int gbest = 0; float gscore = -3.0e38f;
#pragma unroll
        for (int g = 0; g < 4; ++g) {
            float a0 = sv[4 * g], a1 = sv[4 * g + 1], a2 = sv[4 * g + 2], a3 = sv[4 * g + 3];
            float m1 = fmaxf(fmaxf(a0, a1), fmaxf(a2, a3));
            float p01 = a0 + a1, p02 = a0 + a2, p03 = a0 + a3, p12 = a1 + a2, p13 = a1 + a3, p23 = a2 + a3;
            float t2 = fmaxf(fmaxf(fmaxf(p01, p02), fmaxf(p03, p12)), fmaxf(p13, p23));
            (void)m1;
            if (t2 > gscore) { gscore = t2; gbest = g; }
        }
        float g0 = 0.f, g1 = 0.f, g2 = 0.f, g3 = 0.f, f0 = 0.f, f1 = 0.f, f2 = 0.f, f3 = 0.f;
#pragma unroll
        for (int g = 0; g < 4; ++g) if (g == gbest) { g0 = sv[4 * g]; g1 = sv[4 * g + 1]; g2 = sv[4 * g + 2]; g3 = sv[4 * g + 3]; f0 = av[4 * g]; f1 = av[4 * g + 1]; f2 = av[4 * g + 2]; f3 = av[4 * g + 3]; }
        int i0 = 0; float b0 = g0; if (g1 > b0) { b0 = g1; i0 = 1; } if (g2 > b0) { b0 = g2; i0 = 2; } if (g3 > b0) { b0 = g3; i0 = 3; }
        int i1 = -1; float b1 = -3.0e38f;
        if (i0 != 0 && g0 > b1) { b1 = g0; i1 = 0; } if (i0 != 1 && g1 > b1) { b1 = g1; i1 = 1; } if (i0 != 2 && g2 > b1) { b1 = g2; i1 = 2; } if (i0 != 3 && g3 > b1) { b1 = g3; i1 = 3; }
        const float a_0 = i0 == 0 ? f0 : i0 == 1 ? f1 : i0 == 2 ? f2 : f3, a_1 = i1 == 0 ? f0 : i1 == 1 ? f1 : i1 == 2 ? f2 : f3;
        const float inv = 1.0f / (a_0 + a_1);
        const int e0 = gbest * 4 + i0, e1 = gbest * 4 + i1;
        if (F.lane == 0) {
            const int s0 = (int)__hip_atomic_fetch_add(cnt + 64 * e0, 1u, RLX_AGENT), s1 = (int)__hip_atomic_fetch_add(cnt + 64 * e1, 1u, RLX_AGENT);
            tokes[m] = (i32x4){e0, s0, e1, s1}; tokw[m] = (f32x2){a_0 * inv, a_1 * inv};
        }
    }
}
__device__ __forceinline__ void moe_prefix(Frame& F, int layer) {
    __syncthreads();
    if (F.tid == 0) {
        unsigned* cnt = F.ctl + CW_CNT + layer * 16 * 64; int acc = 0;
        for (int e = 0; e < NE; ++e) { F.LC[LC_TSTART + e] = (unsigned)acc; const unsigned c = __hip_atomic_load(cnt + 64 * e, RLX_AGENT); acc += (int)((c + 255u) >> 8); }
        F.LC[LC_TSTART + 16] = (unsigned)acc;
    }
    __syncthreads();
}
__device__ __forceinline__ void moe_gather_phase(Frame& F, const Args& A, int layer) {
    moe_prefix(F, layer);
    const bf16_t* xb = (const bf16_t*)(A.ws + WS_H); bf16_t* xg = (bf16_t*)(A.ws + WS_ARENA);
    const i32x4* tokes = (const i32x4*)(A.ws + WS_TOKES); int* tokrow = (int*)(A.ws + WS_TOKROW);
    const int gw = F.vcu * NWAVES + F.wave, NGW = F.G * NWAVES;
    for (int m = gw; m < NTOK; m += NGW) {
        const i32x4 es = tokes[m];
        const int r0 = (int)F.LC[LC_TSTART + es[0]] * 256 + es[1], r1 = (int)F.LC[LC_TSTART + es[2]] * 256 + es[3];
        const u32x4* src = (const u32x4*)(xb + (size_t)m * DM) + F.lane;
        const u32x4 a = src[0], b = src[64];
        u32x4* d0 = (u32x4*)(xg + (size_t)r0 * DM) + F.lane; u32x4* d1 = (u32x4*)(xg + (size_t)r1 * DM) + F.lane;
        d0[0] = a; d0[64] = b; d1[0] = a; d1[64] = b;
        if (F.lane == 0) { tokrow[2 * m] = r0; tokrow[2 * m + 1] = r1; }
    }
}
__device__ __forceinline__ void ln_b_phase(Frame& F, const Args& A, int layer, bool write_bf16, bool moe_on) {
    float* xres = A.out; bf16_t* xb = (bf16_t*)(A.ws + WS_H);
    const bf16_t* Y = (const bf16_t*)(A.ws + WS_ARENA);
    const float* gam = A.in[layer ? I_LNFG1 : I_LNFG0]; const float* bet = A.in[layer ? I_LNFB1 : I_LNFB0];
    const int* tokrow = (const int*)(A.ws + WS_TOKROW); const f32x2* tokw = (const f32x2*)(A.ws + WS_TOKW);
    f32x4 gv[4], bv[4];
#pragma unroll
    for (int j = 0; j < 4; ++j) { gv[j] = ((const f32x4*)gam)[F.lane + 64 * j]; bv[j] = ((const f32x4*)bet)[F.lane + 64 * j]; }
    const int gw = F.vcu * NWAVES + F.wave, NGW = F.G * NWAVES;
    for (int m = gw; m < NTOK; m += NGW) {
        f32x4* xr = (f32x4*)(xres + (size_t)m * DM) + F.lane;
        f32x4 v[4]; float s = 0.f;
        const int r0 = tokrow[2 * m], r1 = tokrow[2 * m + 1]; const f32x2 w = tokw[m];
        const u32x2* y0 = (const u32x2*)(Y + (size_t)r0 * DM) + F.lane; const u32x2* y1 = (const u32x2*)(Y + (size_t)r1 * DM) + F.lane;
#pragma unroll
        for (int j = 0; j < 4; ++j) {
            v[j] = xr[64 * j] * ALPHA;
            if (moe_on) { const u32x2 a = y0[64 * j], b = y1[64 * j];
                v[j][0] += w[0] * bf_lo(a.x) + w[1] * bf_lo(b.x); v[j][1] += w[0] * bf_hi(a.x) + w[1] * bf_hi(b.x);
                v[j][2] += w[0] * bf_lo(a.y) + w[1] * bf_lo(b.y); v[j][3] += w[0] * bf_hi(a.y) + w[1] * bf_hi(b.y); }
            s += (v[j][0] + v[j][1]) + (v[j][2] + v[j][3]);
        }
        const float mean = wave_sum(s) * (1.f / DM); float s2 = 0.f;
#pragma unroll
        for (int j = 0; j < 4; ++j) { v[j] = v[j] - mean; s2 += (v[j][0] * v[j][0] + v[j][1] * v[j][1]) + (v[j][2] * v[j][2] + v[j][3] * v[j][3]); }
        const float rstd = 1.f / sqrtf(wave_sum(s2) * (1.f / DM) + LN_EPS);
        u32x2* o8 = (u32x2*)(xb + (size_t)m * DM) + F.lane;
#pragma unroll
        for (int j = 0; j < 4; ++j) { v[j] = v[j] * rstd * gv[j] + bv[j]; xr[64 * j] = v[j];
            if (write_bf16) { u32x2 w2; w2.x = cvtpk(v[j][0], v[j][1]); w2.y = cvtpk(v[j][2], v[j][3]); o8[64 * j] = w2; } }
    }
}
__device__ __forceinline__ void scale_phase(Frame& F, const float* src, float* dst) {
    const int gw = F.vcu * NWAVES + F.wave, NGW = F.G * NWAVES;
    for (int m = gw; m < NTOK; m += NGW) {
        const f32x4* xr = (const f32x4*)(src + (size_t)m * DM) + F.lane; f32x4* o = (f32x4*)(dst + (size_t)m * DM) + F.lane;
#pragma unroll
        for (int j = 0; j < 4; ++j) o[64 * j] = xr[64 * j] * ALPHA;
    }
}

__device__ __forceinline__ int q_next(Frame& F, int q) {
    __syncthreads();
    if (F.tid == 0) F.LC[LC_Q] = __hip_atomic_fetch_add(F.ctl + CW_QUEUE + 64 * q, 1u, RLX_AGENT);
    __syncthreads();
    return (int)F.LC[LC_Q];
}

__device__ __forceinline__ void ssm_pow_tables(Frame& F, const Args& A) {
    f32x2* apow = (f32x2*)(A.ws + WS_APOW); f32x2* ftab = (f32x2*)(A.ws + WS_FTAB);
    const int gt = F.vcu * NTHR + F.tid, NGT = F.G * NTHR;
    for (int it = gt; it < 32 * 64 * 65; it += NGT) {
        const int n = it % 65, gp = it / 65, g = gp >> 6;
        const double dt = exp((double)A.in[I_LOGDT][g]);
        const double lr = (double)A.in[I_LAMRE][gp], li = (double)A.in[I_LAMIM][gp];
        const double mag = exp(lr * dt * (double)n);
        double th = li * dt * (double)n; th -= 6.283185307179586476925 * rint(th * 0.15915494309189533577);
        const double c = cos(th), s = sin(th);
        apow[it] = (f32x2){(float)(mag * c), (float)(mag * s)};
        if (n == 1) { const double are = mag * c, aim = mag * s, nr = are - 1.0, den = lr * lr + li * li;
            ftab[gp] = (f32x2){(float)((nr * lr + aim * li) / den), (float)((aim * lr - nr * li) / den)}; }
    }
}
__device__ __forceinline__ void ssm_frag_tables(Frame& F, const Args& A) {
    const f32x2* apow = (const f32x2*)(A.ws + WS_APOW); const f32x2* ftab = (const f32x2*)(A.ws + WS_FTAB);
    const float* bre = A.in[I_BRE]; const float* bim = A.in[I_BIM]; const float* cre = A.in[I_CRE]; const float* cim = A.in[I_CIM];
    const int gt = F.vcu * NTHR + F.tid, NGT = F.G * NTHR;
    constexpr int N_KF = 32 * 64 * 64, N_WF = 32 * 8 * 32 * 64, N_VF = 32 * 64 * 4 * 64;
    for (int it = gt; it < N_KF + N_WF + N_VF; it += NGT) {
        float v[8];
        if (it < N_KF) {
            const int lane = it & 63, tau0 = (it >> 6) & 63, g = it >> 12;
            const int h = lane & 15, kq = lane >> 4, jj = kq >> 1, hb = (kq & 1) * 8, tau = tau0 - jj;
#pragma unroll
            for (int e = 0; e < 8; ++e) v[e] = 0.f;
            if (tau >= 0) {
                for (int p = 0; p < 64; ++p) {
                    const int gp = g * 64 + p; const f32x2 a = apow[gp * 65 + tau], f = ftab[gp];
                    const float cr = cre[(g * 16 + h) * 64 + p], ci = cim[(g * 16 + h) * 64 + p];
                    const float mr = cr * a[0] - ci * a[1], mi = cr * a[1] + ci * a[0];
                    const float nr = mr * f[0] - mi * f[1], ni = mr * f[1] + mi * f[0];
#pragma unroll
                    for (int e = 0; e < 8; ++e) { const float br = bre[gp * 16 + hb + e], bi = bim[gp * 16 + hb + e]; v[e] += nr * br - ni * bi; }
                }
            }
            u32x4 w; w.x = cvtpk(v[0], v[1]); w.y = cvtpk(v[2], v[3]); w.z = cvtpk(v[4], v[5]); w.w = cvtpk(v[6], v[7]);
            ((u32x4*)(A.ws + SSM_KF))[it] = w;
        } else if (it < N_KF + N_WF) {
            const int r = it - N_KF; const int lane = r & 63, js = (r >> 6) & 31, mt = (r >> 11) & 7, g = r >> 14;
            const int rr = 16 * mt + (lane & 15), ri = rr >> 6, p = rr & 63, kq = lane >> 4, j = 2 * js + (kq >> 1), hb = (kq & 1) * 8;
            const int gp = g * 64 + p; const f32x2 a = apow[gp * 65 + (63 - j)], f = ftab[gp];
            const float mr = a[0] * f[0] - a[1] * f[1], mi = a[0] * f[1] + a[1] * f[0];
#pragma unroll
            for (int e = 0; e < 8; ++e) { const float br = bre[gp * 16 + hb + e], bi = bim[gp * 16 + hb + e]; v[e] = ri == 0 ? (mr * br - mi * bi) : (mr * bi + mi * br); }
            u32x4 w; w.x = cvtpk(v[0], v[1]); w.y = cvtpk(v[2], v[3]); w.z = cvtpk(v[4], v[5]); w.w = cvtpk(v[6], v[7]);
            ((u32x4*)(A.ws + SSM_WF))[r] = w;
        } else {
            const int r = it - N_KF - N_WF; const int lane = r & 63, ks = (r >> 6) & 3, i = (r >> 8) & 63, g = r >> 14;
            const int h = lane & 15, kq = lane >> 4;
#pragma unroll
            for (int e = 0; e < 8; ++e) { const int rr = 32 * ks + 8 * kq + e, ri = rr >> 6, p = rr & 63, gp = g * 64 + p; const f32x2 a = apow[gp * 65 + i + 1];
                const float cr = cre[(g * 16 + h) * 64 + p], ci = cim[(g * 16 + h) * 64 + p];
                v[e] = ri == 0 ? (cr * a[0] - ci * a[1]) : -(cr * a[1] + ci * a[0]); }
            u32x4 w; w.x = cvtpk(v[0], v[1]); w.y = cvtpk(v[2], v[3]); w.z = cvtpk(v[4], v[5]); w.w = cvtpk(v[6], v[7]);
            ((u32x4*)(A.ws + SSM_VF))[r] = w;
        }
    }
}

constexpr int SS_KF = 0, SS_UB = 65536, SS_S = 131072, SS_XP = 147456;
__device__ __forceinline__ void ssm_unit(Frame& F, const Args& A, int b, int g) {
    const bf16_t* qkvu = (const bf16_t*)(A.ws + WS_ARENA); bf16_t* hbuf = (bf16_t*)(A.ws + WS_H);
    const int lane = F.lane, w = F.wave, fr = lane & 15, kq = lane >> 4;
    LAS unsigned char* L = F.lds;
    const u32x4* kfsrc = (const u32x4*)(A.ws + SSM_KF) + (size_t)g * 4096;
#pragma unroll
    for (int i = 0; i < 8; ++i) { const int idx = F.tid + i * NTHR; *(LAS u32x4*)(L + SS_KF + idx * 16) = kfsrc[idx]; }
#pragma unroll
    for (int i = 0; i < 8; ++i) { const int idx = F.tid + i * NTHR; const int ln = idx & 63, nt = (idx >> 6) & 1, js = idx >> 7;
        const int c = 16 * nt + (ln & 15), q4 = ln >> 4, tok = 64 * c + 2 * js + (q4 >> 1);
        *(LAS u32x4*)(L + SS_UB + idx * 16) = *(const u32x4*)(qkvu + (size_t)(b * SEQ + tok) * 2048 + 1536 + 16 * g + (q4 & 1) * 8); }
    __syncthreads();
    {
        f32x4 a0 = {0.f, 0.f, 0.f, 0.f}, a1 = {0.f, 0.f, 0.f, 0.f};
        const bf16x8* wf = (const bf16x8*)(A.ws + SSM_WF) + ((size_t)(g * 8 + w) * 32) * 64 + lane;
#pragma unroll 4
        for (int js = 0; js < 32; ++js) {
            const bf16x8 af = wf[js * 64];
            const bf16x8 b0 = *(const LAS bf16x8*)(L + SS_UB + ((js * 2 + 0) * 64 + lane) * 16), b1 = *(const LAS bf16x8*)(L + SS_UB + ((js * 2 + 1) * 64 + lane) * 16);
            a0 = __builtin_amdgcn_mfma_f32_16x16x32_bf16(af, b0, a0, 0, 0, 0); a1 = __builtin_amdgcn_mfma_f32_16x16x32_bf16(af, b1, a1, 0, 0, 0);
        }
        LAS float* S = (LAS float*)(L + SS_S);
#pragma unroll
        for (int r = 0; r < 4; ++r) { S[(16 * w + 4 * kq + r) * 32 + fr] = a0[r]; S[(16 * w + 4 * kq + r) * 32 + 16 + fr] = a1[r]; }
    }
    __syncthreads();
    if (w == 0) {
        const f32x2 a64 = ((const f32x2*)(A.ws + WS_APOW))[(g * 64 + lane) * 65 + 64];
        const LAS float* S = (const LAS float*)(L + SS_S); LAS bf16_t* Xp = (LAS bf16_t*)(L + SS_XP);
        float xr = 0.f, xi = 0.f;
        for (int c = 0; c < 32; ++c) {
            const unsigned pk = cvtpk(xr, xi);
            Xp[c * 128 + lane] = (bf16_t)(pk & 0xffffu); Xp[c * 128 + 64 + lane] = (bf16_t)(pk >> 16);
            const float sr = S[lane * 32 + c], si = S[(64 + lane) * 32 + c];
            const float nr = a64[0] * xr - a64[1] * xi + sr, ni = a64[0] * xi + a64[1] * xr + si;
            xr = nr; xi = ni;
        }
    }
    __syncthreads();
    const float* dsk = A.in[I_SSMD] + 16 * g + 4 * kq;
    const f32x4 dv = *(const f32x4*)dsk;
    for (int ii = 0; ii < 8; ++ii) {
        const int i = w + 8 * ii;
        f32x4 a0 = {0.f, 0.f, 0.f, 0.f}, a1 = {0.f, 0.f, 0.f, 0.f};
        const bf16x8* vf = (const bf16x8*)(A.ws + SSM_VF) + ((size_t)(g * 64 + i) * 4) * 64 + lane;
#pragma unroll
        for (int ks = 0; ks < 4; ++ks) {
            const bf16x8 af = vf[ks * 64];
            const bf16x8 b0 = *(const LAS bf16x8*)(L + SS_XP + (fr * 128 + 32 * ks + 8 * kq) * 2), b1 = *(const LAS bf16x8*)(L + SS_XP + ((16 + fr) * 128 + 32 * ks + 8 * kq) * 2);
            a0 = __builtin_amdgcn_mfma_f32_16x16x32_bf16(af, b0, a0, 0, 0, 0); a1 = __builtin_amdgcn_mfma_f32_16x16x32_bf16(af, b1, a1, 0, 0, 0);
        }
        const int njs = (i >> 1) + 1;
        for (int js = 0; js < njs; ++js) {
            const bf16x8 af = *(const LAS bf16x8*)(L + SS_KF + ((i - 2 * js) * 64 + lane) * 16);
            const bf16x8 b0 = *(const LAS bf16x8*)(L + SS_UB + ((js * 2 + 0) * 64 + lane) * 16), b1 = *(const LAS bf16x8*)(L + SS_UB + ((js * 2 + 1) * 64 + lane) * 16);
            a0 = __builtin_amdgcn_mfma_f32_16x16x32_bf16(af, b0, a0, 0, 0, 0); a1 = __builtin_amdgcn_mfma_f32_16x16x32_bf16(af, b1, a1, 0, 0, 0);
        }
#pragma unroll
        for (int nt = 0; nt < 2; ++nt) {
            const f32x4 acc = nt ? a1 : a0; const int tok = 64 * (16 * nt + fr) + i; const size_t row = (size_t)(b * SEQ + tok);
            const u32x2 uu = *(const u32x2*)(qkvu + row * 2048 + 1536 + 16 * g + 4 * kq);
            const float y0 = acc[0] + dv[0] * bf_lo(uu.x), y1 = acc[1] + dv[1] * bf_hi(uu.x), y2 = acc[2] + dv[2] * bf_lo(uu.y), y3 = acc[3] + dv[3] * bf_hi(uu.y);
            u32x2 o; o.x = cvtpk(gelu_tanh(y0), gelu_tanh(y1)); o.y = cvtpk(gelu_tanh(y2), gelu_tanh(y3));
            *(u32x2*)(hbuf + row * 512 + 16 * g + 4 * kq) = o;
        }
    }
}

__device__ __forceinline__ int crow(int r, int hi) { return (r & 3) + 8 * (r >> 2) + 4 * hi; }
__device__ __forceinline__ void qkt_tile(f32x16& p0, f32x16& p1, const LAS unsigned char* Ks, const bf16x8 (&qr)[4], int r32, int hi) {
    const LAS unsigned char* kb = Ks + hi * 1024 + r32 * 16;
    p0 = (f32x16){}; p1 = (f32x16){};
#pragma unroll
    for (int d0 = 0; d0 < 4; ++d0) {
        const bf16x8 b0 = *(const LAS bf16x8*)(kb + d0 * 2048), b1 = *(const LAS bf16x8*)(kb + d0 * 2048 + 512);
        p0 = __builtin_amdgcn_mfma_f32_32x32x16_bf16(b0, qr[d0], p0, 0, 0, 0); p1 = __builtin_amdgcn_mfma_f32_32x32x16_bf16(b1, qr[d0], p1, 0, 0, 0);
    }
}
__device__ __forceinline__ s16x4 vtr(const LAS unsigned char* p) { typedef short v4i16_t __attribute__((ext_vector_type(4))); return __builtin_bit_cast(s16x4, __builtin_amdgcn_ds_read_tr16_b64_v4i16((LAS v4i16_t*)p)); }
__device__ __forceinline__ void pv_tile(f32x16 (&o)[2], const LAS unsigned char* Vs, const f32x16& p0, const f32x16& p1, int lane) {
    const int hi = lane >> 5;
    const LAS unsigned char* vb = Vs + ((lane >> 4) & 1) * 32 + (lane & 3) * 8 + (4 * hi + ((lane & 15) >> 2)) * 64;
    u32x4 pw[4];
#pragma unroll
    for (int s = 0; s < 2; ++s) {
        pw[s] = (u32x4){cvtpk(p0[8 * s], p0[8 * s + 1]), cvtpk(p0[8 * s + 2], p0[8 * s + 3]), cvtpk(p0[8 * s + 4], p0[8 * s + 5]), cvtpk(p0[8 * s + 6], p0[8 * s + 7])};
        pw[2 + s] = (u32x4){cvtpk(p1[8 * s], p1[8 * s + 1]), cvtpk(p1[8 * s + 2], p1[8 * s + 3]), cvtpk(p1[8 * s + 4], p1[8 * s + 5]), cvtpk(p1[8 * s + 6], p1[8 * s + 7])};
    }
#pragma unroll
    for (int d0 = 0; d0 < 2; ++d0)
#pragma unroll
        for (int ks = 0; ks < 4; ++ks) {
            const s16x4 lo = vtr(vb + d0 * 4096 + ks * 1024), hh = vtr(vb + d0 * 4096 + ks * 1024 + 512);
            const bf16x8 vf = (bf16x8){lo[0], lo[1], lo[2], lo[3], hh[0], hh[1], hh[2], hh[3]};
            o[d0] = __builtin_amdgcn_mfma_f32_32x32x16_bf16(__builtin_bit_cast(bf16x8, pw[ks]), vf, o[d0], 0, 0, 0);
        }
}
__device__ __forceinline__ void kv_load(u32x4& kreg, u32x4& vreg, const bf16_t* Kbase, const bf16_t* Vbase, int pitch, int key0, int wave, int lane) {
    kreg = *(const u32x4*)(Kbase + (size_t)(key0 + lane) * pitch + wave * 8);
    vreg = *(const u32x4*)(Vbase + (size_t)(key0 + 16 * (wave & 3) + (lane >> 2)) * pitch + (wave >> 2) * 32 + (lane & 3) * 8);
}
__device__ __forceinline__ void kv_store(LAS unsigned char* Ks, LAS unsigned char* Vs, const u32x4& kreg, const u32x4& vreg, int wave, int lane) {
    *(LAS u32x4*)(Ks + wave * 1024 + lane * 16) = kreg; *(LAS u32x4*)(Vs + wave * 1024 + lane * 16) = vreg;
}
__device__ __forceinline__ void o_store(const f32x16 (&o)[2], bf16_t* dst, int pitch, int lane) {
    const int hi = lane >> 5, c = lane & 31;
#pragma unroll
    for (int d0 = 0; d0 < 2; ++d0)
#pragma unroll
        for (int r = 0; r < 16; ++r) { const unsigned pk = cvtpk(o[d0][r], 0.f); dst[(size_t)crow(r, hi) * pitch + 32 * d0 + c] = (bf16_t)(pk & 0xffffu); }
}

constexpr int AT_K = 0, AT_V = 8192;
__device__ __forceinline__ void sb_unit(Frame& F, const Args& A, int b, int h, int qb) {
    const bf16_t* qkvu = (const bf16_t*)(A.ws + WS_ARENA); bf16_t* cat = (bf16_t*)(A.ws + WS_CAT);
    const int lane = F.lane, w = F.wave, r32 = lane & 31, hi = lane >> 5;
    const int t0 = qb * 256, trow = t0 + 32 * w + r32;
    const bf16_t* Qp = qkvu + (size_t)(b * SEQ + trow) * 2048 + h * 64 + hi * 8;
    const bf16_t* Kb = qkvu + (size_t)(b * SEQ) * 2048 + 512 + h * 64; const bf16_t* Vb = qkvu + (size_t)(b * SEQ) * 2048 + 1024 + h * 64;
    bf16x8 qr[4];
#pragma unroll
    for (int d0 = 0; d0 < 4; ++d0) qr[d0] = *(const bf16x8*)(Qp + 16 * d0);
    f32x16 o[2]; o[0] = (f32x16){}; o[1] = (f32x16){};
    float carry = 0.f;
    LAS unsigned char* Ks = F.lds + AT_K; LAS unsigned char* Vs = F.lds + AT_V;
    u32x4 kreg, vreg;
    const int kt_hi = 4 * qb + 3;
    kv_load(kreg, vreg, Kb, Vb, 2048, 64 * kt_hi, w, lane);
    for (int kt = kt_hi; kt >= 0; --kt) {
        __syncthreads();
        kv_store(Ks, Vs, kreg, vreg, w, lane);
        if (kt > 0) kv_load(kreg, vreg, Kb, Vb, 2048, 64 * (kt - 1), w, lane);
        __syncthreads();
        if (64 * kt <= t0 + 32 * w + 30) {
            f32x16 p0, p1; qkt_tile(p0, p1, Ks, qr, r32, hi);
            float l0[16], l1[16];
#pragma unroll
            for (int r = 0; r < 16; ++r) {
                const int kv = 64 * kt + crow(r, hi);
                { const float z = p0[r] * 0.125f; const float sp = fmaxf(z, 0.f) + 0.6931471805599453f * __builtin_amdgcn_logf(1.0f + fast_exp(-fabsf(z))); const bool ok = kv < trow; l0[r] = ok ? -sp : 0.f; p0[r] = ok ? (z - sp) : -1.0e30f; }
                { const float z = p1[r] * 0.125f; const float sp = fmaxf(z, 0.f) + 0.6931471805599453f * __builtin_amdgcn_logf(1.0f + fast_exp(-fabsf(z))); const bool ok = (kv + 32) < trow; l1[r] = ok ? -sp : 0.f; p1[r] = ok ? (z - sp) : -1.0e30f; }
            }
            float gs[8], og[8];
#pragma unroll
            for (int rg = 0; rg < 4; ++rg) { gs[rg] = (l0[4 * rg] + l0[4 * rg + 1]) + (l0[4 * rg + 2] + l0[4 * rg + 3]); gs[4 + rg] = (l1[4 * rg] + l1[4 * rg + 1]) + (l1[4 * rg + 2] + l1[4 * rg + 3]); }
#pragma unroll
            for (int k = 0; k < 8; ++k) og[k] = __shfl_xor(gs[k], 32);
            float sfx[8]; float run = 0.f;
#pragma unroll
            for (int k = 7; k >= 0; --k) {
                const float g_even = hi ? og[k] : gs[k], g_odd = hi ? gs[k] : og[k];
                const float s_odd = run; run += g_odd; const float s_even = run; run += g_even;
                sfx[k] = hi ? s_odd : s_even;
            }
#pragma unroll
            for (int rg = 0; rg < 4; ++rg) {
                { const float base = carry + sfx[rg]; const float a3 = base, a2 = a3 + l0[4 * rg + 3], a1 = a2 + l0[4 * rg + 2], a0 = a1 + l0[4 * rg + 1];
                  p0[4 * rg] = fast_exp(p0[4 * rg] + a0); p0[4 * rg + 1] = fast_exp(p0[4 * rg + 1] + a1); p0[4 * rg + 2] = fast_exp(p0[4 * rg + 2] + a2); p0[4 * rg + 3] = fast_exp(p0[4 * rg + 3] + a3); }
                { const float base = carry + sfx[4 + rg]; const float a3 = base, a2 = a3 + l1[4 * rg + 3], a1 = a2 + l1[4 * rg + 2], a0 = a1 + l1[4 * rg + 1];
                  p1[4 * rg] = fast_exp(p1[4 * rg] + a0); p1[4 * rg + 1] = fast_exp(p1[4 * rg + 1] + a1); p1[4 * rg + 2] = fast_exp(p1[4 * rg + 2] + a2); p1[4 * rg + 3] = fast_exp(p1[4 * rg + 3] + a3); }
            }
            carry += run;
            pv_tile(o, Vs, p0, p1, lane);
        }
    }
    o_store(o, cat + (size_t)(b * SEQ + t0 + 32 * w) * 1024 + h * 64, 1024, lane);
}

__device__ __forceinline__ void l0_mixer_phase(Frame& F, const Args& A) {
    for (int u = blockIdx.x; u < 256; u += F.G) { __syncthreads(); ssm_unit(F, A, u >> 5, u & 31); }
    for (;;) {
        const int t = q_next(F, 0);
        if (t >= 512) break;
        sb_unit(F, A, (t & 63) >> 3, t & 7, 7 - (t >> 6));
    }
}

__device__ __forceinline__ void nsa_small_tables(Frame& F, const Args& A) {
    const int gt = F.vcu * NTHR + F.tid, NGT = F.G * NTHR;
    float* rc = (float*)(A.ws + WS_ROPE); float* rs = rc + 2048 * 32;
    for (int it = gt; it < 2048 * 32; it += NGT) {
        const int pos = it >> 5, i = it & 31;
        const double inv = exp(-9.210340371976182736 * (double)i / 32.0);
        double th = (double)pos * inv; th -= 6.283185307179586476925 * rint(th * 0.15915494309189533577);
        rc[it] = (float)cos(th); rs[it] = (float)sin(th);
    }
    float* cb = (float*)(A.ws + WS_CBIAS);
    for (int it = gt; it < 512; it += NGT) {
        const int kv = it >> 8, n = it & 255; const float* pos = A.in[kv ? I_CPV : I_CPK]; const float* w1 = A.in[kv ? I_CW1V : I_CW1K];
        float s = 0.f;
        for (int kk = 0; kk < 2048; ++kk) s += pos[kk] * w1[(size_t)kk * 256 + n];
        cb[it] = s;
    }
    bf16_t* w2t = (bf16_t*)(A.ws + WS_CW2T);
    for (int it = gt; it < 2 * 64 * 256; it += NGT) {
        const int kv = it >> 14, n = (it >> 8) & 63, k = it & 255; const float* w2 = A.in[kv ? I_CW2V : I_CW2K];
        w2t[it] = (bf16_t)(cvtpk(w2[k * 64 + n], 0.f) & 0xffffu);
    }
}

constexpr int CP_A = 0, CP_B = 2 * 64 * 144, CP_H = CP_B + 2 * 256 * 144;
__device__ __forceinline__ void cmp_unit(Frame& F, const Args& A, int kv, int rb) {
    const bf16_t* proj = (const bf16_t*)(A.ws + WS_ARENA);
    const bf16_t* w1t = (const bf16_t*)(A.ws + WS_CW1T) + (size_t)kv * 256 * 2048;
    const bf16_t* w2t = (const bf16_t*)(A.ws + WS_CW2T) + kv * 64 * 256;
    const float* cb = (const float*)(A.ws + WS_CBIAS) + kv * 256;
    bf16_t* outp = (bf16_t*)(A.ws + WS_KCMP) + (size_t)kv * (8 * 4 * 128 * 64);
    const int lane = F.lane, w = F.wave, fr = lane & 15, kq = lane >> 4, tid = F.tid;
    LAS unsigned char* L = F.lds;
    const int arow = tid >> 3, ach = tid & 7;
    const int R = rb * 64 + arow, ab = R >> 9, am = (R >> 2) & 127, ag = R & 3;
    const bf16_t* asrc = proj + (size_t)(ab * SEQ + 16 * am) * 2560 + (kv ? 1280 : 1024) + ag * 64 + ach * 8;
    const bf16_t* bsrc = w1t + (size_t)(tid >> 3) * 2048 + ach * 8;
    u32x4 areg, breg[4];
    areg = *(const u32x4*)asrc;
#pragma unroll
    for (int i = 0; i < 4; ++i) breg[i] = *(const u32x4*)(bsrc + (size_t)i * 64 * 2048);
    f32x4 acc[4][2];
#pragma unroll
    for (int m = 0; m < 4; ++m) { acc[m][0] = (f32x4){0.f, 0.f, 0.f, 0.f}; acc[m][1] = (f32x4){0.f, 0.f, 0.f, 0.f}; }
    for (int l = 0; l < 32; ++l) {
        const int buf = l & 1;
        *(LAS u32x4*)(L + CP_A + buf * 9216 + arow * 144 + ach * 16) = areg;
#pragma unroll
        for (int i = 0; i < 4; ++i) *(LAS u32x4*)(L + CP_B + buf * 36864 + ((tid >> 3) + 64 * i) * 144 + ach * 16) = breg[i];
        if (l < 31) { areg = *(const u32x4*)(asrc + (size_t)(l + 1) * 2560);
#pragma unroll
            for (int i = 0; i < 4; ++i) breg[i] = *(const u32x4*)(bsrc + (size_t)i * 64 * 2048 + (l + 1) * 64); }
        __syncthreads();
#pragma unroll
        for (int ks = 0; ks < 2; ++ks) {
            bf16x8 af[4], bfv[2];
#pragma unroll
            for (int m = 0; m < 4; ++m) af[m] = *(const LAS bf16x8*)(L + CP_A + buf * 9216 + (16 * m + fr) * 144 + (32 * ks + 8 * kq) * 2);
#pragma unroll
            for (int n = 0; n < 2; ++n) bfv[n] = *(const LAS bf16x8*)(L + CP_B + buf * 36864 + (32 * w + 16 * n + fr) * 144 + (32 * ks + 8 * kq) * 2);
#pragma unroll
            for (int m = 0; m < 4; ++m)
#pragma unroll
                for (int n = 0; n < 2; ++n) acc[m][n] = __builtin_amdgcn_mfma_f32_16x16x32_bf16(bfv[n], af[m], acc[m][n], 0, 0, 0);
        }
    }
    __syncthreads();
#pragma unroll
    for (int m = 0; m < 4; ++m)
#pragma unroll
        for (int n = 0; n < 2; ++n) { const int col = 32 * w + 16 * n + 4 * kq; const f32x4 bv = *(const f32x4*)(cb + col); const f32x4 v = acc[m][n] + bv;
            u32x2 o; o.x = cvtpk(gelu_tanh(v[0]), gelu_tanh(v[1])); o.y = cvtpk(gelu_tanh(v[2]), gelu_tanh(v[3]));
            *(LAS u32x2*)(L + CP_H + ((16 * m + fr) * 264 + col) * 2) = o; }
    __syncthreads();
    {
        const int rt = w >> 1, c0 = w & 1;
        f32x4 o0 = {0.f, 0.f, 0.f, 0.f}, o1 = {0.f, 0.f, 0.f, 0.f};
#pragma unroll
        for (int ks = 0; ks < 8; ++ks) {
            const bf16x8 af = *(const LAS bf16x8*)(L + CP_H + ((16 * rt + fr) * 264 + 32 * ks + 8 * kq) * 2);
            const bf16x8 b0 = *(const bf16x8*)(w2t + (16 * c0 + fr) * 256 + 32 * ks + 8 * kq), b1 = *(const bf16x8*)(w2t + (16 * (c0 + 2) + fr) * 256 + 32 * ks + 8 * kq);
            o0 = __builtin_amdgcn_mfma_f32_16x16x32_bf16(af, b0, o0, 0, 0, 0); o1 = __builtin_amdgcn_mfma_f32_16x16x32_bf16(af, b1, o1, 0, 0, 0);
        }
        const float* rc = (const float*)(A.ws + WS_ROPE); const float* rs = rc + 2048 * 32;
#pragma unroll
        for (int r = 0; r < 4; ++r) {
            const int Rr = rb * 64 + 16 * rt + 4 * kq + r, b = Rr >> 9, m = (Rr >> 2) & 127, g = Rr & 3, d = 16 * c0 + fr;
            float x1 = o0[r], x2 = o1[r];
            if (kv == 0) { const int pos = (16 * m + 31) & 2047; const float c = rc[pos * 32 + d], s = rs[pos * 32 + d]; const float y1 = x1 * c - x2 * s, y2 = x1 * s + x2 * c; x1 = y1; x2 = y2; }
            if (m == 127) { x1 = 0.f; x2 = 0.f; }
            bf16_t* op = outp + ((size_t)((b * 4 + g) * 128 + m)) * 64;
            op[d] = (bf16_t)(cvtpk(x1, 0.f) & 0xffffu); op[d + 32] = (bf16_t)(cvtpk(x2, 0.f) & 0xffffu);
        }
    }
}

constexpr int NA_K = 0, NA_V = 16384, NA_GS = 32768, NA_LS = 40960, NA_MASK = 49152, NA_WSF = 49152 + 512, NA_OR = NA_WSF + 1024;
__device__ __forceinline__ float half_max(float v) { return fmaxf(v, __shfl_xor(v, 32)); }
__device__ __forceinline__ float half_sum(float v) { return v + __shfl_xor(v, 32); }
__device__ __forceinline__ float tile_max(const f32x16& p0, const f32x16& p1) {
    float a = fmaxf(p0[0], p1[0]);
#pragma unroll
    for (int r = 1; r < 16; ++r) a = fmaxf(a, fmaxf(p0[r], p1[r]));
    return half_max(a);
}
__device__ __forceinline__ float tile_sum(const f32x16& p0, const f32x16& p1) {
    float a = 0.f, b = 0.f;
#pragma unroll
    for (int r = 0; r < 16; ++r) { a += p0[r]; b += p1[r]; }
    return half_sum(a + b);
}
__device__ __forceinline__ void o_rows_mul(f32x16 (&o)[2], LAS float* wsf, float f, int r32, int hi) {
    if (hi == 0) wsf[r32] = f;
    LDS_WAIT();
#pragma unroll
    for (int r = 0; r < 16; ++r) { const float fr_ = wsf[crow(r, hi)]; o[0][r] *= fr_; o[1][r] *= fr_; }
    LDS_WAIT();
}
__device__ __forceinline__ void o_rows_fma(f32x16 (&ot)[2], const f32x16 (&o)[2], LAS float* wsf, float f, int r32, int hi) {
    if (hi == 0) wsf[r32] = f;
    LDS_WAIT();
#pragma unroll
    for (int r = 0; r < 16; ++r) { const float fr_ = wsf[crow(r, hi)]; ot[0][r] += o[0][r] * fr_; ot[1][r] += o[1][r] * fr_; }
    LDS_WAIT();
}
template <class MaskF>
__device__ __forceinline__ void flash_step(f32x16 (&o)[2], float& m_run, float& l_run, f32x16& p0, f32x16& p1, const MaskF& ok, LAS float* wsf, const LAS unsigned char* Vs, int lane, int r32, int hi) {
#pragma unroll
    for (int r = 0; r < 16; ++r) { p0[r] = ok(r, 0) ? p0[r] : -1.0e30f; p1[r] = ok(r, 1) ? p1[r] : -1.0e30f; }
    const float mx = tile_max(p0, p1), m_new = fmaxf(m_run, mx), alpha = fast_exp(m_run - m_new);
#pragma unroll
    for (int r = 0; r < 16; ++r) { p0[r] = ok(r, 0) ? fast_exp(p0[r] - m_new) : 0.f; p1[r] = ok(r, 1) ? fast_exp(p1[r] - m_new) : 0.f; }
    l_run = l_run * alpha + tile_sum(p0, p1); m_run = m_new;
    o_rows_mul(o, wsf, alpha, r32, hi);
    pv_tile(o, Vs, p0, p1, lane);
}

__device__ __forceinline__ void nsa_unit(Frame& F, const Args& A, int b, int g, int qt) {
    const bf16_t* proj = (const bf16_t*)(A.ws + WS_ARENA); bf16_t* cat = (bf16_t*)(A.ws + WS_CAT);
    const bf16_t* kc = (const bf16_t*)(A.ws + WS_KCMP) + (size_t)((b * 4 + g) * 128) * 64; const bf16_t* vc = kc + (size_t)(8 * 4 * 128 * 64);
    const float* gate = (const float*)(A.ws + WS_GATE);
    const int lane = F.lane, w = F.wave, r32 = lane & 31, hi = lane >> 5, tid = F.tid;
    const int t0 = qt * 64, tl = r32 >> 2, hr = r32 & 3, tok = t0 + 8 * w + tl;
    const size_t qrow = (size_t)(b * SEQ + tok);
    LAS unsigned char* L = F.lds;
    LAS float* wsf = (LAS float*)(L + NA_WSF) + w * 32;
    bf16x8 qr[4];
#pragma unroll
    for (int d0 = 0; d0 < 4; ++d0) qr[d0] = *(const bf16x8*)(proj + qrow * 2560 + (g * 4 + hr) * 64 + 16 * d0 + 8 * hi);
    const float g0 = gate[qrow * 48 + (g * 4 + hr) * 3 + 0], g1 = gate[qrow * 48 + (g * 4 + hr) * 3 + 1], g2 = gate[qrow * 48 + (g * 4 + hr) * 3 + 2];
    f32x16 ot[2]; ot[0] = (f32x16){}; ot[1] = (f32x16){};
    u32x4 kreg, vreg;
    const bool two = t0 >= 1024;
    __syncthreads();
    kv_load(kreg, vreg, kc, vc, 64, 0, w, lane); kv_store(L + NA_K, L + NA_V, kreg, vreg, w, lane);
    if (two) { kv_load(kreg, vreg, kc, vc, 64, 64, w, lane); kv_store(L + NA_K + 8192, L + NA_V + 8192, kreg, vreg, w, lane); }
    __syncthreads();
    {
        f32x16 pa0, pa1, pb0, pb1; pb0 = (f32x16){}; pb1 = (f32x16){};
        qkt_tile(pa0, pa1, L + NA_K, qr, r32, hi);
        if (two) qkt_tile(pb0, pb1, L + NA_K + 8192, qr, r32, hi);
        const int mv = tok >= 31 ? ((tok - 31) >> 4) : -1;
        float mx = -1.0e30f;
#pragma unroll
        for (int r = 0; r < 16; ++r) { const int m = crow(r, hi);
            pa0[r] = (m <= mv) ? pa0[r] : -1.0e30f; pa1[r] = (m + 32 <= mv) ? pa1[r] : -1.0e30f; pb0[r] = (m + 64 <= mv) ? pb0[r] : -1.0e30f; pb1[r] = (m + 96 <= mv) ? pb1[r] : -1.0e30f;
            mx = fmaxf(fmaxf(mx, fmaxf(pa0[r], pa1[r])), fmaxf(pb0[r], pb1[r])); }
        mx = half_max(mx);
        float sum = 0.f;
#pragma unroll
        for (int r = 0; r < 16; ++r) { const int m = crow(r, hi);
            pa0[r] = (m <= mv) ? fast_exp(pa0[r] - mx) : 0.f; pa1[r] = (m + 32 <= mv) ? fast_exp(pa1[r] - mx) : 0.f; pb0[r] = (m + 64 <= mv) ? fast_exp(pb0[r] - mx) : 0.f; pb1[r] = (m + 96 <= mv) ? fast_exp(pb1[r] - mx) : 0.f;
            sum += (pa0[r] + pa1[r]) + (pb0[r] + pb1[r]); }
        sum = half_sum(sum);
        const float inv = sum > 0.f ? 1.0f / sum : 0.f;
#pragma unroll
        for (int r = 0; r < 16; ++r) { pa0[r] *= inv; pa1[r] *= inv; pb0[r] *= inv; pb1[r] *= inv; }
        LAS float* Gs = (LAS float*)(L + NA_GS); LAS float* Ls = (LAS float*)(L + NA_LS);
#pragma unroll
        for (int rg = 0; rg < 4; ++rg) {
            float gv[4], lv[4];
            gv[0] = (pa0[4 * rg] + pa0[4 * rg + 1]) + (pa0[4 * rg + 2] + pa0[4 * rg + 3]); lv[0] = pa0[4 * rg + 3];
            gv[1] = (pa1[4 * rg] + pa1[4 * rg + 1]) + (pa1[4 * rg + 2] + pa1[4 * rg + 3]); lv[1] = pa1[4 * rg + 3];
            gv[2] = (pb0[4 * rg] + pb0[4 * rg + 1]) + (pb0[4 * rg + 2] + pb0[4 * rg + 3]); lv[2] = pb0[4 * rg + 3];
            gv[3] = (pb1[4 * rg] + pb1[4 * rg + 1]) + (pb1[4 * rg + 2] + pb1[4 * rg + 3]); lv[3] = pb1[4 * rg + 3];
#pragma unroll
            for (int k = 0; k < 4; ++k) { gv[k] += __shfl_xor(gv[k], 1); gv[k] += __shfl_xor(gv[k], 2); lv[k] += __shfl_xor(lv[k], 1); lv[k] += __shfl_xor(lv[k], 2);
                if (hr == 0) { const int np = 8 * k + 2 * rg + hi; Gs[(8 * w + tl) * 32 + np] = gv[k]; Ls[(8 * w + tl) * 32 + np] = lv[k]; } }
        }
#pragma unroll
        for (int r = 0; r < 16; ++r) { pa0[r] *= g0; pa1[r] *= g0; pb0[r] *= g0; pb1[r] *= g0; }
        pv_tile(ot, L + NA_V, pa0, pa1, lane);
        if (two) pv_tile(ot, L + NA_V + 8192, pb0, pb1, lane);
    }
    __syncthreads();
    if (tid < 64) {
        const LAS float* Gs = (const LAS float*)(L + NA_GS) + tid * 32; const LAS float* Ls = (const LAS float*)(L + NA_LS) + tid * 32;
        const int t = t0 + tid, cur = t >> 6;
        float sc[32];
#pragma unroll
        for (int n = 0; n < 32; ++n) { const float imp = Gs[n] + (n > 0 ? Ls[n - 1] : 0.f); const bool forced = (n == 0) || (n == cur) || (n == cur - 1);
            sc[n] = (n <= cur) ? (imp + (forced ? 1.0e4f : 0.f)) : -1.0e30f; }
        unsigned mask = 0u;
        for (int k = 0; k < 8; ++k) {
            float best = -3.0e38f; int bi = 0;
#pragma unroll
            for (int n = 0; n < 32; ++n) { const bool take = sc[n] > best; best = take ? sc[n] : best; bi = take ? n : bi; }
            if (bi <= cur) mask |= 1u << bi;
#pragma unroll
            for (int n = 0; n < 32; ++n) sc[n] = (n == bi) ? -3.0e38f : sc[n];
        }
        ((LAS unsigned*)(L + NA_MASK))[tid] = mask;
    }
    __syncthreads();
    const unsigned mymask = ((const LAS unsigned*)(L + NA_MASK))[8 * w + tl];
    unsigned ormask = 0u;
    { const LAS unsigned* mk = (const LAS unsigned*)(L + NA_MASK);
#pragma unroll 8
      for (int i = 0; i < 64; ++i) ormask |= mk[i]; }
    ormask = (unsigned)__builtin_amdgcn_readfirstlane((int)ormask);
    {
        const bf16_t* Kb = proj + (size_t)(b * SEQ) * 2560 + 1536 + g * 64; const bf16_t* Vb = proj + (size_t)(b * SEQ) * 2560 + 1792 + g * 64;
        f32x16 o[2]; o[0] = (f32x16){}; o[1] = (f32x16){}; float m_run = -1.0e30f, l_run = 0.f;
        for (int n = 0; n <= qt; ++n) {
            if (!((ormask >> n) & 1u)) continue;
            __syncthreads();
            kv_load(kreg, vreg, Kb, Vb, 2560, 64 * n, w, lane); kv_store(L + NA_K, L + NA_V, kreg, vreg, w, lane);
            __syncthreads();
            f32x16 p0, p1; qkt_tile(p0, p1, L + NA_K, qr, r32, hi);
            const bool sel = (mymask >> n) & 1u; const int kbase = 64 * n + 4 * hi;
            auto ok = [&](int r, int blk) { const int kvp = kbase + (r & 3) + 8 * (r >> 2) + 32 * blk; return sel && (kvp <= tok); };
            flash_step(o, m_run, l_run, p0, p1, ok, wsf, L + NA_V, lane, r32, hi);
        }
        o_rows_fma(ot, o, wsf, g1 / l_run, r32, hi);
    }
    {
        const bf16_t* Kb = proj + (size_t)(b * SEQ) * 2560 + 2048 + g * 64; const bf16_t* Vb = proj + (size_t)(b * SEQ) * 2560 + 2304 + g * 64;
        f32x16 o[2]; o[0] = (f32x16){}; o[1] = (f32x16){}; float m_run = -1.0e30f, l_run = 0.f;
        const int n_lo = qt >= 8 ? qt - 8 : 0;
        for (int n = n_lo; n <= qt; ++n) {
            __syncthreads();
            kv_load(kreg, vreg, Kb, Vb, 2560, 64 * n, w, lane); kv_store(L + NA_K, L + NA_V, kreg, vreg, w, lane);
            __syncthreads();
            f32x16 p0, p1; qkt_tile(p0, p1, L + NA_K, qr, r32, hi);
            const int kbase = 64 * n + 4 * hi;
            auto ok = [&](int r, int blk) { const int kvp = kbase + (r & 3) + 8 * (r >> 2) + 32 * blk; return (kvp <= tok) && (kvp > tok - 512); };
            flash_step(o, m_run, l_run, p0, p1, ok, wsf, L + NA_V, lane, r32, hi);
        }
        o_rows_fma(ot, o, wsf, g2 / l_run, r32, hi);
    }
#pragma unroll
    for (int d0 = 0; d0 < 2; ++d0)
#pragma unroll
        for (int r = 0; r < 16; ++r) { const int row = crow(r, hi); const size_t orow = (size_t)(b * SEQ + t0 + 8 * w + (row >> 2));
            cat[orow * 1024 + (g * 4 + (row & 3)) * 64 + 32 * d0 + r32] = (bf16_t)(cvtpk(ot[d0][r], 0.f) & 0xffffu); }
}

#ifndef STUB_MIX0
#define STUB_MIX0 0
#endif
#ifndef STUB_MIX1
#define STUB_MIX1 0
#endif
#ifndef MOE_ON
#define MOE_ON 1
#endif
constexpr int N_PHASES = 19;

__global__ void __launch_bounds__(NTHR, 2) mega_fwd(Args args) {
    extern __shared__ __attribute__((aligned(16))) unsigned char lds_raw[];
    Frame F;
    F.lds = (LAS unsigned char*)lds_raw;
    F.LC = (volatile LAS unsigned*)(F.lds + LDSCTL_OFF);
    F.tid = threadIdx.x; F.lane = F.tid & 63; F.wave = __builtin_amdgcn_readfirstlane(F.tid >> 6);
    F.G = gridDim.x; { const int bx = blockIdx.x; F.vcu = (F.G % 8 == 0) ? (bx % 8) * (F.G / 8) + bx / 8 : bx; }
    F.ctl = (unsigned*)(args.ws + WS_CTL);
    for (int u = F.tid; u < 256; u += NTHR) F.LC[u] = 0u;
    __syncthreads();
    XcdBarrier bar = xcd_barrier_post(F.ctl + CW_BAR, F.LC + LC_BAR);
    const int lo = args.ph_lo, hi = args.ph_hi;
#define IN(k) (lo <= (k) && (k) < hi)
#define SEAM(k) do { if (IN(k) && IN((k) + 1)) xcd_barrier(bar); } while (0)
    unsigned char* ws = args.ws;

    if (IN(0)) { ssm_pow_tables(F, args); nsa_small_tables(F, args); p0_prologue(F, args); } SEAM(0);
#if STUB_MIX0
    if (IN(4)) { scale_phase(F, args.in[I_X], args.out); } SEAM(4);
#else
    if (IN(1)) {
        ssm_frag_tables(F, args);
        pg8::Gemm g{(const bf16_t*)(ws + WS_H), (const bf16_t*)(ws + WS_W0T), 1024}; pg8::StaticOrder S; S.init(NTOK, 2048, F.G, (int)blockIdx.x);
        pg8::EpiBf16 E{(bf16_t*)(ws + WS_ARENA), 2048};
        pg8::gemm_phase(F.lds, g, S, E);
    } SEAM(1);
    if (IN(2)) { l0_mixer_phase(F, args); } SEAM(2);
    if (IN(3)) {
        pg8::Gemm g{(const bf16_t*)(ws + WS_H), (const bf16_t*)(ws + WS_WGLUT), 512}; pg8::StaticOrder S; S.init(NTOK, 512, F.G, (int)blockIdx.x);
        pg8::EpiGlu E{(const bf16_t*)(ws + WS_H), 512, (bf16_t*)(ws + WS_CAT) + 512, 1024};
        pg8::gemm_phase(F.lds, g, S, E);
    } SEAM(3);
    if (IN(4)) {
        pg8::Gemm g{(const bf16_t*)(ws + WS_CAT), (const bf16_t*)(ws + WS_WOUT0T), 1024}; pg8::StaticOrder S; S.init(NTOK, 1024, F.G, (int)blockIdx.x);
        pg8::EpiResid E{args.in[I_X], args.out, 1024};
        pg8::gemm_phase(F.lds, g, S, E);
    } SEAM(4);
#endif
#define MOE_BLOCK(layer, pb) do { \
        if (IN(pb)) { ln_a_phase(F, args, layer); } SEAM(pb); \
        if (MOE_ON) { \
        if (IN(pb + 1)) { moe_gather_phase(F, args, layer); } SEAM(pb + 1); \
        if (IN(pb + 2)) { \
            moe_prefix(F, layer); \
            pg8::Gemm g{(const bf16_t*)(ws + WS_ARENA), (const bf16_t*)(ws + WS_WEXP + layer * WEXP_LAYER), 1024}; \
            pg8::MoeOrder S{(const LAS int*)(F.LC + LC_TSTART), F.G, (int)blockIdx.x}; \
            pg8::EpiSwiGLU E{(bf16_t*)(ws + WS_H), DE}; \
            pg8::gemm_phase(F.lds, g, S, E); \
        } SEAM(pb + 2); \
        if (IN(pb + 3)) { \
            moe_prefix(F, layer); \
            pg8::Gemm g{(const bf16_t*)(ws + WS_H), (const bf16_t*)(ws + WS_WEXP + layer * WEXP_LAYER + WEXP_W2), 512}; \
            pg8::MoeOrder S{(const LAS int*)(F.LC + LC_TSTART), F.G, (int)blockIdx.x}; \
            pg8::EpiBf16 E{(bf16_t*)(ws + WS_ARENA), DM}; \
            pg8::gemm_phase(F.lds, g, S, E); \
        } SEAM(pb + 3); \
        } \
        if (IN(pb + 4)) { ln_b_phase(F, args, layer, layer == 0, MOE_ON != 0); } SEAM(pb + 4); \
    } while (0)
    MOE_BLOCK(0, 5);
#if STUB_MIX1
    if (IN(13)) { scale_phase(F, args.out, args.out); } SEAM(13);
#else
    if (IN(10)) {
        pg8::Gemm g{(const bf16_t*)(ws + WS_H), (const bf16_t*)(ws + WS_WIN1T), 1024}; pg8::StaticOrder S; S.init(NTOK, 2816, F.G, (int)blockIdx.x);
        pg8::EpiRope E{(bf16_t*)(ws + WS_ARENA), (float*)(ws + WS_GATE), (const float*)(ws + WS_ROPE), (const float*)(ws + WS_ROPE) + 2048 * 32};
        pg8::gemm_phase(F.lds, g, S, E);
    } SEAM(10);
    if (IN(11)) { for (int u = blockIdx.x; u < 128; u += F.G) { __syncthreads(); cmp_unit(F, args, u >> 6, u & 63); } } SEAM(11);
    if (IN(12)) { for (;;) { const int t = q_next(F, 1); if (t >= 1024) break; nsa_unit(F, args, (t & 31) >> 2, t & 3, 31 - (t >> 5)); } } SEAM(12);
    if (IN(13)) {
        pg8::Gemm g{(const bf16_t*)(ws + WS_CAT), (const bf16_t*)(ws + WS_WOUT1T), 1024}; pg8::StaticOrder S; S.init(NTOK, 1024, F.G, (int)blockIdx.x);
        pg8::EpiResid E{args.out, args.out, 1024};
        pg8::gemm_phase(F.lds, g, S, E);
    } SEAM(13);
#endif
    MOE_BLOCK(1, 14);
#undef IN
#undef SEAM
}

extern "C" void kernel_launch(void* const* d_in, const int* in_sizes, int n_in, void* d_out, int out_size, void* d_ws, size_t ws_size, hipStream_t stream) {
    static int grid = 0;
    if (grid == 0) {
        if (n_in != 36 || out_size != NTOK * DM || ws_size < WS_END) { fprintf(stderr, "kernel_launch: unexpected shapes (n_in %d out %d ws %zu)\n", n_in, out_size, ws_size); grid = -1; return; }
        int dev = 0, cus = 0, per_cu = 0;
        if (hipGetDevice(&dev) != hipSuccess || hipDeviceGetAttribute(&cus, hipDeviceAttributeMultiprocessorCount, dev) != hipSuccess) { grid = -1; return; }
        if (hipFuncSetAttribute((const void*)mega_fwd, hipFuncAttributeMaxDynamicSharedMemorySize, LDS_BYTES) != hipSuccess) { fprintf(stderr, "kernel_launch: hipFuncSetAttribute failed\n"); grid = -1; return; }
        if (hipOccupancyMaxActiveBlocksPerMultiprocessor(&per_cu, (const void*)mega_fwd, NTHR, LDS_BYTES) != hipSuccess || per_cu < 1) { fprintf(stderr, "kernel_launch: occupancy query says %d\n", per_cu); }
        (void)hipGetLastError();
        grid = cus;
    }
    if (grid < 0) return;
    (void)hipMemsetAsync((char*)d_ws + WS_CTL, 0, CTL_ZERO_BYTES, stream);
    Args a{};
    for (int i = 0; i < 36; ++i) a.in[i] = (const float*)d_in[i];
    a.out = (float*)d_out; a.ws = (unsigned char*)d_ws; a.ph_lo = 0; a.ph_hi = N_PHASES;
    hipLaunchKernelGGL(mega_fwd, dim3(grid), dim3(NTHR), LDS_BYTES, stream, a);
}
```

```cpp
#include <hip/hip_runtime.h>
#include <cstdio>
#include <cstdint>

#define GAS __attribute__((address_space(1)))
#define LAS __attribute__((address_space(3)))
typedef unsigned short bf16_t;
typedef short bf16x8 __attribute__((ext_vector_type(8)));
typedef short s16x4 __attribute__((ext_vector_type(4)));
typedef float f32x2 __attribute__((ext_vector_type(2)));
typedef float f32x4 __attribute__((ext_vector_type(4)));
typedef float f32x16 __attribute__((ext_vector_type(16)));
typedef unsigned u32x2 __attribute__((ext_vector_type(2)));
typedef unsigned u32x4 __attribute__((ext_vector_type(4)));
typedef int i32x4 __attribute__((ext_vector_type(4)));
typedef __bf16 bf16x2_t __attribute__((ext_vector_type(2)));

constexpr int NB = 8, SEQ = 2048, DM = 1024, NTOK = NB * SEQ;
constexpr int NE = 16, DE = 512;
constexpr float ALPHA = 1.41421356237309515f;
constexpr float LN_EPS = 1e-5f;
constexpr int NWAVES = 8, NTHR = 512;
constexpr int MOE_ROWS = 36864;

constexpr size_t MiB = 1u << 20;
constexpr size_t WS_CTL = 0, CTL_ZERO_BYTES = 1 * MiB;
constexpr size_t WS_MISC = 1 * MiB;
constexpr size_t WS_TOKES = WS_MISC;
constexpr size_t WS_TOKW = WS_TOKES + 256 * 1024;
constexpr size_t WS_TOKROW = WS_TOKW + 128 * 1024;
constexpr size_t WS_APOW = WS_MISC + 512 * 1024;
constexpr size_t WS_FTAB = WS_APOW + 1088 * 1024;
constexpr size_t WS_ROPE = WS_FTAB + 64 * 1024;
constexpr size_t WS_GATE = WS_ROPE + 512 * 1024;
constexpr size_t WS_KCMP = WS_GATE + 3 * MiB;
constexpr size_t WS_CBIAS = WS_KCMP + 1024 * 1024;
constexpr size_t WS_CW2T = WS_CBIAS + 4096;
constexpr size_t WS_SSMTAB = 9 * MiB;
constexpr size_t SSM_KF = WS_SSMTAB, SSM_WF = WS_SSMTAB + 2 * MiB, SSM_VF = WS_SSMTAB + 10 * MiB;
constexpr size_t WS_WDENSE = 27 * MiB;
constexpr size_t WS_W0T = WS_WDENSE;
constexpr size_t WS_WGLUT = WS_W0T + 4 * MiB;
constexpr size_t WS_WOUT0T = WS_WGLUT + 512 * 1024;
constexpr size_t WS_WIN1T = WS_WOUT0T + 2 * MiB;
constexpr size_t WS_WOUT1T = WS_WIN1T + 5632 * 1024;
constexpr size_t WS_CW1T = WS_WOUT1T + 2 * MiB;
constexpr size_t WS_WEXP = 43 * MiB;
constexpr size_t WEXP_LAYER = 48 * MiB, WEXP_W2 = 32 * MiB;
constexpr size_t WS_ARENA = 139 * MiB;
constexpr size_t WS_CAT = 219 * MiB;
constexpr size_t WS_H = 251 * MiB;
constexpr size_t WS_END = 287 * MiB;
constexpr int CW_BAR = 4096;
constexpr int CW_CNT = 8192;
constexpr int CW_QUEUE = 16384;

constexpr int RING_BYTES = 131072;
constexpr int LDSCTL_OFF = 163840 - 1024;
constexpr int LC_BAR = 0;
constexpr int LC_Q = 4;
constexpr int LC_TSTART = 16;
constexpr int LDS_BYTES = 163840;

__device__ __forceinline__ unsigned cvtpk(float lo, float hi) { f32x2 v = {lo, hi}; bf16x2_t b = __builtin_convertvector(v, bf16x2_t); return __builtin_bit_cast(unsigned, b); }
__device__ __forceinline__ float bf_lo(unsigned u) { return __uint_as_float(u << 16); }
__device__ __forceinline__ float bf_hi(unsigned u) { return __uint_as_float(u & 0xffff0000u); }
__device__ __forceinline__ float wave_sum(float v) {
#pragma unroll
    for (int o = 1; o < 64; o <<= 1) v += __shfl_xor(v, o);
    return v;
}
__device__ __forceinline__ float fast_exp(float x) { return __builtin_amdgcn_exp2f(x * 1.4426950408889634f); }
__device__ __forceinline__ float fast_sigmoid(float x) { return __builtin_amdgcn_rcpf(1.0f + fast_exp(-x)); }
__device__ __forceinline__ float gelu_tanh(float x) {
    const float u = 0.7978845608028654f * (x + 0.044715f * x * x * x);
    return x * fast_sigmoid(2.0f * u);
}
#define LDS_WAIT() asm volatile("s_waitcnt lgkmcnt(0)" ::: "memory")
#define VM_WAIT() asm volatile("s_waitcnt vmcnt(0)" ::: "memory")
#define RLX_AGENT __ATOMIC_RELAXED, __HIP_MEMORY_SCOPE_AGENT

namespace pg8 {
constexpr int BM = 256, BK = 64, HALF = 128, HTB = HALF * BK * 2, STAGE_BYTES = 8 * HTB, NXCD = 8, WGM = 8;
__host__ __device__ __forceinline__ int lds_byte(int r, int c) { const int st = (r >> 4) * 2 + (c >> 5), rr = r & 15, cc = c & 31, ob = rr * 64 + cc * 2; return st * 1024 + (ob ^ (((ob >> 9) & 1) << 5)); }
__host__ __device__ __forceinline__ void stage_rc(int b, int& R, int& C) { const int st = b / 1024, sb = b % 1024, swz = sb ^ (((sb >> 9) & 1) << 5); R = (st >> 1) * 16 + swz / 64; C = (st & 1) * 32 + (swz % 64) / 2; }
__host__ __device__ __forceinline__ int perm32(int rho) { const int n = rho >> 4, i = rho & 15; return 8 * (i >> 2) + 4 * n + (i & 3); }

struct Unit { int pm, pn, pb; };
struct Gemm { const bf16_t* A; const bf16_t* Bt; int K; };

struct StaticOrder {
    int nM, nN, nwg, G, c;
    __device__ void init(int M, int N, int G_, int c_) { nM = M / BM; nN = N / BM; nwg = nM * nN; G = G_; c = c_; }
    __device__ bool next(int i, Unit& u) const {
        const long L = (long)i * G + c; if (L >= nwg) return false;
        int wgid = (int)L; { const int q = nwg / NXCD, r = nwg % NXCD, xcd = wgid % NXCD, off = wgid / NXCD; wgid = (xcd < r ? xcd * (q + 1) : r * (q + 1) + (xcd - r) * q) + off; }
        const int nig = WGM * nN, gid = wgid / nig, fm = gid * WGM, gsz = (nM - fm) < WGM ? (nM - fm) : WGM;
        u.pm = fm + ((wgid % nig) % gsz); u.pn = (wgid % nig) / gsz; u.pb = u.pn; return true;
    }
};
struct MoeOrder {
    const LAS int* tstart; int G, c;
    __device__ bool next(int i, Unit& u) const {
        const int total = tstart[16] * 4; const long L = (long)i * G + c; if (L >= total) return false;
        const int rt = (int)L >> 2, pn = (int)L & 3; int e = 0;
#pragma unroll
        for (int k = 1; k < 16; ++k) e += (rt >= tstart[k]) ? 1 : 0;
        u.pm = rt; u.pn = pn; u.pb = e * 4 + pn; return true;
    }
};

template <class Epi, class Sched>
__device__ __forceinline__ void gemm_phase(LAS unsigned char* lds, const Gemm g, const Sched& S, const Epi& E) {
    const int tid = threadIdx.x, wid = __builtin_amdgcn_readfirstlane(tid >> 6), lane = tid & 63, wr = wid >> 2, wc = wid & 3, fr = lane & 15, fq = lane >> 4;
    const int K = g.K, nt = K / BK;
    unsigned voffA[2], voffB[2];
#pragma unroll
    for (int i = 0; i < 2; ++i) { int R, C; stage_rc(tid * 16 + i * 8192, R, C); const int Rb = Epi::PERM ? ((R & ~31) + perm32(R & 31)) : R;
        voffA[i] = (unsigned)(R * K + C) * 2u; voffB[i] = (unsigned)(Rb * K + C) * 2u; }
    const size_t kstep = (size_t)(BK * 2);
    const size_t hstep = (size_t)HALF * K * 2;
    const size_t tstep = 2 * hstep;
    const unsigned ldsw = (unsigned)wid * 1024u;
    const int aoff = lds_byte(wr * 64 + fr, fq * 8), boff = lds_byte(wc * 32 + fr, fq * 8);
#define PG8_SA(b, h) (((b) * 2 + (h)) * HTB)
#define PG8_SB(b, h) ((4 + (b) * 2 + (h)) * HTB)
#define PG8_STAGE(bufoff, gbase, voff) do { _Pragma("unroll") for (int _i = 0; _i < 2; ++_i) \
        __builtin_amdgcn_global_load_lds((const unsigned*)((const char*)(gbase) + (voff)[_i]), (LAS unsigned*)(lds + (bufoff) + ldsw + _i * 8192), 16, 0, 0); } while (0)
#define PG8_LDA(dst, b, h) do { _Pragma("unroll") for (int m = 0; m < 4; ++m) _Pragma("unroll") for (int k = 0; k < 2; ++k) dst[m][k] = *(const LAS bf16x8*)(lds + PG8_SA(b, h) + aoff + m * 2048 + k * 1024); } while (0)
#define PG8_LDB(dst, b, h) do { _Pragma("unroll") for (int n = 0; n < 2; ++n) _Pragma("unroll") for (int k = 0; k < 2; ++k) dst[n][k] = *(const LAS bf16x8*)(lds + PG8_SB(b, h) + boff + n * 2048 + k * 1024); } while (0)
#define PG8_MMA(ai, bj, At, Bt) do { __builtin_amdgcn_s_setprio(1); _Pragma("unroll") for (int m = 0; m < 4; ++m) _Pragma("unroll") for (int n = 0; n < 2; ++n) _Pragma("unroll") for (int k = 0; k < 2; ++k) \
        acc[ai][bj][m][n] = __builtin_amdgcn_mfma_f32_16x16x32_bf16(Bt[n][k], At[m][k], acc[ai][bj][m][n], 0, 0, 0); __builtin_amdgcn_s_setprio(0); } while (0)
#define PG8_WAIT_V(n) asm volatile("s_waitcnt vmcnt(" #n ")" ::: "memory")
#define PG8_WAIT_L(n) asm volatile("s_waitcnt lgkmcnt(" #n ")" ::: "memory")
#define PG8_BAR __builtin_amdgcn_s_barrier()
#define PG8_SCHED __builtin_amdgcn_sched_barrier(0)
    Unit cur, nxt; int ui = 0;
    if (!S.next(0, cur)) return;
    f32x4 acc[2][2][4][2];
#pragma unroll
    for (int a = 0; a < 2; ++a)
#pragma unroll
        for (int b = 0; b < 2; ++b)
#pragma unroll
            for (int m = 0; m < 4; ++m)
#pragma unroll
                for (int n = 0; n < 2; ++n) acc[a][b][m][n] = (f32x4){0.f, 0.f, 0.f, 0.f};
    bf16x8 At[4][2], B0[2][2], B1[2][2];
    const char* cA = (const char*)g.A + (size_t)cur.pm * tstep; const char* cB = (const char*)g.Bt + (size_t)cur.pb * tstep;
    PG8_STAGE(PG8_SB(0, 0), cB, voffB); PG8_STAGE(PG8_SB(0, 1), cB + hstep, voffB); PG8_STAGE(PG8_SA(0, 0), cA, voffA); PG8_STAGE(PG8_SA(0, 1), cA + hstep, voffA);
    if (wr == 1) PG8_BAR;
    PG8_WAIT_V(2); PG8_BAR;
    PG8_STAGE(PG8_SB(1, 0), cB + kstep, voffB); PG8_STAGE(PG8_SA(1, 0), cA + kstep, voffA); PG8_STAGE(PG8_SB(1, 1), cB + hstep + kstep, voffB);
    PG8_WAIT_V(6); PG8_BAR;
    for (;;) {
        const bool has_next = S.next(ui + 1, nxt);
        const char* nA = has_next ? (const char*)g.A + (size_t)nxt.pm * tstep : cA; const char* nB = has_next ? (const char*)g.Bt + (size_t)nxt.pb * tstep : cB;
        for (int t = 0; t < nt; t += 2) {
            const bool last = (t == nt - 2);
            const char* a1 = cA + (size_t)(t + 1) * kstep;
            const char* a2 = last ? nA : cA + (size_t)(t + 2) * kstep; const char* b2 = last ? nB : cB + (size_t)(t + 2) * kstep;
            const char* a3 = a2 + kstep; const char* b3 = b2 + kstep;
            PG8_LDB(B0, 0, 0); PG8_LDB(B1, 0, 1); PG8_SCHED; PG8_LDA(At, 0, 0); PG8_STAGE(PG8_SA(1, 1), a1 + hstep, voffA);
            PG8_WAIT_V(8); PG8_WAIT_L(0); PG8_BAR; PG8_MMA(0, 0, At, B0); PG8_MMA(0, 1, At, B1); PG8_BAR; PG8_SCHED;
            PG8_LDA(At, 0, 1); PG8_STAGE(PG8_SB(0, 0), b2, voffB); PG8_STAGE(PG8_SB(0, 1), b2 + hstep, voffB); PG8_STAGE(PG8_SA(0, 0), a2, voffA);
            PG8_WAIT_V(8); PG8_WAIT_L(0); PG8_BAR; PG8_MMA(1, 0, At, B0); PG8_MMA(1, 1, At, B1); PG8_BAR; PG8_SCHED;
            PG8_LDB(B0, 1, 0); PG8_LDB(B1, 1, 1); PG8_SCHED; PG8_LDA(At, 1, 0); PG8_STAGE(PG8_SA(0, 1), a2 + hstep, voffA);
            PG8_WAIT_V(8); PG8_WAIT_L(0); PG8_BAR; PG8_MMA(0, 0, At, B0); PG8_MMA(0, 1, At, B1); PG8_BAR; PG8_SCHED;
            PG8_LDA(At, 1, 1); PG8_STAGE(PG8_SB(1, 0), b3, voffB); PG8_STAGE(PG8_SB(1, 1), b3 + hstep, voffB); PG8_STAGE(PG8_SA(1, 0), a3, voffA);
            PG8_WAIT_V(8); PG8_WAIT_L(0); PG8_BAR; PG8_MMA(1, 0, At, B0); PG8_MMA(1, 1, At, B1); PG8_BAR; PG8_SCHED;
        }
        if (wr == 0) PG8_BAR;
        E(acc, cur, wr, wc, fr, fq);
        if (!has_next) break;
#pragma unroll
        for (int a = 0; a < 2; ++a)
#pragma unroll
            for (int b = 0; b < 2; ++b)
#pragma unroll
                for (int m = 0; m < 4; ++m)
#pragma unroll
                    for (int n = 0; n < 2; ++n) acc[a][b][m][n] = (f32x4){0.f, 0.f, 0.f, 0.f};
        cur = nxt; cA = nA; cB = nB; ++ui;
        if (wr == 1) PG8_BAR;
    }
    PG8_WAIT_V(0);
    PG8_BAR;
#undef PG8_SA
#undef PG8_SB
#undef PG8_STAGE
#undef PG8_LDA
#undef PG8_LDB
#undef PG8_MMA
#undef PG8_WAIT_V
#undef PG8_WAIT_L
#undef PG8_BAR
#undef PG8_SCHED
}

struct EpiBf16 {
    static constexpr bool PERM = true;
    bf16_t* O; int ldc;
    __device__ __forceinline__ void operator()(const f32x4 (&acc)[2][2][4][2], const Unit& u, int wr, int wc, int fr, int fq) const {
        const int row0 = u.pm * BM + wr * 64 + fr, col0 = u.pn * BM + wc * 32 + 8 * fq;
#pragma unroll
        for (int ai = 0; ai < 2; ++ai)
#pragma unroll
            for (int m = 0; m < 4; ++m) { bf16_t* rowp = O + (size_t)(row0 + ai * HALF + m * 16) * ldc + col0;
#pragma unroll
                for (int bj = 0; bj < 2; ++bj) { const f32x4 v0 = acc[ai][bj][m][0], v1 = acc[ai][bj][m][1];
                    u32x4 w; w.x = cvtpk(v0[0], v0[1]); w.y = cvtpk(v0[2], v0[3]); w.z = cvtpk(v1[0], v1[1]); w.w = cvtpk(v1[2], v1[3]);
                    *(u32x4*)(rowp + bj * HALF) = w; } }
    }
};
struct EpiSwiGLU {
    static constexpr bool PERM = true;
    bf16_t* O; int ldc;
    __device__ __forceinline__ void operator()(const f32x4 (&acc)[2][2][4][2], const Unit& u, int wr, int wc, int fr, int fq) const {
        const int row0 = u.pm * BM + wr * 64 + fr, col0 = u.pn * HALF + wc * 32 + 8 * fq;
#pragma unroll
        for (int ai = 0; ai < 2; ++ai)
#pragma unroll
            for (int m = 0; m < 4; ++m) { bf16_t* rowp = O + (size_t)(row0 + ai * HALF + m * 16) * ldc + col0;
                float h[8];
#pragma unroll
                for (int n = 0; n < 2; ++n)
#pragma unroll
                    for (int i = 0; i < 4; ++i) { const float a = acc[ai][0][m][n][i], b = acc[ai][1][m][n][i]; h[n * 4 + i] = a * fast_sigmoid(a) * b; }
                u32x4 w; w.x = cvtpk(h[0], h[1]); w.y = cvtpk(h[2], h[3]); w.z = cvtpk(h[4], h[5]); w.w = cvtpk(h[6], h[7]);
                *(u32x4*)rowp = w; }
    }
};
struct EpiResid {
    static constexpr bool PERM = false;
    const float* resid; float* out; int ldc;
    __device__ __forceinline__ void operator()(const f32x4 (&acc)[2][2][4][2], const Unit& u, int wr, int wc, int fr, int fq) const {
        const int row0 = u.pm * BM + wr * 64 + fr, col0 = u.pn * BM + wc * 32 + 4 * fq;
#pragma unroll
        for (int ai = 0; ai < 2; ++ai)
#pragma unroll
            for (int m = 0; m < 4; ++m) { const size_t off = (size_t)(row0 + ai * HALF + m * 16) * ldc + col0;
#pragma unroll
                for (int bj = 0; bj < 2; ++bj)
#pragma unroll
                    for (int n = 0; n < 2; ++n) { const f32x4 r = *(const f32x4*)(resid + off + bj * HALF + n * 16); *(f32x4*)(out + off + bj * HALF + n * 16) = r * ALPHA + acc[ai][bj][m][n]; } }
    }
};
struct EpiGlu {
    static constexpr bool PERM = true;
    const bf16_t* h; int ldh; bf16_t* O; int ldc;
    __device__ __forceinline__ void operator()(const f32x4 (&acc)[2][2][4][2], const Unit& u, int wr, int wc, int fr, int fq) const {
        const int row0 = u.pm * BM + wr * 64 + fr, col0 = u.pn * BM + wc * 32 + 8 * fq;
#pragma unroll
        for (int ai = 0; ai < 2; ++ai)
#pragma unroll
            for (int m = 0; m < 4; ++m) { const size_t row = (size_t)(row0 + ai * HALF + m * 16);
#pragma unroll
                for (int bj = 0; bj < 2; ++bj) { const int col = col0 + bj * HALF; const u32x4 hv = *(const u32x4*)(h + row * ldh + col);
                    const f32x4 v0 = acc[ai][bj][m][0], v1 = acc[ai][bj][m][1];
                    u32x4 w; w.x = cvtpk(bf_lo(hv.x) * fast_sigmoid(v0[0]), bf_hi(hv.x) * fast_sigmoid(v0[1])); w.y = cvtpk(bf_lo(hv.y) * fast_sigmoid(v0[2]), bf_hi(hv.y) * fast_sigmoid(v0[3]));
                    w.z = cvtpk(bf_lo(hv.z) * fast_sigmoid(v1[0]), bf_hi(hv.z) * fast_sigmoid(v1[1])); w.w = cvtpk(bf_lo(hv.w) * fast_sigmoid(v1[2]), bf_hi(hv.w) * fast_sigmoid(v1[3]));
                    *(u32x4*)(O + row * ldc + col) = w; } }
    }
};
struct EpiRope {
    static constexpr bool PERM = false;
    bf16_t* O; float* gate; const float* rc; const float* rs;
    __device__ __forceinline__ void operator()(const f32x4 (&acc)[2][2][4][2], const Unit& u, int wr, int wc, int fr, int fq) const {
        const int row0 = u.pm * BM + wr * 64 + fr;
        if (u.pn < 10) {
            const bool rope = (u.pn < 4) || (u.pn == 6) || (u.pn == 8); const float sc = u.pn < 4 ? 0.125f : 1.0f;
            const int j = (wc & 1) * 16 + fq * 4;
#pragma unroll
            for (int ai = 0; ai < 2; ++ai)
#pragma unroll
                for (int m = 0; m < 4; ++m) { const int row = row0 + ai * HALF + m * 16, pos = row & 2047;
                    f32x4 c4 = {1.f, 1.f, 1.f, 1.f}, s4 = {0.f, 0.f, 0.f, 0.f};
                    if (rope) { c4 = *(const f32x4*)(rc + pos * 32 + j); s4 = *(const f32x4*)(rs + pos * 32 + j); }
#pragma unroll
                    for (int bj = 0; bj < 2; ++bj) { const int head = bj * 2 + (wc >> 1); const f32x4 x1 = acc[ai][bj][m][0], x2 = acc[ai][bj][m][1];
                        const f32x4 y1 = (x1 * c4 - x2 * s4) * sc, y2 = (x1 * s4 + x2 * c4) * sc;
                        bf16_t* op = O + (size_t)row * 2560 + u.pn * 256 + head * 64 + j;
                        u32x2 w1; w1.x = cvtpk(y1[0], y1[1]); w1.y = cvtpk(y1[2], y1[3]); *(u32x2*)op = w1;
                        u32x2 w2; w2.x = cvtpk(y2[0], y2[1]); w2.y = cvtpk(y2[2], y2[3]); *(u32x2*)(op + 32) = w2; } }
        } else {
#pragma unroll
            for (int ai = 0; ai < 2; ++ai)
#pragma unroll
                for (int m = 0; m < 4; ++m) { const int row = row0 + ai * HALF + m * 16;
#pragma unroll
                    for (int n = 0; n < 2; ++n) { const int c = 32 * wc + 16 * n + 4 * fq; const f32x4 v = acc[ai][0][m][n];
                        if (c < 48) *(f32x4*)(gate + (size_t)row * 48 + c) = (f32x4){fast_sigmoid(v[0]), fast_sigmoid(v[1]), fast_sigmoid(v[2]), fast_sigmoid(v[3])}; } }
        }
    }
};
}

#define XB_TMO      128
#define XB_XCNT(j)  (256  + 64 * (j))
#define XB_XSUB(j)  (1280 + 64 * (j))
#define XB_XGEN(j)  (2304 + 64 * (j))
#define XB_TOP      3328
#define XB_TOPGEN   3392
#define XCD_BAR_WORDS 3456
#define XB_SPIN_CAP (1u << 22)
__device__ __forceinline__ unsigned xb_ld(unsigned* p)              { return __hip_atomic_load(p, __ATOMIC_RELAXED, __HIP_MEMORY_SCOPE_AGENT); }
__device__ __forceinline__ unsigned xb_add(unsigned* p, unsigned v) { return __hip_atomic_fetch_add(p, v, __ATOMIC_RELAXED, __HIP_MEMORY_SCOPE_AGENT); }
__device__ __forceinline__ unsigned xb_xcc_id() { return (unsigned)__builtin_amdgcn_s_getreg((3 << 11) | 20) & 0xFu; }
#define XB_SPIN(cond, bar) do { unsigned _sp = 0; while (cond) { __builtin_amdgcn_s_sleep(1); \
    if ((++_sp & 255u) == 0u) { if (xb_ld(&(bar)[XB_TMO])) break; if (_sp > XB_SPIN_CAP) { atomicAdd(&(bar)[XB_TMO], 1u); break; } } } } while (0)
struct XcdBarrier { unsigned* bar; unsigned x; volatile LAS unsigned* st; };
__device__ __forceinline__ XcdBarrier xcd_barrier_post(unsigned* bar, volatile LAS unsigned* st) {
    XcdBarrier b; b.bar = bar; b.x = xb_xcc_id(); b.st = st;
    if (threadIdx.x == 0) (void)xb_add(&bar[XB_XCNT(b.x)], 1u);
    return b;
}
__device__ __forceinline__ void xcd_barrier_complete(unsigned* bar, unsigned x, unsigned& nloc, unsigned& nx) {
    const unsigned G = gridDim.x * gridDim.y * gridDim.z;
    unsigned sum, cnt, mine, sp = 0u;
    for (;;) {
        sum = 0u; cnt = 0u; mine = 0u;
#pragma unroll
        for (unsigned j = 0; j < 16; ++j) { const unsigned c = xb_ld(&bar[XB_XCNT(j)]); sum += c; cnt += (c > 0u) ? 1u : 0u; mine = (j == x) ? c : mine; }
        if (sum == G) break;
        __builtin_amdgcn_s_sleep(1);
        if ((++sp & 255u) == 0u) { if (xb_ld(&bar[XB_TMO])) break; if (sp > XB_SPIN_CAP) { atomicAdd(&bar[XB_TMO], 1u); break; } }
    }
    nloc = mine > 0u ? mine : 1u; nx = cnt > 0u ? cnt : 1u;
}
__device__ __forceinline__ void xcd_barrier(const XcdBarrier& b) {
    asm volatile("s_waitcnt vmcnt(0)" ::: "memory");
    __syncthreads();
    if (threadIdx.x == 0) {
        unsigned* bar = b.bar;
        __builtin_amdgcn_s_waitcnt(0);
        unsigned nloc = b.st[0], nx = b.st[1];
        if (nloc == 0u) { xcd_barrier_complete(bar, b.x, nloc, nx); b.st[0] = nloc; b.st[1] = nx; }
        const unsigned old = xb_add(&bar[XB_XSUB(b.x)], 1u);
        const unsigned gen = old / nloc;
        if (old + 1u == (gen + 1u) * nloc) {
            __builtin_amdgcn_fence(__ATOMIC_RELEASE, "agent");
            asm volatile("s_waitcnt vmcnt(0)" ::: "memory");
            const unsigned og = xb_add(&bar[XB_TOP], 1u);
            const unsigned tg = og / nx;
            if (og + 1u == (tg + 1u) * nx) xb_add(&bar[XB_TOPGEN], 1u);
            else XB_SPIN(xb_ld(&bar[XB_TOPGEN]) == tg, bar);
            __builtin_amdgcn_fence(__ATOMIC_ACQUIRE, "agent");
            xb_add(&bar[XB_XGEN(b.x)], 1u);
            asm volatile("s_waitcnt vmcnt(0)" ::: "memory");
        } else {
            XB_SPIN(xb_ld(&bar[XB_XGEN(b.x)]) == gen, bar);
            __builtin_amdgcn_fence(__ATOMIC_ACQUIRE, "agent");
            asm volatile("s_waitcnt vmcnt(0)" ::: "memory");
        }
    }
    __syncthreads();
}

struct Args { const float* in[36]; float* out; unsigned char* ws; int ph_lo, ph_hi; };
struct Frame {
    LAS unsigned char* lds;
    volatile LAS unsigned* LC;
    unsigned* ctl;
    int tid, lane, wave, vcu, G;
};
enum { I_X = 0, I_WIN0, I_LAMRE, I_LAMIM, I_LOGDT, I_BRE, I_BIM, I_CRE, I_CIM, I_SSMD, I_WGLU, I_WOUT0, I_LNMG0, I_LNMB0, I_LNFG0, I_LNFB0, I_W1_0, I_W3_0, I_W2_0,
       I_WIN1, I_CPK, I_CW1K, I_CW2K, I_CPV, I_CW1V, I_CW2V, I_WOUT1, I_LNMG1, I_LNMB1, I_LNFG1, I_LNFB1, I_W1_1, I_W3_1, I_W2_1, I_WR, I_BR };

template <class RowMap>
__device__ __forceinline__ void p0_transpose_item(const float* W, int K, int ldw, int ncols_valid, int nblk, bf16_t* WT, const RowMap& rm, LAS float* scr, int item, int lane) {
    const int kb = item / nblk, nb = item % nblk, k0 = 64 * kb, n0 = 32 * nb;
    const int nsrc = (n0 + (lane & 31)) < ncols_valid ? (n0 + (lane & 31)) : (ncols_valid - 1);
#pragma unroll 8
    for (int i = 0; i < 32; ++i) { const int kk = 2 * i + (lane >> 5); scr[kk * 33 + (lane & 31)] = W[(size_t)(k0 + kk) * ldw + nsrc]; }
    LDS_WAIT(); asm volatile("" ::: "memory");
    const int c = lane & 7;
#pragma unroll
    for (int j = 0; j < 4; ++j) { const int n = (lane >> 3) + 8 * j; const LAS float* s = scr + (8 * c) * 33 + n;
        u32x4 o; o.x = cvtpk(s[0 * 33], s[1 * 33]); o.y = cvtpk(s[2 * 33], s[3 * 33]); o.z = cvtpk(s[4 * 33], s[5 * 33]); o.w = cvtpk(s[6 * 33], s[7 * 33]);
        *(u32x4*)(WT + (size_t)rm(n0 + n) * K + k0 + 8 * c) = o; }
    LDS_WAIT(); asm volatile("" ::: "memory");
}
struct RmId { int off; __device__ __forceinline__ int operator()(int n) const { return off + n; } };
struct RmW13 { int half; __device__ __forceinline__ int operator()(int n) const { return (n >> 7) * 256 + half * 128 + (n & 127); } };
struct RmRope {
    __device__ __forceinline__ int operator()(int n) const {
        if (n >= 2560) return n;
        const int tile = n >> 8, o = n & 255, head = o >> 6, half = (o >> 5) & 1, j = o & 31;
        const int bj = head >> 1, wc = (head & 1) * 2 + (j >> 4), fq = (j >> 2) & 3, i = j & 3;
        return tile * 256 + 128 * bj + 32 * wc + 16 * half + 4 * fq + i;
    }
};

__device__ __forceinline__ void p0_prologue(Frame& F, const Args& A) {
    LAS float* scr = (LAS float*)(F.lds + F.wave * 16384);
    const int gw = F.vcu * NWAVES + F.wave, NGW = F.G * NWAVES;
    unsigned char* ws = A.ws;
    constexpr int IT_W0 = (1024 / 64) * (2048 / 32);
    constexpr int IT_GLU = (512 / 64) * (512 / 32);
    constexpr int IT_SQ = (1024 / 64) * (1024 / 32);
    constexpr int IT_IN1 = (1024 / 64) * (2816 / 32);
    constexpr int IT_CW1 = (2048 / 64) * (256 / 32);
    constexpr int IT_E13 = (1024 / 64) * (512 / 32);
    constexpr int IT_E2 = (512 / 64) * (1024 / 32);
    constexpr int IT_DENSE = IT_W0 + IT_GLU + IT_SQ + IT_IN1 + IT_SQ + 2 * IT_CW1;
    constexpr int IT_EXPL = 16 * (2 * IT_E13 + IT_E2);
    constexpr int NITEMS = IT_DENSE + 2 * IT_EXPL;
    for (int it = gw; it < NITEMS; it += NGW) {
        int r = it;
        if (r < IT_W0) { p0_transpose_item(A.in[I_WIN0], 1024, 2048, 2048, 64, (bf16_t*)(ws + WS_W0T), RmId{0}, scr, r, F.lane); continue; } r -= IT_W0;
        if (r < IT_GLU) { p0_transpose_item(A.in[I_WGLU], 512, 512, 512, 16, (bf16_t*)(ws + WS_WGLUT), RmId{0}, scr, r, F.lane); continue; } r -= IT_GLU;
        if (r < IT_SQ) { p0_transpose_item(A.in[I_WOUT0], 1024, 1024, 1024, 32, (bf16_t*)(ws + WS_WOUT0T), RmId{0}, scr, r, F.lane); continue; } r -= IT_SQ;
        if (r < IT_IN1) { p0_transpose_item(A.in[I_WIN1], 1024, 2608, 2608, 88, (bf16_t*)(ws + WS_WIN1T), RmRope{}, scr, r, F.lane); continue; } r -= IT_IN1;
        if (r < IT_SQ) { p0_transpose_item(A.in[I_WOUT1], 1024, 1024, 1024, 32, (bf16_t*)(ws + WS_WOUT1T), RmId{0}, scr, r, F.lane); continue; } r -= IT_SQ;
        if (r < IT_CW1) { p0_transpose_item(A.in[I_CW1K], 2048, 256, 256, 8, (bf16_t*)(ws + WS_CW1T), RmId{0}, scr, r, F.lane); continue; } r -= IT_CW1;
        if (r < IT_CW1) { p0_transpose_item(A.in[I_CW1V], 2048, 256, 256, 8, (bf16_t*)(ws + WS_CW1T) + 256 * 2048, RmId{0}, scr, r, F.lane); continue; } r -= IT_CW1;
        const int layer = r / IT_EXPL; r -= layer * IT_EXPL;
        const int e = r / (2 * IT_E13 + IT_E2); r -= e * (2 * IT_E13 + IT_E2);
        bf16_t* w13t = (bf16_t*)(ws + WS_WEXP + layer * WEXP_LAYER) + (size_t)e * 1024 * 1024;
        bf16_t* w2t = (bf16_t*)(ws + WS_WEXP + layer * WEXP_LAYER + WEXP_W2) + (size_t)e * 1024 * 512;
        const float* w1 = A.in[layer ? I_W1_1 : I_W1_0] + (size_t)e * 1024 * 512;
        const float* w3 = A.in[layer ? I_W3_1 : I_W3_0] + (size_t)e * 1024 * 512;
        const float* w2 = A.in[layer ? I_W2_1 : I_W2_0] + (size_t)e * 512 * 1024;
        if (r < IT_E13) { p0_transpose_item(w1, 1024, 512, 512, 16, w13t, RmW13{0}, scr, r, F.lane); continue; } r -= IT_E13;
        if (r < IT_E13) { p0_transpose_item(w3, 1024, 512, 512, 16, w13t, RmW13{1}, scr, r, F.lane); continue; } r -= IT_E13;
        p0_transpose_item(w2, 512, 1024, 1024, 32, w2t, RmId{0}, scr, r, F.lane);
    }
    bf16_t* xb = (bf16_t*)(ws + WS_H);
    for (int m = gw; m < NTOK; m += NGW) {
        const f32x4* xr = (const f32x4*)(A.in[I_X] + (size_t)m * DM) + F.lane; u32x2* o = (u32x2*)(xb + (size_t)m * DM) + F.lane;
#pragma unroll
        for (int j = 0; j < 4; ++j) { const f32x4 v = xr[64 * j]; u32x2 w; w.x = cvtpk(v[0], v[1]); w.y = cvtpk(v[2], v[3]); o[64 * j] = w; }
    }
}

__device__ __forceinline__ void ln_a_phase(Frame& F, const Args& A, int layer) {
    float* xres = A.out; bf16_t* xb = (bf16_t*)(A.ws + WS_H);
    const float* gam = A.in[layer ? I_LNMG1 : I_LNMG0]; const float* bet = A.in[layer ? I_LNMB1 : I_LNMB0];
    const float* wr = A.in[I_WR]; const float* br = A.in[I_BR];
    LAS float* wrT = (LAS float*)F.lds;
    for (int i = F.tid; i < DM * NE; i += NTHR) { const int k = i >> 4, e = i & 15; wrT[e * DM + k] = wr[i]; }
    __syncthreads();
    f32x4 gv[4], bv[4];
#pragma unroll
    for (int j = 0; j < 4; ++j) { gv[j] = ((const f32x4*)gam)[F.lane + 64 * j]; bv[j] = ((const f32x4*)bet)[F.lane + 64 * j]; }
    float brv = br[F.lane & 15];
    i32x4* tokes = (i32x4*)(A.ws + WS_TOKES); f32x2* tokw = (f32x2*)(A.ws + WS_TOKW);
    unsigned* cnt = F.ctl + CW_CNT + layer * 16 * 64;
    const int gw = F.vcu * NWAVES + F.wave, NGW = F.G * NWAVES;
    for (int m = gw; m < NTOK; m += NGW) {
        f32x4* xr = (f32x4*)(xres + (size_t)m * DM) + F.lane;
        f32x4 v[4]; float s = 0.f;
#pragma unroll
        for (int j = 0; j < 4; ++j) { v[j] = xr[64 * j]; s += (v[j][0] + v[j][1]) + (v[j][2] + v[j][3]); }
        const float mean = wave_sum(s) * (1.f / DM); float s2 = 0.f;
#pragma unroll
        for (int j = 0; j < 4; ++j) { v[j] = v[j] - mean; s2 += (v[j][0] * v[j][0] + v[j][1] * v[j][1]) + (v[j][2] * v[j][2] + v[j][3] * v[j][3]); }
        const float rstd = 1.f / sqrtf(wave_sum(s2) * (1.f / DM) + LN_EPS);
        u32x2* o8 = (u32x2*)(xb + (size_t)m * DM) + F.lane;
#pragma unroll
        for (int j = 0; j < 4; ++j) { v[j] = v[j] * rstd * gv[j] + bv[j]; xr[64 * j] = v[j]; u32x2 w; w.x = cvtpk(v[j][0], v[j][1]); w.y = cvtpk(v[j][2], v[j][3]); o8[64 * j] = w; }
        float lg = 0.f;
#pragma unroll 1
        for (int e = 0; e < NE; ++e) {
            float p = 0.f;
#pragma unroll
            for (int j = 0; j < 4; ++j) { const f32x4 w = *(const LAS f32x4*)(wrT + e * DM + 4 * F.lane + 256 * j); p += (v[j][0] * w[0] + v[j][1] * w[1]) + (v[j][2] * w[2] + v[j][3] * w[3]); }
            p = wave_sum(p);
            lg = ((F.lane & 15) == e) ? p : lg;
        }
        const float aff = 1.0f / (1.0f + expf(-lg));
        const float sel = aff + brv;
        float sv[16], av[16];
#pragma unroll
        for (int e = 0; e < NE; ++e) { sv[e] = __shfl(sel, e); av[e] = __shfl(aff, e); }
        int gbest = 0; float gscore = -3.0e38f;
#pragma unroll
        for (int g = 0; g < 4; ++g) {
            float a0 = sv[4 * g], a1 = sv[4 * g + 1], a2 = sv[4 * g + 2], a3 = sv[4 * g + 3];
            float m1 = fmaxf(fmaxf(a0, a1), fmaxf(a2, a3));
            float p01 = a0 + a1, p02 = a0 + a2, p03 = a0 + a3, p12 = a1 + a2, p13 = a1 + a3, p23 = a2 + a3;
            float t2 = fmaxf(fmaxf(fmaxf(p01, p02), fmaxf(p03, p12)), fmaxf(p13, p23));
            (void)m1;
            if (t2 > gscore) { gscore = t2; gbest = g; }
        }
        float g0 = 0.f, g1 = 0.f, g2 = 0.f, g3 = 0.f, f0 = 0.f, f1 = 0.f, f2 = 0.f, f3 = 0.f;
#pragma unroll
        for (int g = 0; g < 4; ++g) if (g == gbest) { g0 = sv[4 * g]; g1 = sv[4 * g + 1]; g2 = sv[4 * g + 2]; g3 = sv[4 * g + 3]; f0 = av[4 * g]; f1 = av[4 * g + 1]; f2 = av[4 * g + 2]; f3 = av[4 * g + 3]; }
        int i0 = 0; float b0 = g0; if (g1 > b0) { b0 = g1; i0 = 1; } if (g2 > b0) { b0 = g2; i0 = 2; } if (g3 > b0) { b0 = g3; i0 = 3; }
        int i1 = -1; float b1 = -3.0e38f;
        if (i0 != 0 && g0 > b1) { b1 = g0; i1 = 0; } if (i0 != 1 && g1 > b1) { b1 = g1; i1 = 1; } if (i0 != 2 && g2 > b1) { b1 = g2; i1 = 2; } if (i0 != 3 && g3 > b1) { b1 = g3; i1 = 3; }
        const float a_0 = i0 == 0 ? f0 : i0 == 1 ? f1 : i0 == 2 ? f2 : f3, a_1 = i1 == 0 ? f0 : i1 == 1 ? f1 : i1 == 2 ? f2 : f3;
        const float inv = 1.0f / (a_0 + a_1);
        const int e0 = gbest * 4 + i0, e1 = gbest * 4 + i1;
        if (F.lane == 0) {
            const int s0 = (int)__hip_atomic_fetch_add(cnt + 64 * e0, 1u, RLX_AGENT), s1 = (int)__hip_atomic_fetch_add(cnt + 64 * e1, 1u, RLX_AGENT);
            tokes[m] = (i32x4){e0, s0, e1, s1}; tokw[m] = (f32x2){a_0 * inv, a_1 * inv};
        }
    }
}
__device__ __forceinline__ void moe_prefix(Frame& F, int layer) {
    __syncthreads();
    if (F.tid == 0) {
        unsigned* cnt = F.ctl + CW_CNT + layer * 16 * 64; int acc = 0;
        for (int e = 0; e < NE; ++e) { F.LC[LC_TSTART + e] = (unsigned)acc; const unsigned c = __hip_atomic_load(cnt + 64 * e, RLX_AGENT); acc += (int)((c + 255u) >> 8); }
        F.LC[LC_TSTART + 16] = (unsigned)acc;
    }
    __syncthreads();
}
__device__ __forceinline__ void moe_gather_phase(Frame& F, const Args& A, int layer) {
    moe_prefix(F, layer);
    const bf16_t* xb = (const bf16_t*)(A.ws + WS_H); bf16_t* xg = (bf16_t*)(A.ws + WS_ARENA);
    const i32x4* tokes = (const i32x4*)(A.ws + WS_TOKES); int* tokrow = (int*)(A.ws + WS_TOKROW);
    const int gw = F.vcu * NWAVES + F.wave, NGW = F.G * NWAVES;
    for (int m = gw; m < NTOK; m += NGW) {
        const i32x4 es = tokes[m];
        const int r0 = (int)F.LC[LC_TSTART + es[0]] * 256 + es[1], r1 = (int)F.LC[LC_TSTART + es[2]] * 256 + es[3];
        const u32x4* src = (const u32x4*)(xb + (size_t)m * DM) + F.lane;
        const u32x4 a = src[0], b = src[64];
        u32x4* d0 = (u32x4*)(xg + (size_t)r0 * DM) + F.lane; u32x4* d1 = (u32x4*)(xg + (size_t)r1 * DM) + F.lane;
        d0[0] = a; d0[64] = b; d1[0] = a; d1[64] = b;
        if (F.lane == 0) { tokrow[2 * m] = r0; tokrow[2 * m + 1] = r1; }
    }
}
__device__ __forceinline__ void ln_b_phase(Frame& F, const Args& A, int layer, bool write_bf16, bool moe_on) {
    float* xres = A.out; bf16_t* xb = (bf16_t*)(A.ws + WS_H);
    const bf16_t* Y = (const bf16_t*)(A.ws + WS_ARENA);
    const float* gam = A.in[layer ? I_LNFG1 : I_LNFG0]; const float* bet = A.in[layer ? I_LNFB1 : I_LNFB0];
    const int* tokrow = (const int*)(A.ws + WS_TOKROW); const f32x2* tokw = (const f32x2*)(A.ws + WS_TOKW);
    f32x4 gv[4], bv[4];
#pragma unroll
    for (int j = 0; j < 4; ++j) { gv[j] = ((const f32x4*)gam)[F.lane + 64 * j]; bv[j] = ((const f32x4*)bet)[F.lane + 64 * j]; }
    const int gw = F.vcu * NWAVES + F.wave, NGW = F.G * NWAVES;
    for (int m = gw; m < NTOK; m += NGW) {
        f32x4* xr = (f32x4*)(xres + (size_t)m * DM) + F.lane;
        f32x4 v[4]; float s = 0.f;
        const int r0 = tokrow[2 * m], r1 = tokrow[2 * m + 1]; const f32x2 w = tokw[m];
        const u32x2* y0 = (const u32x2*)(Y + (size_t)r0 * DM) + F.lane; const u32x2* y1 = (const u32x2*)(Y + (size_t)r1 * DM) + F.lane;
#pragma unroll
        for (int j = 0; j < 4; ++j) {
            v[j] = xr[64 * j] * ALPHA;
            if (moe_on) { const u32x2 a = y0[64 * j], b = y1[64 * j];
                v[j][0] += w[0] * bf_lo(a.x) + w[1] * bf_lo(b.x); v[j][1] += w[0] * bf_hi(a.x) + w[1] * bf_hi(b.x);
                v[j][2] += w[0] * bf_lo(a.y) + w[1] * bf_lo(b.y); v[j][3] += w[0] * bf_hi(a.y) + w[1] * bf_hi(b.y); }
            s += (v[j][0] + v[j][1]) + (v[j][2] + v[j][3]);
        }
        const float mean = wave_sum(s) * (1.f / DM); float s2 = 0.f;
#pragma unroll
        for (int j = 0; j < 4; ++j) { v[j] = v[j] - mean; s2 += (v[j][0] * v[j][0] + v[j][1] * v[j][1]) + (v[j][2] * v[j][2] + v[j][3] * v[j][3]); }
        const float rstd = 1.f / sqrtf(wave_sum(s2) * (1.f / DM) + LN_EPS);
        u32x2* o8 = (u32x2*)(xb + (size_t)m * DM) + F.lane;
#pragma unroll
        for (int j = 0; j < 4; ++j) { v[j] = v[j] * rstd * gv[j] + bv[j]; xr[64 * j] = v[j];
            if (write_bf16) { u32x2 w2; w2.x = cvtpk(v[j][0], v[j][1]); w2.y = cvtpk(v[j][2], v[j][3]); o8[64 * j] = w2; } }
    }
}
__device__ __forceinline__ void scale_phase(Frame& F, const float* src, float* dst) {
    const int gw = F.vcu * NWAVES + F.wave, NGW = F.G * NWAVES;
    for (int m = gw; m < NTOK; m += NGW) {
        const f32x4* xr = (const f32x4*)(src + (size_t)m * DM) + F.lane; f32x4* o = (f32x4*)(dst + (size_t)m * DM) + F.lane;
#pragma unroll
        for (int j = 0; j < 4; ++j) o[64 * j] = xr[64 * j] * ALPHA;
    }
}

__device__ __forceinline__ int q_next(Frame& F, int q) {
    __syncthreads();
    if (F.tid == 0) F.LC[LC_Q] = __hip_atomic_fetch_add(F.ctl + CW_QUEUE + 64 * q, 1u, RLX_AGENT);
    __syncthreads();
    return (int)F.LC[LC_Q];
}

__device__ __forceinline__ void ssm_pow_tables(Frame& F, const Args& A) {
    f32x2* apow = (f32x2*)(A.ws + WS_APOW); f32x2* ftab = (f32x2*)(A.ws + WS_FTAB);
    const int gt = F.vcu * NTHR + F.tid, NGT = F.G * NTHR;
    for (int it = gt; it < 32 * 64 * 65; it += NGT) {
        const int n = it % 65, gp = it / 65, g = gp >> 6;
        const double dt = exp((double)A.in[I_LOGDT][g]);
        const double lr = (double)A.in[I_LAMRE][gp], li = (double)A.in[I_LAMIM][gp];
        const double mag = exp(lr * dt * (double)n);
        double th = li * dt * (double)n; th -= 6.283185307179586476925 * rint(th * 0.15915494309189533577);
        const double c = cos(th), s = sin(th);
        apow[it] = (f32x2){(float)(mag * c), (float)(mag * s)};
        if (n == 1) { const double are = mag * c, aim = mag * s, nr = are - 1.0, den = lr * lr + li * li;
            ftab[gp] = (f32x2){(float)((nr * lr + aim * li) / den), (float)((aim * lr - nr * li) / den)}; }
    }
}
__device__ __forceinline__ void ssm_frag_tables(Frame& F, const Args& A) {
    const f32x2* apow = (const f32x2*)(A.ws + WS_APOW); const f32x2* ftab = (const f32x2*)(A.ws + WS_FTAB);
    const float* bre = A.in[I_BRE]; const float* bim = A.in[I_BIM]; const float* cre = A.in[I_CRE]; const float* cim = A.in[I_CIM];
    const int gt = F.vcu * NTHR + F.tid, NGT = F.G * NTHR;
    constexpr int N_KF = 32 * 64 * 64, N_WF = 32 * 8 * 32 * 64, N_VF = 32 * 64 * 4 * 64;
    for (int it = gt; it < N_KF + N_WF + N_VF; it += NGT) {
        float v[8];
        if (it < N_KF) {
            const int lane = it & 63, tau0 = (it >> 6) & 63, g = it >> 12;
            const int h = lane & 15, kq = lane >> 4, jj = kq >> 1, hb = (kq & 1) * 8, tau = tau0 - jj;
#pragma unroll
            for (int e = 0; e < 8; ++e) v[e] = 0.f;
            if (tau >= 0) {
                for (int p = 0; p < 64; ++p) {
                    const int gp = g * 64 + p; const f32x2 a = apow[gp * 65 + tau], f = ftab[gp];
                    const float cr = cre[(g * 16 + h) * 64 + p], ci = cim[(g * 16 + h) * 64 + p];
                    const float mr = cr * a[0] - ci * a[1], mi = cr * a[1] + ci * a[0];
                    const float nr = mr * f[0] - mi * f[1], ni = mr * f[1] + mi * f[0];
#pragma unroll
                    for (int e = 0; e < 8; ++e) { const float br = bre[gp * 16 + hb + e], bi = bim[gp * 16 + hb + e]; v[e] += nr * br - ni * bi; }
                }
            }
            u32x4 w; w.x = cvtpk(v[0], v[1]); w.y = cvtpk(v[2], v[3]); w.z = cvtpk(v[4], v[5]); w.w = cvtpk(v[6], v[7]);
            ((u32x4*)(A.ws + SSM_KF))[it] = w;
        } else if (it < N_KF + N_WF) {
            const int r = it - N_KF; const int lane = r & 63, js = (r >> 6) & 31, mt = (r >> 11) & 7, g = r >> 14;
            const int rr = 16 * mt + (lane & 15), ri = rr >> 6, p = rr & 63, kq = lane >> 4, j = 2 * js + (kq >> 1), hb = (kq & 1) * 8;
            const int gp = g * 64 + p; const f32x2 a = apow[gp * 65 + (63 - j)], f = ftab[gp];
            const float mr = a[0] * f[0] - a[1] * f[1], mi = a[0] * f[1] + a[1] * f[0];
#pragma unroll
            for (int e = 0; e < 8; ++e) { const float br = bre[gp * 16 + hb + e], bi = bim[gp * 16 + hb + e]; v[e] = ri == 0 ? (mr * br - mi * bi) : (mr * bi + mi * br); }
            u32x4 w; w.x = cvtpk(v[0], v[1]); w.y = cvtpk(v[2], v[3]); w.z = cvtpk(v[4], v[5]); w.w = cvtpk(v[6], v[7]);
            ((u32x4*)(A.ws + SSM_WF))[r] = w;
        } else {
            const int r = it - N_KF - N_WF; const int lane = r & 63, ks = (r >> 6) & 3, i = (r >> 8) & 63, g = r >> 14;
            const int h = lane & 15, kq = lane >> 4;
#pragma unroll
            for (int e = 0; e < 8; ++e) { const int rr = 32 * ks + 8 * kq + e, ri = rr >> 6, p = rr & 63, gp = g * 64 + p; const f32x2 a = apow[gp * 65 + i + 1];
                const float cr = cre[(g * 16 + h) * 64 + p], ci = cim[(g * 16 + h) * 64 + p];
                v[e] = ri == 0 ? (cr * a[0] - ci * a[1]) : -(cr * a[1] + ci * a[0]); }
            u32x4 w; w.x = cvtpk(v[0], v[1]); w.y = cvtpk(v[2], v[3]); w.z = cvtpk(v[4], v[5]); w.w = cvtpk(v[6], v[7]);
            ((u32x4*)(A.ws + SSM_VF))[r] = w;
        }
    }
}

constexpr int SS_KF = 0, SS_UB = 65536, SS_S = 131072, SS_XP = 147456;
__device__ __forceinline__ void ssm_unit(Frame& F, const Args& A, int b, int g) {
    const bf16_t* qkvu = (const bf16_t*)(A.ws + WS_ARENA); bf16_t* hbuf = (bf16_t*)(A.ws + WS_H);
    const int lane = F.lane, w = F.wave, fr = lane & 15, kq = lane >> 4;
    LAS unsigned char* L = F.lds;
    const u32x4* kfsrc = (const u32x4*)(A.ws + SSM_KF) + (size_t)g * 4096;
#pragma unroll
    for (int i = 0; i < 8; ++i) { const int idx = F.tid + i * NTHR; *(LAS u32x4*)(L + SS_KF + idx * 16) = kfsrc[idx]; }
#pragma unroll
    for (int i = 0; i < 8; ++i) { const int idx = F.tid + i * NTHR; const int ln = idx & 63, nt = (idx >> 6) & 1, js = idx >> 7;
        const int c = 16 * nt + (ln & 15), q4 = ln >> 4, tok = 64 * c + 2 * js + (q4 >> 1);
        *(LAS u32x4*)(L + SS_UB + idx * 16) = *(const u32x4*)(qkvu + (size_t)(b * SEQ + tok) * 2048 + 1536 + 16 * g + (q4 & 1) * 8); }
    __syncthreads();
    {
        f32x4 a0 = {0.f, 0.f, 0.f, 0.f}, a1 = {0.f, 0.f, 0.f, 0.f};
        const bf16x8* wf = (const bf16x8*)(A.ws + SSM_WF) + ((size_t)(g * 8 + w) * 32) * 64 + lane;
#pragma unroll 4
        for (int js = 0; js < 32; ++js) {
            const bf16x8 af = wf[js * 64];
            const bf16x8 b0 = *(const LAS bf16x8*)(L + SS_UB + ((js * 2 + 0) * 64 + lane) * 16), b1 = *(const LAS bf16x8*)(L + SS_UB + ((js * 2 + 1) * 64 + lane) * 16);
            a0 = __builtin_amdgcn_mfma_f32_16x16x32_bf16(af, b0, a0, 0, 0, 0); a1 = __builtin_amdgcn_mfma_f32_16x16x32_bf16(af, b1, a1, 0, 0, 0);
        }
        LAS float* S = (LAS float*)(L + SS_S);
#pragma unroll
        for (int r = 0; r < 4; ++r) { S[(16 * w + 4 * kq + r) * 32 + fr] = a0[r]; S[(16 * w + 4 * kq + r) * 32 + 16 + fr] = a1[r]; }
    }
    __syncthreads();
    if (w == 0) {
        const f32x2 a64 = ((const f32x2*)(A.ws + WS_APOW))[(g * 64 + lane) * 65 + 64];
        const LAS float* S = (const LAS float*)(L + SS_S); LAS bf16_t* Xp = (LAS bf16_t*)(L + SS_XP);
        float xr = 0.f, xi = 0.f;
        for (int c = 0; c < 32; ++c) {
            const unsigned pk = cvtpk(xr, xi);
            Xp[c * 128 + lane] = (bf16_t)(pk & 0xffffu); Xp[c * 128 + 64 + lane] = (bf16_t)(pk >> 16);
            const float sr = S[lane * 32 + c], si = S[(64 + lane) * 32 + c];
            const float nr = a64[0] * xr - a64[1] * xi + sr, ni = a64[0] * xi + a64[1] * xr + si;
            xr = nr; xi = ni;
        }
    }
    __syncthreads();
    const float* dsk = A.in[I_SSMD] + 16 * g + 4 * kq;
    const f32x4 dv = *(const f32x4*)dsk;
    for (int ii = 0; ii < 8; ++ii) {
        const int i = w + 8 * ii;
        f32x4 a0 = {0.f, 0.f, 0.f, 0.f}, a1 = {0.f, 0.f, 0.f, 0.f};
        const bf16x8* vf = (const bf16x8*)(A.ws + SSM_VF) + ((size_t)(g * 64 + i) * 4) * 64 + lane;
#pragma unroll
        for (int ks = 0; ks < 4; ++ks) {
            const bf16x8 af = vf[ks * 64];
            const bf16x8 b0 = *(const LAS bf16x8*)(L + SS_XP + (fr * 128 + 32 * ks + 8 * kq) * 2), b1 = *(const LAS bf16x8*)(L + SS_XP + ((16 + fr) * 128 + 32 * ks + 8 * kq) * 2);
            a0 = __builtin_amdgcn_mfma_f32_16x16x32_bf16(af, b0, a0, 0, 0, 0); a1 = __builtin_amdgcn_mfma_f32_16x16x32_bf16(af, b1, a1, 0, 0, 0);
        }
        const int njs = (i >> 1) + 1;
        for (int js = 0; js < njs; ++js) {
            const bf16x8 af = *(const LAS bf16x8*)(L + SS_KF + ((i - 2 * js) * 64 + lane) * 16);
            const bf16x8 b0 = *(const LAS bf16x8*)(L + SS_UB + ((js * 2 + 0) * 64 + lane) * 16), b1 = *(const LAS bf16x8*)(L + SS_UB + ((js * 2 + 1) * 64 + lane) * 16);
            a0 = __builtin_amdgcn_mfma_f32_16x16x32_bf16(af, b0, a0, 0, 0, 0); a1 = __builtin_amdgcn_mfma_f32_16x16x32_bf16(af, b1, a1, 0, 0, 0);
        }
#pragma unroll
        for (int nt = 0; nt < 2; ++nt) {
            const f32x4 acc = nt ? a1 : a0; const int tok = 64 * (16 * nt + fr) + i; const size_t row = (size_t)(b * SEQ + tok);
            const u32x2 uu = *(const u32x2*)(qkvu + row * 2048 + 1536 + 16 * g + 4 * kq);
            const float y0 = acc[0] + dv[0] * bf_lo(uu.x), y1 = acc[1] + dv[1] * bf_hi(uu.x), y2 = acc[2] + dv[2] * bf_lo(uu.y), y3 = acc[3] + dv[3] * bf_hi(uu.y);
            u32x2 o; o.x = cvtpk(gelu_tanh(y0), gelu_tanh(y1)); o.y = cvtpk(gelu_tanh(y2), gelu_tanh(y3));
            *(u32x2*)(hbuf + row * 512 + 16 * g + 4 * kq) = o;
        }
    }
}

__device__ __forceinline__ int crow(int r, int hi) { return (r & 3) + 8 * (r >> 2) + 4 * hi; }
__device__ __forceinline__ void qkt_tile(f32x16& p0, f32x16& p1, const LAS unsigned char* Ks, const bf16x8 (&qr)[4], int r32, int hi) {
    const LAS unsigned char* kb = Ks + hi * 1024 + r32 * 16;
    p0 = (f32x16){}; p1 = (f32x16){};
#pragma unroll
    for (int d0 = 0; d0 < 4; ++d0) {
        const bf16x8 b0 = *(const LAS bf16x8*)(kb + d0 * 2048), b1 = *(const LAS bf16x8*)(kb + d0 * 2048 + 512);
        p0 = __builtin_amdgcn_mfma_f32_32x32x16_bf16(b0, qr[d0], p0, 0, 0, 0); p1 = __builtin_amdgcn_mfma_f32_32x32x16_bf16(b1, qr[d0], p1, 0, 0, 0);
    }
}
__device__ __forceinline__ s16x4 vtr(const LAS unsigned char* p) { typedef short v4i16_t __attribute__((ext_vector_type(4))); return __builtin_bit_cast(s16x4, __builtin_amdgcn_ds_read_tr16_b64_v4i16((LAS v4i16_t*)p)); }
__device__ __forceinline__ void pv_tile(f32x16 (&o)[2], const LAS unsigned char* Vs, const f32x16& p0, const f32x16& p1, int lane) {
    const int hi = lane >> 5;
    const LAS unsigned char* vb = Vs + ((lane >> 4) & 1) * 32 + (lane & 3) * 8 + (4 * hi + ((lane & 15) >> 2)) * 64;
    u32x4 pw[4];
#pragma unroll
    for (int s = 0; s < 2; ++s) {
        pw[s] = (u32x4){cvtpk(p0[8 * s], p0[8 * s + 1]), cvtpk(p0[8 * s + 2], p0[8 * s + 3]), cvtpk(p0[8 * s + 4], p0[8 * s + 5]), cvtpk(p0[8 * s + 6], p0[8 * s + 7])};
        pw[2 + s] = (u32x4){cvtpk(p1[8 * s], p1[8 * s + 1]), cvtpk(p1[8 * s + 2], p1[8 * s + 3]), cvtpk(p1[8 * s + 4], p1[8 * s + 5]), cvtpk(p1[8 * s + 6], p1[8 * s + 7])};
    }
#pragma unroll
    for (int d0 = 0; d0 < 2; ++d0)
#pragma unroll
        for (int ks = 0; ks < 4; ++ks) {
            const s16x4 lo = vtr(vb + d0 * 4096 + ks * 1024), hh = vtr(vb + d0 * 4096 + ks * 1024 + 512);
            const bf16x8 vf = (bf16x8){lo[0], lo[1], lo[2], lo[3], hh[0], hh[1], hh[2], hh[3]};
            o[d0] = __builtin_amdgcn_mfma_f32_32x32x16_bf16(__builtin_bit_cast(bf16x8, pw[ks]), vf, o[d0], 0, 0, 0);
        }
}
__device__ __forceinline__ void kv_load(u32x4& kreg, u32x4& vreg, const bf16_t* Kbase, const bf16_t* Vbase, int pitch, int key0, int wave, int lane) {
    kreg = *(const u32x4*)(Kbase + (size_t)(key0 + lane) * pitch + wave * 8);
    vreg = *(const u32x4*)(Vbase + (size_t)(key0 + 16 * (wave & 3) + (lane >> 2)) * pitch + (wave >> 2) * 32 + (lane & 3) * 8);
}
__device__ __forceinline__ void kv_store(LAS unsigned char* Ks, LAS unsigned char* Vs, const u32x4& kreg, const u32x4& vreg, int wave, int lane) {
    *(LAS u32x4*)(Ks + wave * 1024 + lane * 16) = kreg; *(LAS u32x4*)(Vs + wave * 1024 + lane * 16) = vreg;
}
__device__ __forceinline__ void o_store(const f32x16 (&o)[2], bf16_t* dst, int pitch, int lane) {
    const int hi = lane >> 5, c = lane & 31;
#pragma unroll
    for (int d0 = 0; d0 < 2; ++d0)
#pragma unroll
        for (int r = 0; r < 16; ++r) { const unsigned pk = cvtpk(o[d0][r], 0.f); dst[(size_t)crow(r, hi) * pitch + 32 * d0 + c] = (bf16_t)(pk & 0xffffu); }
}

constexpr int AT_K = 0, AT_V = 8192;
__device__ __forceinline__ void sb_unit(Frame& F, const Args& A, int b, int h, int qb) {
    const bf16_t* qkvu = (const bf16_t*)(A.ws + WS_ARENA); bf16_t* cat = (bf16_t*)(A.ws + WS_CAT);
    const int lane = F.lane, w = F.wave, r32 = lane & 31, hi = lane >> 5;
    const int t0 = qb * 256, trow = t0 + 32 * w + r32;
    const bf16_t* Qp = qkvu + (size_t)(b * SEQ + trow) * 2048 + h * 64 + hi * 8;
    const bf16_t* Kb = qkvu + (size_t)(b * SEQ) * 2048 + 512 + h * 64; const bf16_t* Vb = qkvu + (size_t)(b * SEQ) * 2048 + 1024 + h * 64;
    bf16x8 qr[4];
#pragma unroll
    for (int d0 = 0; d0 < 4; ++d0) qr[d0] = *(const bf16x8*)(Qp + 16 * d0);
    f32x16 o[2]; o[0] = (f32x16){}; o[1] = (f32x16){};
    float carry = 0.f;
    LAS unsigned char* Ks = F.lds + AT_K; LAS unsigned char* Vs = F.lds + AT_V;
    u32x4 kreg, vreg;
    const int kt_hi = 4 * qb + 3;
    kv_load(kreg, vreg, Kb, Vb, 2048, 64 * kt_hi, w, lane);
    for (int kt = kt_hi; kt >= 0; --kt) {
        __syncthreads();
        kv_store(Ks, Vs, kreg, vreg, w, lane);
        if (kt > 0) kv_load(kreg, vreg, Kb, Vb, 2048, 64 * (kt - 1), w, lane);
        __syncthreads();
        if (64 * kt <= t0 + 32 * w + 30) {
            f32x16 p0, p1; qkt_tile(p0, p1, Ks, qr, r32, hi);
            float l0[16], l1[16];
#pragma unroll
            for (int r = 0; r < 16; ++r) {
                const int kv = 64 * kt + crow(r, hi);
                { const float z = p0[r] * 0.125f; const float sp = fmaxf(z, 0.f) + 0.6931471805599453f * __builtin_amdgcn_logf(1.0f + fast_exp(-fabsf(z))); const bool ok = kv < trow; l0[r] = ok ? -sp : 0.f; p0[r] = ok ? (z - sp) : -1.0e30f; }
                { const float z = p1[r] * 0.125f; const float sp = fmaxf(z, 0.f) + 0.6931471805599453f * __builtin_amdgcn_logf(1.0f + fast_exp(-fabsf(z))); const bool ok = (kv + 32) < trow; l1[r] = ok ? -sp : 0.f; p1[r] = ok ? (z - sp) : -1.0e30f; }
            }
            float gs[8], og[8];
#pragma unroll
            for (int rg = 0; rg < 4; ++rg) { gs[rg] = (l0[4 * rg] + l0[4 * rg + 1]) + (l0[4 * rg + 2] + l0[4 * rg + 3]); gs[4 + rg] = (l1[4 * rg] + l1[4 * rg + 1]) + (l1[4 * rg + 2] + l1[4 * rg + 3]); }
#pragma unroll
            for (int k = 0; k < 8; ++k) og[k] = __shfl_xor(gs[k], 32);
            float sfx[8]; float run = 0.f;
#pragma unroll
            for (int k = 7; k >= 0; --k) {
                const float g_even = hi ? og[k] : gs[k], g_odd = hi ? gs[k] : og[k];
                const float s_odd = run; run += g_odd; const float s_even = run; run += g_even;
                sfx[k] = hi ? s_odd : s_even;
            }
#pragma unroll
            for (int rg = 0; rg < 4; ++rg) {
                { const float base = carry + sfx[rg]; const float a3 = base, a2 = a3 + l0[4 * rg + 3], a1 = a2 + l0[4 * rg + 2], a0 = a1 + l0[4 * rg + 1];
                  p0[4 * rg] = fast_exp(p0[4 * rg] + a0); p0[4 * rg + 1] = fast_exp(p0[4 * rg + 1] + a1); p0[4 * rg + 2] = fast_exp(p0[4 * rg + 2] + a2); p0[4 * rg + 3] = fast_exp(p0[4 * rg + 3] + a3); }
                { const float base = carry + sfx[4 + rg]; const float a3 = base, a2 = a3 + l1[4 * rg + 3], a1 = a2 + l1[4 * rg + 2], a0 = a1 + l1[4 * rg + 1];
                  p1[4 * rg] = fast_exp(p1[4 * rg] + a0); p1[4 * rg + 1] = fast_exp(p1[4 * rg + 1] + a1); p1[4 * rg + 2] = fast_exp(p1[4 * rg + 2] + a2); p1[4 * rg + 3] = fast_exp(p1[4 * rg + 3] + a3); }
            }
            carry += run;
            pv_tile(o, Vs, p0, p1, lane);
        }
    }
    o_store(o, cat + (size_t)(b * SEQ + t0 + 32 * w) * 1024 + h * 64, 1024, lane);
}

__device__ __forceinline__ void l0_mixer_phase(Frame& F, const Args& A, int qid) {
    for (int u = blockIdx.x; u < 256; u += F.G) { __syncthreads(); ssm_unit(F, A, u >> 5, u & 31); }
    for (;;) {
        const int t = q_next(F, qid);
        if (t >= 512) break;
        sb_unit(F, A, (t & 63) >> 3, t & 7, 7 - (t >> 6));
    }
}

__device__ __forceinline__ void nsa_small_tables(Frame& F, const Args& A) {
    const int gt = F.vcu * NTHR + F.tid, NGT = F.G * NTHR;
    float* rc = (float*)(A.ws + WS_ROPE); float* rs = rc + 2048 * 32;
    for (int it = gt; it < 2048 * 32; it += NGT) {
        const int pos = it >> 5, i = it & 31;
        const double inv = exp(-9.210340371976182736 * (double)i / 32.0);
        double th = (double)pos * inv; th -= 6.283185307179586476925 * rint(th * 0.15915494309189533577);
        rc[it] = (float)cos(th); rs[it] = (float)sin(th);
    }
    float* cb = (float*)(A.ws + WS_CBIAS);
    for (int it = gt; it < 512; it += NGT) {
        const int kv = it >> 8, n = it & 255; const float* pos = A.in[kv ? I_CPV : I_CPK]; const float* w1 = A.in[kv ? I_CW1V : I_CW1K];
        float s = 0.f;
        for (int kk = 0; kk < 2048; ++kk) s += pos[kk] * w1[(size_t)kk * 256 + n];
        cb[it] = s;
    }
    bf16_t* w2t = (bf16_t*)(A.ws + WS_CW2T);
    for (int it = gt; it < 2 * 64 * 256; it += NGT) {
        const int kv = it >> 14, n = (it >> 8) & 63, k = it & 255; const float* w2 = A.in[kv ? I_CW2V : I_CW2K];
        w2t[it] = (bf16_t)(cvtpk(w2[k * 64 + n], 0.f) & 0xffffu);
    }
}

constexpr int CP_A = 0, CP_B = 2 * 64 * 144, CP_H = CP_B + 2 * 256 * 144;
__device__ __forceinline__ void cmp_unit(Frame& F, const Args& A, int kv, int rb) {
    const bf16_t* proj = (const bf16_t*)(A.ws + WS_ARENA);
    const bf16_t* w1t = (const bf16_t*)(A.ws + WS_CW1T) + (size_t)kv * 256 * 2048;
    const bf16_t* w2t = (const bf16_t*)(A.ws + WS_CW2T) + kv * 64 * 256;
    const float* cb = (const float*)(A.ws + WS_CBIAS) + kv * 256;
    bf16_t* outp = (bf16_t*)(A.ws + WS_KCMP) + (size_t)kv * (8 * 4 * 128 * 64);
    const int lane = F.lane, w = F.wave, fr = lane & 15, kq = lane >> 4, tid = F.tid;
    LAS unsigned char* L = F.lds;
    const int arow = tid >> 3, ach = tid & 7;
    const int R = rb * 64 + arow, ab = R >> 9, am = (R >> 2) & 127, ag = R & 3;
    const bf16_t* asrc = proj + (size_t)(ab * SEQ + 16 * am) * 2560 + (kv ? 1280 : 1024) + ag * 64 + ach * 8;
    const bf16_t* bsrc = w1t + (size_t)(tid >> 3) * 2048 + ach * 8;
    u32x4 areg, breg[4];
    areg = *(const u32x4*)asrc;
#pragma unroll
    for (int i = 0; i < 4; ++i) breg[i] = *(const u32x4*)(bsrc + (size_t)i * 64 * 2048);
    f32x4 acc[4][2];
#pragma unroll
    for (int m = 0; m < 4; ++m) { acc[m][0] = (f32x4){0.f, 0.f, 0.f, 0.f}; acc[m][1] = (f32x4){0.f, 0.f, 0.f, 0.f}; }
    for (int l = 0; l < 32; ++l) {
        const int buf = l & 1;
        *(LAS u32x4*)(L + CP_A + buf * 9216 + arow * 144 + ach * 16) = areg;
#pragma unroll
        for (int i = 0; i < 4; ++i) *(LAS u32x4*)(L + CP_B + buf * 36864 + ((tid >> 3) + 64 * i) * 144 + ach * 16) = breg[i];
        if (l < 31) { areg = *(const u32x4*)(asrc + (size_t)(l + 1) * 2560);
#pragma unroll
            for (int i = 0; i < 4; ++i) breg[i] = *(const u32x4*)(bsrc + (size_t)i * 64 * 2048 + (l + 1) * 64); }
        __syncthreads();
#pragma unroll
        for (int ks = 0; ks < 2; ++ks) {
            bf16x8 af[4], bfv[2];
#pragma unroll
            for (int m = 0; m < 4; ++m) af[m] = *(const LAS bf16x8*)(L + CP_A + buf * 9216 + (16 * m + fr) * 144 + (32 * ks + 8 * kq) * 2);
#pragma unroll
            for (int n = 0; n < 2; ++n) bfv[n] = *(const LAS bf16x8*)(L + CP_B + buf * 36864 + (32 * w + 16 * n + fr) * 144 + (32 * ks + 8 * kq) * 2);
#pragma unroll
            for (int m = 0; m < 4; ++m)
#pragma unroll
                for (int n = 0; n < 2; ++n) acc[m][n] = __builtin_amdgcn_mfma_f32_16x16x32_bf16(bfv[n], af[m], acc[m][n], 0, 0, 0);
        }
    }
    __syncthreads();
#pragma unroll
    for (int m = 0; m < 4; ++m)
#pragma unroll
        for (int n = 0; n < 2; ++n) { const int col = 32 * w + 16 * n + 4 * kq; const f32x4 bv = *(const f32x4*)(cb + col); const f32x4 v = acc[m][n] + bv;
            u32x2 o; o.x = cvtpk(gelu_tanh(v[0]), gelu_tanh(v[1])); o.y = cvtpk(gelu_tanh(v[2]), gelu_tanh(v[3]));
            *(LAS u32x2*)(L + CP_H + ((16 * m + fr) * 264 + col) * 2) = o; }
    __syncthreads();
    {
        const int rt = w >> 1, c0 = w & 1;
        f32x4 o0 = {0.f, 0.f, 0.f, 0.f}, o1 = {0.f, 0.f, 0.f, 0.f};
#pragma unroll
        for (int ks = 0; ks < 8; ++ks) {
            const bf16x8 af = *(const LAS bf16x8*)(L + CP_H + ((16 * rt + fr) * 264 + 32 * ks + 8 * kq) * 2);
            const bf16x8 b0 = *(const bf16x8*)(w2t + (16 * c0 + fr) * 256 + 32 * ks + 8 * kq), b1 = *(const bf16x8*)(w2t + (16 * (c0 + 2) + fr) * 256 + 32 * ks + 8 * kq);
            o0 = __builtin_amdgcn_mfma_f32_16x16x32_bf16(af, b0, o0, 0, 0, 0); o1 = __builtin_amdgcn_mfma_f32_16x16x32_bf16(af, b1, o1, 0, 0, 0);
        }
        const float* rc = (const float*)(A.ws + WS_ROPE); const float* rs = rc + 2048 * 32;
#pragma unroll
        for (int r = 0; r < 4; ++r) {
            const int Rr = rb * 64 + 16 * rt + 4 * kq + r, b = Rr >> 9, m = (Rr >> 2) & 127, g = Rr & 3, d = 16 * c0 + fr;
            float x1 = o0[r], x2 = o1[r];
            if (kv == 0) { const int pos = (16 * m + 31) & 2047; const float c = rc[pos * 32 + d], s = rs[pos * 32 + d]; const float y1 = x1 * c - x2 * s, y2 = x1 * s + x2 * c; x1 = y1; x2 = y2; }
            if (m == 127) { x1 = 0.f; x2 = 0.f; }
            bf16_t* op = outp + ((size_t)((b * 4 + g) * 128 + m)) * 64;
            op[d] = (bf16_t)(cvtpk(x1, 0.f) & 0xffffu); op[d + 32] = (bf16_t)(cvtpk(x2, 0.f) & 0xffffu);
        }
    }
}

constexpr int NA_K = 0, NA_V = 16384, NA_GS = 32768, NA_LS = 40960, NA_MASK = 49152, NA_WSF = 49152 + 512, NA_OR = NA_WSF + 1024;
__device__ __forceinline__ float half_max(float v) { return fmaxf(v, __shfl_xor(v, 32)); }
__device__ __forceinline__ float half_sum(float v) { return v + __shfl_xor(v, 32); }
__device__ __forceinline__ float tile_max(const f32x16& p0, const f32x16& p1) {
    float a = fmaxf(p0[0], p1[0]);
#pragma unroll
    for (int r = 1; r < 16; ++r) a = fmaxf(a, fmaxf(p0[r], p1[r]));
    return half_max(a);
}
__device__ __forceinline__ float tile_sum(const f32x16& p0, const f32x16& p1) {
    float a = 0.f, b = 0.f;
#pragma unroll
    for (int r = 0; r < 16; ++r) { a += p0[r]; b += p1[r]; }
    return half_sum(a + b);
}
__device__ __forceinline__ void o_rows_mul(f32x16 (&o)[2], LAS float* wsf, float f, int r32, int hi) {
    if (hi == 0) wsf[r32] = f;
    LDS_WAIT();
#pragma unroll
    for (int r = 0; r < 16; ++r) { const float fr_ = wsf[crow(r, hi)]; o[0][r] *= fr_; o[1][r] *= fr_; }
    LDS_WAIT();
}
__device__ __forceinline__ void o_rows_fma(f32x16 (&ot)[2], const f32x16 (&o)[2], LAS float* wsf, float f, int r32, int hi) {
    if (hi == 0) wsf[r32] = f;
    LDS_WAIT();
#pragma unroll
    for (int r = 0; r < 16; ++r) { const float fr_ = wsf[crow(r, hi)]; ot[0][r] += o[0][r] * fr_; ot[1][r] += o[1][r] * fr_; }
    LDS_WAIT();
}
template <class MaskF>
__device__ __forceinline__ void flash_step(f32x16 (&o)[2], float& m_run, float& l_run, f32x16& p0, f32x16& p1, const MaskF& ok, LAS float* wsf, const LAS unsigned char* Vs, int lane, int r32, int hi) {
#pragma unroll
    for (int r = 0; r < 16; ++r) { p0[r] = ok(r, 0) ? p0[r] : -1.0e30f; p1[r] = ok(r, 1) ? p1[r] : -1.0e30f; }
    const float mx = tile_max(p0, p1), m_new = fmaxf(m_run, mx), alpha = fast_exp(m_run - m_new);
#pragma unroll
    for (int r = 0; r < 16; ++r) { p0[r] = ok(r, 0) ? fast_exp(p0[r] - m_new) : 0.f; p1[r] = ok(r, 1) ? fast_exp(p1[r] - m_new) : 0.f; }
    l_run = l_run * alpha + tile_sum(p0, p1); m_run = m_new;
    o_rows_mul(o, wsf, alpha, r32, hi);
    pv_tile(o, Vs, p0, p1, lane);
}

__device__ __forceinline__ void nsa_unit(Frame& F, const Args& A, int b, int g, int qt) {
    const bf16_t* proj = (const bf16_t*)(A.ws + WS_ARENA); bf16_t* cat = (bf16_t*)(A.ws + WS_CAT);
    const bf16_t* kc = (const bf16_t*)(A.ws + WS_KCMP) + (size_t)((b * 4 + g) * 128) * 64; const bf16_t* vc = kc + (size_t)(8 * 4 * 128 * 64);
    const float* gate = (const float*)(A.ws + WS_GATE);
    const int lane = F.lane, w = F.wave, r32 = lane & 31, hi = lane >> 5, tid = F.tid;
    const int t0 = qt * 64, tl = r32 >> 2, hr = r32 & 3, tok = t0 + 8 * w + tl;
    const size_t qrow = (size_t)(b * SEQ + tok);
    LAS unsigned char* L = F.lds;
    LAS float* wsf = (LAS float*)(L + NA_WSF) + w * 32;
    bf16x8 qr[4];
#pragma unroll
    for (int d0 = 0; d0 < 4; ++d0) qr[d0] = *(const bf16x8*)(proj + qrow * 2560 + (g * 4 + hr) * 64 + 16 * d0 + 8 * hi);
    const float g0 = gate[qrow * 48 + (g * 4 + hr) * 3 + 0], g1 = gate[qrow * 48 + (g * 4 + hr) * 3 + 1], g2 = gate[qrow * 48 + (g * 4 + hr) * 3 + 2];
    f32x16 ot[2]; ot[0] = (f32x16){}; ot[1] = (f32x16){};
    u32x4 kreg, vreg;
    const bool two = t0 >= 1024;
    __syncthreads();
    kv_load(kreg, vreg, kc, vc, 64, 0, w, lane); kv_store(L + NA_K, L + NA_V, kreg, vreg, w, lane);
    if (two) { kv_load(kreg, vreg, kc, vc, 64, 64, w, lane); kv_store(L + NA_K + 8192, L + NA_V + 8192, kreg, vreg, w, lane); }
    __syncthreads();
    {
        f32x16 pa0, pa1, pb0, pb1; pb0 = (f32x16){}; pb1 = (f32x16){};
        qkt_tile(pa0, pa1, L + NA_K, qr, r32, hi);
        if (two) qkt_tile(pb0, pb1, L + NA_K + 8192, qr, r32, hi);
        const int mv = tok >= 31 ? ((tok - 31) >> 4) : -1;
        float mx = -1.0e30f;
#pragma unroll
        for (int r = 0; r < 16; ++r) { const int m = crow(r, hi);
            pa0[r] = (m <= mv) ? pa0[r] : -1.0e30f; pa1[r] = (m + 32 <= mv) ? pa1[r] : -1.0e30f; pb0[r] = (m + 64 <= mv) ? pb0[r] : -1.0e30f; pb1[r] = (m + 96 <= mv) ? pb1[r] : -1.0e30f;
            mx = fmaxf(fmaxf(mx, fmaxf(pa0[r], pa1[r])), fmaxf(pb0[r], pb1[r])); }
        mx = half_max(mx);
        float sum = 0.f;
#pragma unroll
        for (int r = 0; r < 16; ++r) { const int m = crow(r, hi);
            pa0[r] = (m <= mv) ? fast_exp(pa0[r] - mx) : 0.f; pa1[r] = (m + 32 <= mv) ? fast_exp(pa1[r] - mx) : 0.f; pb0[r] = (m + 64 <= mv) ? fast_exp(pb0[r] - mx) : 0.f; pb1[r] = (m + 96 <= mv) ? fast_exp(pb1[r] - mx) : 0.f;
            sum += (pa0[r] + pa1[r]) + (pb0[r] + pb1[r]); }
        sum = half_sum(sum);
        const float inv = sum > 0.f ? 1.0f / sum : 0.f;
#pragma unroll
        for (int r = 0; r < 16; ++r) { pa0[r] *= inv; pa1[r] *= inv; pb0[r] *= inv; pb1[r] *= inv; }
        LAS float* Gs = (LAS float*)(L + NA_GS); LAS float* Ls = (LAS float*)(L + NA_LS);
#pragma unroll
        for (int rg = 0; rg < 4; ++rg) {
            float gv[4], lv[4];
            gv[0] = (pa0[4 * rg] + pa0[4 * rg + 1]) + (pa0[4 * rg + 2] + pa0[4 * rg + 3]); lv[0] = pa0[4 * rg + 3];
            gv[1] = (pa1[4 * rg] + pa1[4 * rg + 1]) + (pa1[4 * rg + 2] + pa1[4 * rg + 3]); lv[1] = pa1[4 * rg + 3];
            gv[2] = (pb0[4 * rg] + pb0[4 * rg + 1]) + (pb0[4 * rg + 2] + pb0[4 * rg + 3]); lv[2] = pb0[4 * rg + 3];
            gv[3] = (pb1[4 * rg] + pb1[4 * rg + 1]) + (pb1[4 * rg + 2] + pb1[4 * rg + 3]); lv[3] = pb1[4 * rg + 3];
#pragma unroll
            for (int k = 0; k < 4; ++k) { gv[k] += __shfl_xor(gv[k], 1); gv[k] += __shfl_xor(gv[k], 2); lv[k] += __shfl_xor(lv[k], 1); lv[k] += __shfl_xor(lv[k], 2);
                if (hr == 0) { const int np = 8 * k + 2 * rg + hi; Gs[(8 * w + tl) * 32 + np] = gv[k]; Ls[(8 * w + tl) * 32 + np] = lv[k]; } }
        }
#pragma unroll
        for (int r = 0; r < 16; ++r) { pa0[r] *= g0; pa1[r] *= g0; pb0[r] *= g0; pb1[r] *= g0; }
        pv_tile(ot, L + NA_V, pa0, pa1, lane);
        if (two) pv_tile(ot, L + NA_V + 8192, pb0, pb1, lane);
    }
    __syncthreads();
    if (tid < 64) {
        const LAS float* Gs = (const LAS float*)(L + NA_GS) + tid * 32; const LAS float* Ls = (const LAS float*)(L + NA_LS) + tid * 32;
        const int t = t0 + tid, cur = t >> 6;
        float sc[32];
#pragma unroll
        for (int n = 0; n < 32; ++n) { const float imp = Gs[n] + (n > 0 ? Ls[n - 1] : 0.f); const bool forced = (n == 0) || (n == cur) || (n == cur - 1);
            sc[n] = (n <= cur) ? (imp + (forced ? 1.0e4f : 0.f)) : -1.0e30f; }
        unsigned mask = 0u;
        for (int k = 0; k < 8; ++k) {
            float best = -3.0e38f; int bi = 0;
#pragma unroll
            for (int n = 0; n < 32; ++n) { const bool take = sc[n] > best; best = take ? sc[n] : best; bi = take ? n : bi; }
            if (bi <= cur) mask |= 1u << bi;
#pragma unroll
            for (int n = 0; n < 32; ++n) sc[n] = (n == bi) ? -3.0e38f : sc[n];
        }
        ((LAS unsigned*)(L + NA_MASK))[tid] = mask;
    }
    __syncthreads();
    const unsigned mymask = ((const LAS unsigned*)(L + NA_MASK))[8 * w + tl];
    unsigned ormask = 0u;
    { const LAS unsigned* mk = (const LAS unsigned*)(L + NA_MASK);
#pragma unroll 8
      for (int i = 0; i < 64; ++i) ormask |= mk[i]; }
    ormask = (unsigned)__builtin_amdgcn_readfirstlane((int)ormask);
    {
        const bf16_t* Kb = proj + (size_t)(b * SEQ) * 2560 + 1536 + g * 64; const bf16_t* Vb = proj + (size_t)(b * SEQ) * 2560 + 1792 + g * 64;
        f32x16 o[2]; o[0] = (f32x16){}; o[1] = (f32x16){}; float m_run = -1.0e30f, l_run = 0.f;
        for (int n = 0; n <= qt; ++n) {
            if (!((ormask >> n) & 1u)) continue;
            __syncthreads();
            kv_load(kreg, vreg, Kb, Vb, 2560, 64 * n, w, lane); kv_store(L + NA_K, L + NA_V, kreg, vreg, w, lane);
            __syncthreads();
            f32x16 p0, p1; qkt_tile(p0, p1, L + NA_K, qr, r32, hi);
            const bool sel = (mymask >> n) & 1u; const int kbase = 64 * n + 4 * hi;
            auto ok = [&](int r, int blk) { const int kvp = kbase + (r & 3) + 8 * (r >> 2) + 32 * blk; return sel && (kvp <= tok); };
            flash_step(o, m_run, l_run, p0, p1, ok, wsf, L + NA_V, lane, r32, hi);
        }
        o_rows_fma(ot, o, wsf, g1 / l_run, r32, hi);
    }
    {
        const bf16_t* Kb = proj + (size_t)(b * SEQ) * 2560 + 2048 + g * 64; const bf16_t* Vb = proj + (size_t)(b * SEQ) * 2560 + 2304 + g * 64;
        f32x16 o[2]; o[0] = (f32x16){}; o[1] = (f32x16){}; float m_run = -1.0e30f, l_run = 0.f;
        const int n_lo = qt >= 8 ? qt - 8 : 0;
        for (int n = n_lo; n <= qt; ++n) {
            __syncthreads();
            kv_load(kreg, vreg, Kb, Vb, 2560, 64 * n, w, lane); kv_store(L + NA_K, L + NA_V, kreg, vreg, w, lane);
            __syncthreads();
            f32x16 p0, p1; qkt_tile(p0, p1, L + NA_K, qr, r32, hi);
            const int kbase = 64 * n + 4 * hi;
            auto ok = [&](int r, int blk) { const int kvp = kbase + (r & 3) + 8 * (r >> 2) + 32 * blk; return (kvp <= tok) && (kvp > tok - 512); };
            flash_step(o, m_run, l_run, p0, p1, ok, wsf, L + NA_V, lane, r32, hi);
        }
        o_rows_fma(ot, o, wsf, g2 / l_run, r32, hi);
    }
#pragma unroll
    for (int d0 = 0; d0 < 2; ++d0)
#pragma unroll
        for (int r = 0; r < 16; ++r) { const int row = crow(r, hi); const size_t orow = (size_t)(b * SEQ + t0 + 8 * w + (row >> 2));
            cat[orow * 1024 + (g * 4 + (row & 3)) * 64 + 32 * d0 + r32] = (bf16_t)(cvtpk(ot[d0][r], 0.f) & 0xffffu); }
}

#ifndef PROBE_PHASE
#define PROBE_PHASE -1
#endif
#define REPS(k) ((PROBE_PHASE == (k)) ? 3 : 1)
constexpr int N_PHASES = 19;

__global__ void __launch_bounds__(NTHR, 2) mega_fwd(Args args) {
    extern __shared__ __attribute__((aligned(16))) unsigned char lds_raw[];
    Frame F;
    F.lds = (LAS unsigned char*)lds_raw;
    F.LC = (volatile LAS unsigned*)(F.lds + LDSCTL_OFF);
    F.tid = threadIdx.x; F.lane = F.tid & 63; F.wave = __builtin_amdgcn_readfirstlane(F.tid >> 6);
    F.G = gridDim.x; { const int bx = blockIdx.x; F.vcu = (F.G % 8 == 0) ? (bx % 8) * (F.G / 8) + bx / 8 : bx; }
    F.ctl = (unsigned*)(args.ws + WS_CTL);
    for (int u = F.tid; u < 256; u += NTHR) F.LC[u] = 0u;
    __syncthreads();
    XcdBarrier bar = xcd_barrier_post(F.ctl + CW_BAR, F.LC + LC_BAR);
    const int lo = args.ph_lo, hi = args.ph_hi;
#define IN(k) (lo <= (k) && (k) < hi)
#define SEAM(k) do { if (IN(k) && IN((k) + 1)) xcd_barrier(bar); } while (0)
    unsigned char* ws = args.ws;

#define PH(k, ...) do { if (IN(k)) { for (int rep_ = 0; rep_ < REPS(k); ++rep_) { __VA_ARGS__; if (rep_ + 1 < REPS(k)) xcd_barrier(bar); } } SEAM(k); } while (0)
    PH(0, { ssm_pow_tables(F, args); nsa_small_tables(F, args); p0_prologue(F, args); });
    PH(1, {
        ssm_frag_tables(F, args);
        pg8::Gemm g{(const bf16_t*)(ws + WS_H), (const bf16_t*)(ws + WS_W0T), 1024}; pg8::StaticOrder S; S.init(NTOK, 2048, F.G, (int)blockIdx.x);
        pg8::EpiBf16 E{(bf16_t*)(ws + WS_ARENA), 2048};
        pg8::gemm_phase(F.lds, g, S, E); });
    PH(2, { l0_mixer_phase(F, args, 2 * rep_); });
    PH(3, {
        pg8::Gemm g{(const bf16_t*)(ws + WS_H), (const bf16_t*)(ws + WS_WGLUT), 512}; pg8::StaticOrder S; S.init(NTOK, 512, F.G, (int)blockIdx.x);
        pg8::EpiGlu E{(const bf16_t*)(ws + WS_H), 512, (bf16_t*)(ws + WS_CAT) + 512, 1024};
        pg8::gemm_phase(F.lds, g, S, E); });
    PH(4, {
        pg8::Gemm g{(const bf16_t*)(ws + WS_CAT), (const bf16_t*)(ws + WS_WOUT0T), 1024}; pg8::StaticOrder S; S.init(NTOK, 1024, F.G, (int)blockIdx.x);
        pg8::EpiResid E{args.in[I_X], args.out, 1024};
        pg8::gemm_phase(F.lds, g, S, E); });
#define MOE_BLOCK(layer, pb) do { \
        PH(pb, { ln_a_phase(F, args, layer); }); \
        PH(pb + 1, { moe_gather_phase(F, args, layer); }); \
        PH(pb + 2, { \
            moe_prefix(F, layer); \
            pg8::Gemm g{(const bf16_t*)(ws + WS_ARENA), (const bf16_t*)(ws + WS_WEXP + layer * WEXP_LAYER), 1024}; \
            pg8::MoeOrder S{(const LAS int*)(F.LC + LC_TSTART), F.G, (int)blockIdx.x}; \
            pg8::EpiSwiGLU E{(bf16_t*)(ws + WS_H), DE}; \
            pg8::gemm_phase(F.lds, g, S, E); }); \
        PH(pb + 3, { \
            moe_prefix(F, layer); \
            pg8::Gemm g{(const bf16_t*)(ws + WS_H), (const bf16_t*)(ws + WS_WEXP + layer * WEXP_LAYER + WEXP_W2), 512}; \
            pg8::MoeOrder S{(const LAS int*)(F.LC + LC_TSTART), F.G, (int)blockIdx.x}; \
            pg8::EpiBf16 E{(bf16_t*)(ws + WS_ARENA), DM}; \
            pg8::gemm_phase(F.lds, g, S, E); }); \
        PH(pb + 4, { ln_b_phase(F, args, layer, layer == 0, true); }); \
    } while (0)
    MOE_BLOCK(0, 5);
    PH(10, {
        pg8::Gemm g{(const bf16_t*)(ws + WS_H), (const bf16_t*)(ws + WS_WIN1T), 1024}; pg8::StaticOrder S; S.init(NTOK, 2816, F.G, (int)blockIdx.x);
        pg8::EpiRope E{(bf16_t*)(ws + WS_ARENA), (float*)(ws + WS_GATE), (const float*)(ws + WS_ROPE), (const float*)(ws + WS_ROPE) + 2048 * 32};
        pg8::gemm_phase(F.lds, g, S, E); });
    PH(11, { for (int u = blockIdx.x; u < 128; u += F.G) { __syncthreads(); cmp_unit(F, args, u >> 6, u & 63); } });
    PH(12, { for (;;) { const int t = q_next(F, 1 + 2 * rep_); if (t >= 1024) break; nsa_unit(F, args, (t & 31) >> 2, t & 3, 31 - (t >> 5)); } });
    PH(13, {
        pg8::Gemm g{(const bf16_t*)(ws + WS_CAT), (const bf16_t*)(ws + WS_WOUT1T), 1024}; pg8::StaticOrder S; S.init(NTOK, 1024, F.G, (int)blockIdx.x);
        pg8::EpiResid E{args.out, args.out, 1024};
        pg8::gemm_phase(F.lds, g, S, E); });
    MOE_BLOCK(1, 14);
#undef IN
#undef SEAM
}

extern "C" void kernel_launch(void* const* d_in, const int* in_sizes, int n_in, void* d_out, int out_size, void* d_ws, size_t ws_size, hipStream_t stream) {
    static int grid = 0;
    if (grid == 0) {
        if (n_in != 36 || out_size != NTOK * DM || ws_size < WS_END) { fprintf(stderr, "kernel_launch: unexpected shapes (n_in %d out %d ws %zu)\n", n_in, out_size, ws_size); grid = -1; return; }
        int dev = 0, cus = 0, per_cu = 0;
        if (hipGetDevice(&dev) != hipSuccess || hipDeviceGetAttribute(&cus, hipDeviceAttributeMultiprocessorCount, dev) != hipSuccess) { grid = -1; return; }
        if (hipFuncSetAttribute((const void*)mega_fwd, hipFuncAttributeMaxDynamicSharedMemorySize, LDS_BYTES) != hipSuccess) { fprintf(stderr, "kernel_launch: hipFuncSetAttribute failed\n"); grid = -1; return; }
        if (hipOccupancyMaxActiveBlocksPerMultiprocessor(&per_cu, (const void*)mega_fwd, NTHR, LDS_BYTES) != hipSuccess || per_cu < 1) { fprintf(stderr, "kernel_launch: occupancy query says %d\n", per_cu); }
        (void)hipGetLastError();
        grid = cus;
    }
    if (grid < 0) return;
    (void)hipMemsetAsync((char*)d_ws + WS_CTL, 0, CTL_ZERO_BYTES, stream);
    Args a{};
    for (int i = 0; i < 36; ++i) a.in[i] = (const float*)d_in[i];
    a.out = (float*)d_out; a.ws = (unsigned char*)d_ws; a.ph_lo = 0; a.ph_hi = N_PHASES;
    hipLaunchKernelGGL(mega_fwd, dim3(grid), dim3(NTHR), LDS_BYTES, stream, a);
}
```

```cpp
#include <hip/hip_runtime.h>
#include <cstdio>
#include <cstdint>

#define GAS __attribute__((address_space(1)))
#define LAS __attribute__((address_space(3)))
typedef unsigned short bf16_t;
typedef short bf16x8 __attribute__((ext_vector_type(8)));
typedef short s16x4 __attribute__((ext_vector_type(4)));
typedef float f32x2 __attribute__((ext_vector_type(2)));
typedef float f32x4 __attribute__((ext_vector_type(4)));
typedef float f32x16 __attribute__((ext_vector_type(16)));
typedef unsigned u32x2 __attribute__((ext_vector_type(2)));
typedef unsigned u32x4 __attribute__((ext_vector_type(4)));
typedef int i32x4 __attribute__((ext_vector_type(4)));
typedef __bf16 bf16x2_t __attribute__((ext_vector_type(2)));

constexpr int NB = 8, SEQ = 2048, DM = 1024, NTOK = NB * SEQ;
constexpr int NE = 16, DE = 512;
constexpr float ALPHA = 1.41421356237309515f;
constexpr float LN_EPS = 1e-5f;
constexpr int NWAVES = 8, NTHR = 512;
constexpr int MOE_ROWS = 36864;

constexpr size_t MiB = 1u << 20;
constexpr size_t WS_CTL = 0, CTL_ZERO_BYTES = 1 * MiB;
constexpr size_t WS_MISC = 1 * MiB;
constexpr size_t WS_TOKES = WS_MISC;
constexpr size_t WS_TOKW = WS_TOKES + 256 * 1024;
constexpr size_t WS_TOKROW = WS_TOKW + 128 * 1024;
constexpr size_t WS_APOW = WS_MISC + 512 * 1024;
constexpr size_t WS_FTAB = WS_APOW + 1088 * 1024;
constexpr size_t WS_ROPE = WS_FTAB + 64 * 1024;
constexpr size_t WS_GATE = WS_ROPE + 512 * 1024;
constexpr size_t WS_KCMP = WS_GATE + 3 * MiB;
constexpr size_t WS_CBIAS = WS_KCMP + 1024 * 1024;
constexpr size_t WS_CW2T = WS_CBIAS + 256 * 1024;
constexpr size_t WS_SSMTAB = 9 * MiB;
constexpr size_t SSM_KF = WS_SSMTAB, SSM_WF = WS_SSMTAB + 2 * MiB, SSM_VF = WS_SSMTAB + 10 * MiB;
constexpr size_t WS_WDENSE = 27 * MiB;
constexpr size_t WS_W0T = WS_WDENSE;
constexpr size_t WS_WGLUT = WS_W0T + 4 * MiB;
constexpr size_t WS_WOUT0T = WS_WGLUT + 512 * 1024;
constexpr size_t WS_WIN1T = WS_WOUT0T + 2 * MiB;
constexpr size_t WS_WOUT1T = WS_WIN1T + 5632 * 1024;
constexpr size_t WS_CW1T = WS_WOUT1T + 2 * MiB;
constexpr size_t WS_WEXP = 43 * MiB;
constexpr size_t WEXP_LAYER = 48 * MiB, WEXP_W2 = 32 * MiB;
constexpr size_t WS_ARENA = 139 * MiB;
constexpr size_t WS_CAT = 219 * MiB;
constexpr size_t WS_H = 251 * MiB;
constexpr size_t WS_END = 287 * MiB;
constexpr int CW_BAR = 4096;
constexpr int CW_CNT = 8192;
constexpr int CW_QUEUE = 16384;

constexpr int RING_BYTES = 131072;
constexpr int LDSCTL_OFF = 163840 - 1024;
constexpr int LC_BAR = 0;
constexpr int LC_Q = 4;
constexpr int LC_TSTART = 16;
constexpr int LDS_BYTES = 163840;

__device__ __forceinline__ unsigned cvtpk(float lo, float hi) { f32x2 v = {lo, hi}; bf16x2_t b = __builtin_convertvector(v, bf16x2_t); return __builtin_bit_cast(unsigned, b); }
__device__ __forceinline__ float bf_lo(unsigned u) { return __uint_as_float(u << 16); }
__device__ __forceinline__ float bf_hi(unsigned u) { return __uint_as_float(u & 0xffff0000u); }
#define DPPF(oldv, src, ctrl, rmask) __builtin_bit_cast(float, __builtin_amdgcn_update_dpp(__builtin_bit_cast(int, (float)(oldv)), __builtin_bit_cast(int, (float)(src)), (ctrl), (rmask), 0xF, false))
__device__ __forceinline__ float wave_sum(float v) {
    v += DPPF(0.f, v, 0xB1, 0xF); v += DPPF(0.f, v, 0x4E, 0xF); v += DPPF(0.f, v, 0x141, 0xF); v += DPPF(0.f, v, 0x140, 0xF);
    v += DPPF(0.f, v, 0x142, 0xA); v += DPPF(0.f, v, 0x143, 0xC);
    return __builtin_bit_cast(float, __builtin_amdgcn_readlane(__builtin_bit_cast(int, v), 63));
}
__device__ __forceinline__ float fast_exp(float x) { return __builtin_amdgcn_exp2f(x * 1.4426950408889634f); }
__device__ __forceinline__ float fast_sigmoid(float x) { return __builtin_amdgcn_rcpf(1.0f + fast_exp(-x)); }
__device__ __forceinline__ float gelu_tanh(float x) {
    const float u = 0.7978845608028654f * (x + 0.044715f * x * x * x);
    return x * fast_sigmoid(2.0f * u);
}
#define LDS_WAIT() asm volatile("s_waitcnt lgkmcnt(0)" ::: "memory")
#define VM_WAIT() asm volatile("s_waitcnt vmcnt(0)" ::: "memory")
#define RLX_AGENT __ATOMIC_RELAXED, __HIP_MEMORY_SCOPE_AGENT

namespace pg8 {
constexpr int BM = 256, BK = 64, HALF = 128, HTB = HALF * BK * 2, STAGE_BYTES = 8 * HTB, NXCD = 8, WGM = 8;
__host__ __device__ __forceinline__ int lds_byte(int r, int c) { const int st = (r >> 4) * 2 + (c >> 5), rr = r & 15, cc = c & 31, ob = rr * 64 + cc * 2; return st * 1024 + (ob ^ (((ob >> 9) & 1) << 5)); }
__host__ __device__ __forceinline__ void stage_rc(int b, int& R, int& C) { const int st = b / 1024, sb = b % 1024, swz = sb ^ (((sb >> 9) & 1) << 5); R = (st >> 1) * 16 + swz / 64; C = (st & 1) * 32 + (swz % 64) / 2; }
__host__ __device__ __forceinline__ int perm32(int rho) { const int n = rho >> 4, i = rho & 15; return 8 * (i >> 2) + 4 * n + (i & 3); }

struct Unit { int pm, pn, pb; };
struct Gemm { const bf16_t* A; const bf16_t* Bt; int K; };

struct StaticOrder {
    int nM, nN, nwg, G, c;
    __device__ void init(int M, int N, int G_, int c_) { nM = M / BM; nN = N / BM; nwg = nM * nN; G = G_; c = c_; }
    __device__ bool next(int i, Unit& u) const {
        const long L = (long)i * G + c; if (L >= nwg) return false;
        int wgid = (int)L; { const int q = nwg / NXCD, r = nwg % NXCD, xcd = wgid % NXCD, off = wgid / NXCD; wgid = (xcd < r ? xcd * (q + 1) : r * (q + 1) + (xcd - r) * q) + off; }
        const int nig = WGM * nN, gid = wgid / nig, fm = gid * WGM, gsz = (nM - fm) < WGM ? (nM - fm) : WGM;
        u.pm = fm + ((wgid % nig) % gsz); u.pn = (wgid % nig) / gsz; u.pb = u.pn; return true;
    }
};
struct MoeOrder {
    const LAS int* tstart; int G, c;
    __device__ bool next(int i, Unit& u) const {
        const int total = tstart[16] * 4; const long L = (long)i * G + c; if (L >= total) return false;
        const int rt = (int)L >> 2, pn = (int)L & 3; int e = 0;
#pragma unroll
        for (int k = 1; k < 16; ++k) e += (rt >= tstart[k]) ? 1 : 0;
        u.pm = rt; u.pn = pn; u.pb = e * 4 + pn; return true;
    }
};

template <class Epi, class Sched>
__device__ __forceinline__ void gemm_phase(LAS unsigned char* lds, const Gemm g, const Sched& S, const Epi& E) {
    const int tid = threadIdx.x, wid = __builtin_amdgcn_readfirstlane(tid >> 6), lane = tid & 63, wr = wid >> 2, wc = wid & 3, fr = lane & 15, fq = lane >> 4;
    const int K = g.K, nt = K / BK;
    unsigned voffA[2], voffB[2];
#pragma unroll
    for (int i = 0; i < 2; ++i) { int R, C; stage_rc(tid * 16 + i * 8192, R, C); const int Rb = Epi::PERM ? ((R & ~31) + perm32(R & 31)) : R;
        voffA[i] = (unsigned)(R * K + C) * 2u; voffB[i] = (unsigned)(Rb * K + C) * 2u; }
    const size_t kstep = (size_t)(BK * 2);
    const size_t hstep = (size_t)HALF * K * 2;
    const size_t tstep = 2 * hstep;
    const unsigned ldsw = (unsigned)wid * 1024u;
    const int aoff = lds_byte(wr * 64 + fr, fq * 8), boff = lds_byte(wc * 32 + fr, fq * 8);
#define PG8_SA(b, h) (((b) * 2 + (h)) * HTB)
#define PG8_SB(b, h) ((4 + (b) * 2 + (h)) * HTB)
#define PG8_STAGE(bufoff, gbase, voff) do { _Pragma("unroll") for (int _i = 0; _i < 2; ++_i) \
        __builtin_amdgcn_global_load_lds((const unsigned*)((const char*)(gbase) + (voff)[_i]), (LAS unsigned*)(lds + (bufoff) + ldsw + _i * 8192), 16, 0, 0); } while (0)
#define PG8_LDA(dst, b, h) do { _Pragma("unroll") for (int m = 0; m < 4; ++m) _Pragma("unroll") for (int k = 0; k < 2; ++k) dst[m][k] = *(const LAS bf16x8*)(lds + PG8_SA(b, h) + aoff + m * 2048 + k * 1024); } while (0)
#define PG8_LDB(dst, b, h) do { _Pragma("unroll") for (int n = 0; n < 2; ++n) _Pragma("unroll") for (int k = 0; k < 2; ++k) dst[n][k] = *(const LAS bf16x8*)(lds + PG8_SB(b, h) + boff + n * 2048 + k * 1024); } while (0)
#define PG8_MMA(ai, bj, At, Bt) do { __builtin_amdgcn_s_setprio(1); _Pragma("unroll") for (int m = 0; m < 4; ++m) _Pragma("unroll") for (int n = 0; n < 2; ++n) _Pragma("unroll") for (int k = 0; k < 2; ++k) \
        acc[ai][bj][m][n] = __builtin_amdgcn_mfma_f32_16x16x32_bf16(Bt[n][k], At[m][k], acc[ai][bj][m][n], 0, 0, 0); __builtin_amdgcn_s_setprio(0); } while (0)
#define PG8_WAIT_V(n) asm volatile("s_waitcnt vmcnt(" #n ")" ::: "memory")
#define PG8_WAIT_L(n) asm volatile("s_waitcnt lgkmcnt(" #n ")" ::: "memory")
#define PG8_BAR __builtin_amdgcn_s_barrier()
#define PG8_SCHED __builtin_amdgcn_sched_barrier(0)
    Unit cur, nxt; int ui = 0;
    if (!S.next(0, cur)) return;
    f32x4 acc[2][2][4][2];
#pragma unroll
    for (int a = 0; a < 2; ++a)
#pragma unroll
        for (int b = 0; b < 2; ++b)
#pragma unroll
            for (int m = 0; m < 4; ++m)
#pragma unroll
                for (int n = 0; n < 2; ++n) acc[a][b][m][n] = (f32x4){0.f, 0.f, 0.f, 0.f};
    bf16x8 At[4][2], B0[2][2], B1[2][2];
    const char* cA = (const char*)g.A + (size_t)cur.pm * tstep; const char* cB = (const char*)g.Bt + (size_t)cur.pb * tstep;
    PG8_STAGE(PG8_SB(0, 0), cB, voffB); PG8_STAGE(PG8_SB(0, 1), cB + hstep, voffB); PG8_STAGE(PG8_SA(0, 0), cA, voffA); PG8_STAGE(PG8_SA(0, 1), cA + hstep, voffA);
    if (wr == 1) PG8_BAR;
    PG8_WAIT_V(2); PG8_BAR;
    PG8_STAGE(PG8_SB(1, 0), cB + kstep, voffB); PG8_STAGE(PG8_SA(1, 0), cA + kstep, voffA); PG8_STAGE(PG8_SB(1, 1), cB + hstep + kstep, voffB);
    PG8_WAIT_V(6); PG8_BAR;
    for (;;) {
        const bool has_next = S.next(ui + 1, nxt);
        const char* nA = has_next ? (const char*)g.A + (size_t)nxt.pm * tstep : cA; const char* nB = has_next ? (const char*)g.Bt + (size_t)nxt.pb * tstep : cB;
        for (int t = 0; t < nt; t += 2) {
            const bool last = (t == nt - 2);
            const char* a1 = cA + (size_t)(t + 1) * kstep;
            const char* a2 = last ? nA : cA + (size_t)(t + 2) * kstep; const char* b2 = last ? nB : cB + (size_t)(t + 2) * kstep;
            const char* a3 = a2 + kstep; const char* b3 = b2 + kstep;
            PG8_LDB(B0, 0, 0); PG8_LDB(B1, 0, 1); PG8_SCHED; PG8_LDA(At, 0, 0); PG8_STAGE(PG8_SA(1, 1), a1 + hstep, voffA);
            PG8_WAIT_V(8); PG8_WAIT_L(0); PG8_BAR; PG8_MMA(0, 0, At, B0); PG8_MMA(0, 1, At, B1); PG8_BAR; PG8_SCHED;
            PG8_LDA(At, 0, 1); PG8_STAGE(PG8_SB(0, 0), b2, voffB); PG8_STAGE(PG8_SB(0, 1), b2 + hstep, voffB); PG8_STAGE(PG8_SA(0, 0), a2, voffA);
            PG8_WAIT_V(8); PG8_WAIT_L(0); PG8_BAR; PG8_MMA(1, 0, At, B0); PG8_MMA(1, 1, At, B1); PG8_BAR; PG8_SCHED;
            PG8_LDB(B0, 1, 0); PG8_LDB(B1, 1, 1); PG8_SCHED; PG8_LDA(At, 1, 0); PG8_STAGE(PG8_SA(0, 1), a2 + hstep, voffA);
            PG8_WAIT_V(8); PG8_WAIT_L(0); PG8_BAR; PG8_MMA(0, 0, At, B0); PG8_MMA(0, 1, At, B1); PG8_BAR; PG8_SCHED;
            PG8_LDA(At, 1, 1); PG8_STAGE(PG8_SB(1, 0), b3, voffB); PG8_STAGE(PG8_SB(1, 1), b3 + hstep, voffB); PG8_STAGE(PG8_SA(1, 0), a3, voffA);
            PG8_WAIT_V(8); PG8_WAIT_L(0); PG8_BAR; PG8_MMA(1, 0, At, B0); PG8_MMA(1, 1, At, B1); PG8_BAR; PG8_SCHED;
        }
        if (wr == 0) PG8_BAR;
        E(acc, cur, wr, wc, fr, fq);
        if (!has_next) break;
#pragma unroll
        for (int a = 0; a < 2; ++a)
#pragma unroll
            for (int b = 0; b < 2; ++b)
#pragma unroll
                for (int m = 0; m < 4; ++m)
#pragma unroll
                    for (int n = 0; n < 2; ++n) acc[a][b][m][n] = (f32x4){0.f, 0.f, 0.f, 0.f};
        cur = nxt; cA = nA; cB = nB; ++ui;
        if (wr == 1) PG8_BAR;
    }
    PG8_WAIT_V(0);
    PG8_BAR;
#undef PG8_SA
#undef PG8_SB
#undef PG8_STAGE
#undef PG8_LDA
#undef PG8_LDB
#undef PG8_MMA
#undef PG8_WAIT_V
#undef PG8_WAIT_L
#undef PG8_BAR
#undef PG8_SCHED
}

struct EpiBf16 {
    static constexpr bool PERM = true;
    bf16_t* O; int ldc;
    __device__ __forceinline__ void operator()(const f32x4 (&acc)[2][2][4][2], const Unit& u, int wr, int wc, int fr, int fq) const {
        const int row0 = u.pm * BM + wr * 64 + fr, col0 = u.pn * BM + wc * 32 + 8 * fq;
#pragma unroll
        for (int ai = 0; ai < 2; ++ai)
#pragma unroll
            for (int m = 0; m < 4; ++m) { bf16_t* rowp = O + (size_t)(row0 + ai * HALF + m * 16) * ldc + col0;
#pragma unroll
                for (int bj = 0; bj < 2; ++bj) { const f32x4 v0 = acc[ai][bj][m][0], v1 = acc[ai][bj][m][1];
                    u32x4 w; w.x = cvtpk(v0[0], v0[1]); w.y = cvtpk(v0[2], v0[3]); w.z = cvtpk(v1[0], v1[1]); w.w = cvtpk(v1[2], v1[3]);
                    *(u32x4*)(rowp + bj * HALF) = w; } }
    }
};
struct EpiSwiGLU {
    static constexpr bool PERM = true;
    bf16_t* O; int ldc;
    __device__ __forceinline__ void operator()(const f32x4 (&acc)[2][2][4][2], const Unit& u, int wr, int wc, int fr, int fq) const {
        const int row0 = u.pm * BM + wr * 64 + fr, col0 = u.pn * HALF + wc * 32 + 8 * fq;
#pragma unroll
        for (int ai = 0; ai < 2; ++ai)
#pragma unroll
            for (int m = 0; m < 4; ++m) { bf16_t* rowp = O + (size_t)(row0 + ai * HALF + m * 16) * ldc + col0;
                float h[8];
#pragma unroll
                for (int n = 0; n < 2; ++n)
#pragma unroll
                    for (int i = 0; i < 4; ++i) { const float a = acc[ai][0][m][n][i], b = acc[ai][1][m][n][i]; h[n * 4 + i] = a * fast_sigmoid(a) * b; }
                u32x4 w; w.x = cvtpk(h[0], h[1]); w.y = cvtpk(h[2], h[3]); w.z = cvtpk(h[4], h[5]); w.w = cvtpk(h[6], h[7]);
                *(u32x4*)rowp = w; }
    }
};
struct EpiResid {
    static constexpr bool PERM = false;
    const float* resid; float* out; int ldc;
    __device__ __forceinline__ void operator()(const f32x4 (&acc)[2][2][4][2], const Unit& u, int wr, int wc, int fr, int fq) const {
        const int row0 = u.pm * BM + wr * 64 + fr, col0 = u.pn * BM + wc * 32 + 4 * fq;
#pragma unroll
        for (int ai = 0; ai < 2; ++ai)
#pragma unroll
            for (int m = 0; m < 4; ++m) { const size_t off = (size_t)(row0 + ai * HALF + m * 16) * ldc + col0;
#pragma unroll
                for (int bj = 0; bj < 2; ++bj)
#pragma unroll
                    for (int n = 0; n < 2; ++n) { const f32x4 r = *(const f32x4*)(resid + off + bj * HALF + n * 16); *(f32x4*)(out + off + bj * HALF + n * 16) = r * ALPHA + acc[ai][bj][m][n]; } }
    }
};
struct EpiGlu {
    static constexpr bool PERM = true;
    const bf16_t* h; int ldh; bf16_t* O; int ldc;
    __device__ __forceinline__ void operator()(const f32x4 (&acc)[2][2][4][2], const Unit& u, int wr, int wc, int fr, int fq) const {
        const int row0 = u.pm * BM + wr * 64 + fr, col0 = u.pn * BM + wc * 32 + 8 * fq;
#pragma unroll
        for (int ai = 0; ai < 2; ++ai)
#pragma unroll
            for (int m = 0; m < 4; ++m) { const size_t row = (size_t)(row0 + ai * HALF + m * 16);
#pragma unroll
                for (int bj = 0; bj < 2; ++bj) { const int col = col0 + bj * HALF; const u32x4 hv = *(const u32x4*)(h + row * ldh + col);
                    const f32x4 v0 = acc[ai][bj][m][0], v1 = acc[ai][bj][m][1];
                    u32x4 w; w.x = cvtpk(bf_lo(hv.x) * fast_sigmoid(v0[0]), bf_hi(hv.x) * fast_sigmoid(v0[1])); w.y = cvtpk(bf_lo(hv.y) * fast_sigmoid(v0[2]), bf_hi(hv.y) * fast_sigmoid(v0[3]));
                    w.z = cvtpk(bf_lo(hv.z) * fast_sigmoid(v1[0]), bf_hi(hv.z) * fast_sigmoid(v1[1])); w.w = cvtpk(bf_lo(hv.w) * fast_sigmoid(v1[2]), bf_hi(hv.w) * fast_sigmoid(v1[3]));
                    *(u32x4*)(O + row * ldc + col) = w; } }
    }
};
struct EpiRope {
    static constexpr bool PERM = false;
    bf16_t* O; float* gate; const float* rc; const float* rs;
    __device__ __forceinline__ void operator()(const f32x4 (&acc)[2][2][4][2], const Unit& u, int wr, int wc, int fr, int fq) const {
        const int row0 = u.pm * BM + wr * 64 + fr;
        if (u.pn < 10) {
            const bool rope = (u.pn < 4) || (u.pn == 6) || (u.pn == 8); const float sc = u.pn < 4 ? 0.18033688011112042f : 1.0f;
            const int j = (wc & 1) * 16 + fq * 4;
#pragma unroll
            for (int ai = 0; ai < 2; ++ai)
#pragma unroll
                for (int m = 0; m < 4; ++m) { const int row = row0 + ai * HALF + m * 16, pos = row & 2047;
                    f32x4 c4 = {1.f, 1.f, 1.f, 1.f}, s4 = {0.f, 0.f, 0.f, 0.f};
                    if (rope) { c4 = *(const f32x4*)(rc + pos * 32 + j); s4 = *(const f32x4*)(rs + pos * 32 + j); }
#pragma unroll
                    for (int bj = 0; bj < 2; ++bj) { const int head = bj * 2 + (wc >> 1); const f32x4 x1 = acc[ai][bj][m][0], x2 = acc[ai][bj][m][1];
                        const f32x4 y1 = (x1 * c4 - x2 * s4) * sc, y2 = (x1 * s4 + x2 * c4) * sc;
                        bf16_t* op = O + (size_t)row * 2560 + u.pn * 256 + head * 64 + j;
                        u32x2 w1; w1.x = cvtpk(y1[0], y1[1]); w1.y = cvtpk(y1[2], y1[3]); *(u32x2*)op = w1;
                        u32x2 w2; w2.x = cvtpk(y2[0], y2[1]); w2.y = cvtpk(y2[2], y2[3]); *(u32x2*)(op + 32) = w2; } }
        } else {
#pragma unroll
            for (int ai = 0; ai < 2; ++ai)
#pragma unroll
                for (int m = 0; m < 4; ++m) { const int row = row0 + ai * HALF + m * 16;
#pragma unroll
                    for (int n = 0; n < 2; ++n) { const int c = 32 * wc + 16 * n + 4 * fq; const f32x4 v = acc[ai][0][m][n];
                        if (c < 48) *(f32x4*)(gate + (size_t)row * 48 + c) = (f32x4){fast_sigmoid(v[0]), fast_sigmoid(v[1]), fast_sigmoid(v[2]), fast_sigmoid(v[3])}; } }
        }
    }
};
}

#define XB_TMO      128
#define XB_XCNT(j)  (256  + 64 * (j))
#define XB_XSUB(j)  (1280 + 64 * (j))
#define XB_XGEN(j)  (2304 + 64 * (j))
#define XB_TOP      3328
#define XB_TOPGEN   3392
#define XCD_BAR_WORDS 3456
#define XB_SPIN_CAP (1u << 22)
__device__ __forceinline__ unsigned xb_ld(unsigned* p)              { return __hip_atomic_load(p, __ATOMIC_RELAXED, __HIP_MEMORY_SCOPE_AGENT); }
__device__ __forceinline__ unsigned xb_add(unsigned* p, unsigned v) { return __hip_atomic_fetch_add(p, v, __ATOMIC_RELAXED, __HIP_MEMORY_SCOPE_AGENT); }
__device__ __forceinline__ unsigned xb_xcc_id() { return (unsigned)__builtin_amdgcn_s_getreg((3 << 11) | 20) & 0xFu; }
#define XB_SPIN(cond, bar) do { unsigned _sp = 0; while (cond) { __builtin_amdgcn_s_sleep(1); \
    if ((++_sp & 255u) == 0u) { if (xb_ld(&(bar)[XB_TMO])) break; if (_sp > XB_SPIN_CAP) { atomicAdd(&(bar)[XB_TMO], 1u); break; } } } } while (0)
struct XcdBarrier { unsigned* bar; unsigned x; volatile LAS unsigned* st; };
__device__ __forceinline__ XcdBarrier xcd_barrier_post(unsigned* bar, volatile LAS unsigned* st) {
    XcdBarrier b; b.bar = bar; b.x = xb_xcc_id(); b.st = st;
    if (threadIdx.x == 0) (void)xb_add(&bar[XB_XCNT(b.x)], 1u);
    return b;
}
__device__ __forceinline__ void xcd_barrier_complete(unsigned* bar, unsigned x, unsigned& nloc, unsigned& nx) {
    const unsigned G = gridDim.x * gridDim.y * gridDim.z;
    unsigned sum, cnt, mine, sp = 0u;
    for (;;) {
        sum = 0u; cnt = 0u; mine = 0u;
#pragma unroll
        for (unsigned j = 0; j < 16; ++j) { const unsigned c = xb_ld(&bar[XB_XCNT(j)]); sum += c; cnt += (c > 0u) ? 1u : 0u; mine = (j == x) ? c : mine; }
        if (sum == G) break;
        __builtin_amdgcn_s_sleep(1);
        if ((++sp & 255u) == 0u) { if (xb_ld(&bar[XB_TMO])) break; if (sp > XB_SPIN_CAP) { atomicAdd(&bar[XB_TMO], 1u); break; } }
    }
    nloc = mine > 0u ? mine : 1u; nx = cnt > 0u ? cnt : 1u;
}
__device__ __forceinline__ void xcd_barrier(const XcdBarrier& b) {
    asm volatile("s_waitcnt vmcnt(0)" ::: "memory");
    __syncthreads();
    if (threadIdx.x == 0) {
        unsigned* bar = b.bar;
        __builtin_amdgcn_s_waitcnt(0);
        unsigned nloc = b.st[0], nx = b.st[1];
        if (nloc == 0u) { xcd_barrier_complete(bar, b.x, nloc, nx); b.st[0] = nloc; b.st[1] = nx; }
        const unsigned old = xb_add(&bar[XB_XSUB(b.x)], 1u);
        const unsigned gen = old / nloc;
        if (old + 1u == (gen + 1u) * nloc) {
            __builtin_amdgcn_fence(__ATOMIC_RELEASE, "agent");
            asm volatile("s_waitcnt vmcnt(0)" ::: "memory");
            const unsigned og = xb_add(&bar[XB_TOP], 1u);
            const unsigned tg = og / nx;
            if (og + 1u == (tg + 1u) * nx) xb_add(&bar[XB_TOPGEN], 1u);
            else XB_SPIN(xb_ld(&bar[XB_TOPGEN]) == tg, bar);
            __builtin_amdgcn_fence(__ATOMIC_ACQUIRE, "agent");
            xb_add(&bar[XB_XGEN(b.x)], 1u);
            asm volatile("s_waitcnt vmcnt(0)" ::: "memory");
        } else {
            XB_SPIN(xb_ld(&bar[XB_XGEN(b.x)]) == gen, bar);
            __builtin_amdgcn_fence(__ATOMIC_ACQUIRE, "agent");
            asm volatile("s_waitcnt vmcnt(0)" ::: "memory");
        }
    }
    __syncthreads();
}

struct Args { const float* in[36]; float* out; unsigned char* ws; int ph_lo, ph_hi; };
struct Frame {
    LAS unsigned char* lds;
    volatile LAS unsigned* LC;
    unsigned* ctl;
    int tid, lane, wave, vcu, G;
};
enum { I_X = 0, I_WIN0, I_LAMRE, I_LAMIM, I_LOGDT, I_BRE, I_BIM, I_CRE, I_CIM, I_SSMD, I_WGLU, I_WOUT0, I_LNMG0, I_LNMB0, I_LNFG0, I_LNFB0, I_W1_0, I_W3_0, I_W2_0,
       I_WIN1, I_CPK, I_CW1K, I_CW2K, I_CPV, I_CW1V, I_CW2V, I_WOUT1, I_LNMG1, I_LNMB1, I_LNFG1, I_LNFB1, I_W1_1, I_W3_1, I_W2_1, I_WR, I_BR };

__device__ __forceinline__ void p0_item_load(float (&v)[32], const float* W, int ldw, int ncols_valid, int nblk, int item, int lane) {
    const int kb = item / nblk, nb = item % nblk, k0 = 64 * kb, n0 = 32 * nb;
    const int nsrc = (n0 + (lane & 31)) < ncols_valid ? (n0 + (lane & 31)) : (ncols_valid - 1);
    const float* p = W + (size_t)(k0 + (lane >> 5)) * ldw + nsrc;
#pragma unroll
    for (int i = 0; i < 32; ++i) v[i] = p[(size_t)(2 * i) * ldw];
}
template <class RowMap>
__device__ __forceinline__ void p0_item_store(const float (&v)[32], int K, int nblk, bf16_t* WT, const RowMap& rm, LAS float* scr, int item, int lane) {
    const int kb = item / nblk, nb = item % nblk, k0 = 64 * kb, n0 = 32 * nb;
#pragma unroll
    for (int i = 0; i < 32; ++i) scr[(2 * i + (lane >> 5)) * 33 + (lane & 31)] = v[i];
    LDS_WAIT(); asm volatile("" ::: "memory");
    const int c = lane & 7;
#pragma unroll
    for (int j = 0; j < 4; ++j) { const int n = (lane >> 3) + 8 * j; const LAS float* s = scr + (8 * c) * 33 + n;
        u32x4 o; o.x = cvtpk(s[0 * 33], s[1 * 33]); o.y = cvtpk(s[2 * 33], s[3 * 33]); o.z = cvtpk(s[4 * 33], s[5 * 33]); o.w = cvtpk(s[6 * 33], s[7 * 33]);
        *(u32x4*)(WT + (size_t)rm(n0 + n) * K + k0 + 8 * c) = o; }
    LDS_WAIT(); asm volatile("" ::: "memory");
}
struct RmId { int off; __device__ __forceinline__ int operator()(int n) const { return off + n; } };
struct RmW13 { int half; __device__ __forceinline__ int operator()(int n) const { return (n >> 7) * 256 + half * 128 + (n & 127); } };
struct RmRope {
    __device__ __forceinline__ int operator()(int n) const {
        if (n >= 2560) return n;
        const int tile = n >> 8, o = n & 255, head = o >> 6, half = (o >> 5) & 1, j = o & 31;
        const int bj = head >> 1, wc = (head & 1) * 2 + (j >> 4), fq = (j >> 2) & 3, i = j & 3;
        return tile * 256 + 128 * bj + 32 * wc + 16 * half + 4 * fq + i;
    }
};

struct P0Item { const float* W; bf16_t* WT; int K, ldw, ncv, nblk, rmk, rmarg, it; };
__device__ __forceinline__ P0Item p0_decode(const Args& A, int it) {
    constexpr int IT_W0 = (1024 / 64) * (2048 / 32), IT_GLU = (512 / 64) * (512 / 32), IT_SQ = (1024 / 64) * (1024 / 32), IT_IN1 = (1024 / 64) * (2816 / 32), IT_CW1 = (2048 / 64) * (256 / 32);
    constexpr int IT_E13 = (1024 / 64) * (512 / 32), IT_E2 = (512 / 64) * (1024 / 32), IT_EXPL = 16 * (2 * IT_E13 + IT_E2);
    unsigned char* ws = A.ws; P0Item d; int r = it;
    if (r < IT_W0) { d = {A.in[I_WIN0], (bf16_t*)(ws + WS_W0T), 1024, 2048, 2048, 64, 0, 0, r}; return d; } r -= IT_W0;
    if (r < IT_GLU) { d = {A.in[I_WGLU], (bf16_t*)(ws + WS_WGLUT), 512, 512, 512, 16, 0, 0, r}; return d; } r -= IT_GLU;
    if (r < IT_SQ) { d = {A.in[I_WOUT0], (bf16_t*)(ws + WS_WOUT0T), 1024, 1024, 1024, 32, 0, 0, r}; return d; } r -= IT_SQ;
    if (r < IT_IN1) { d = {A.in[I_WIN1], (bf16_t*)(ws + WS_WIN1T), 1024, 2608, 2608, 88, 2, 0, r}; return d; } r -= IT_IN1;
    if (r < IT_SQ) { d = {A.in[I_WOUT1], (bf16_t*)(ws + WS_WOUT1T), 1024, 1024, 1024, 32, 0, 0, r}; return d; } r -= IT_SQ;
    if (r < IT_CW1) { d = {A.in[I_CW1K], (bf16_t*)(ws + WS_CW1T), 2048, 256, 256, 8, 0, 0, r}; return d; } r -= IT_CW1;
    if (r < IT_CW1) { d = {A.in[I_CW1V], (bf16_t*)(ws + WS_CW1T) + 256 * 2048, 2048, 256, 256, 8, 0, 0, r}; return d; } r -= IT_CW1;
    const int layer = r / IT_EXPL; r -= layer * IT_EXPL;
    const int e = r / (2 * IT_E13 + IT_E2); r -= e * (2 * IT_E13 + IT_E2);
    bf16_t* w13t = (bf16_t*)(ws + WS_WEXP + layer * WEXP_LAYER) + (size_t)e * 1024 * 1024;
    bf16_t* w2t = (bf16_t*)(ws + WS_WEXP + layer * WEXP_LAYER + WEXP_W2) + (size_t)e * 1024 * 512;
    const float* w1 = A.in[layer ? I_W1_1 : I_W1_0] + (size_t)e * 1024 * 512;
    const float* w3 = A.in[layer ? I_W3_1 : I_W3_0] + (size_t)e * 1024 * 512;
    const float* w2 = A.in[layer ? I_W2_1 : I_W2_0] + (size_t)e * 512 * 1024;
    if (r < IT_E13) { d = {w1, w13t, 1024, 512, 512, 16, 1, 0, r}; return d; } r -= IT_E13;
    if (r < IT_E13) { d = {w3, w13t, 1024, 512, 512, 16, 1, 1, r}; return d; } r -= IT_E13;
    d = {w2, w2t, 512, 1024, 1024, 32, 0, 0, r}; return d;
}
__device__ __forceinline__ void p0_prologue(Frame& F, const Args& A) {
    LAS float* scr = (LAS float*)(F.lds + F.wave * 16384);
    const int gw = F.vcu * NWAVES + F.wave, NGW = F.G * NWAVES;
    constexpr int IT_DENSE = 1024 + 128 + 512 + 1408 + 512 + 2 * 256, NITEMS = IT_DENSE + 2 * 16 * (2 * 256 + 256);
    float v[32];
    P0Item cur = p0_decode(A, gw < NITEMS ? gw : 0);
    if (gw < NITEMS) p0_item_load(v, cur.W, cur.ldw, cur.ncv, cur.nblk, cur.it, F.lane);
    for (int it = gw; it < NITEMS; it += NGW) {
        float u[32];
#pragma unroll
        for (int i = 0; i < 32; ++i) u[i] = v[i];
        const P0Item d = cur;
        if (it + NGW < NITEMS) { cur = p0_decode(A, it + NGW); p0_item_load(v, cur.W, cur.ldw, cur.ncv, cur.nblk, cur.it, F.lane); }
        if (d.rmk == 0) p0_item_store(u, d.K, d.nblk, d.WT, RmId{0}, scr, d.it, F.lane);
        else if (d.rmk == 1) p0_item_store(u, d.K, d.nblk, d.WT, RmW13{d.rmarg}, scr, d.it, F.lane);
        else p0_item_store(u, d.K, d.nblk, d.WT, RmRope{}, scr, d.it, F.lane);
    }
    bf16_t* xb = (bf16_t*)(A.ws + WS_H);
    for (int m = gw; m < NTOK; m += 2 * NGW) {
        const f32x4* xr0 = (const f32x4*)(A.in[I_X] + (size_t)m * DM) + F.lane; const f32x4* xr1 = (const f32x4*)(A.in[I_X] + (size_t)(m + NGW) * DM) + F.lane;
        u32x2* o0 = (u32x2*)(xb + (size_t)m * DM) + F.lane; u32x2* o1 = (u32x2*)(xb + (size_t)(m + NGW) * DM) + F.lane;
        f32x4 a[4], b[4];
#pragma unroll
        for (int j = 0; j < 4; ++j) { a[j] = xr0[64 * j]; if (m + NGW < NTOK) b[j] = xr1[64 * j]; }
#pragma unroll
        for (int j = 0; j < 4; ++j) { u32x2 w; w.x = cvtpk(a[j][0], a[j][1]); w.y = cvtpk(a[j][2], a[j][3]); o0[64 * j] = w;
            if (m + NGW < NTOK) { u32x2 w2; w2.x = cvtpk(b[j][0], b[j][1]); w2.y = cvtpk(b[j][2], b[j][3]); o1[64 * j] = w2; } }
    }
}

__device__ __forceinline__ float rdl(float v, int l) { return __builtin_bit_cast(float, __builtin_amdgcn_readlane(__builtin_bit_cast(int, v), l)); }
constexpr int LNR = 2;
__device__ __forceinline__ void ln_a_phase(Frame& F, const Args& A, int layer, bool dry = false) {
    const float* xres = A.out; float* xout = dry ? (float*)(A.ws + WS_ARENA) : A.out; bf16_t* xb = (bf16_t*)(A.ws + (dry ? WS_CAT : WS_H));
    const float* gam = A.in[layer ? I_LNMG1 : I_LNMG0]; const float* bet = A.in[layer ? I_LNMB1 : I_LNMB0];
    const float* wr = A.in[I_WR]; const float* br = A.in[I_BR];
    LAS float* wrT = (LAS float*)F.lds;
    for (int i = F.tid; i < DM * NE; i += NTHR) { const int k = i >> 4, e = i & 15; wrT[e * DM + k] = wr[i]; }
    __syncthreads();
    const float brv = br[(F.lane >> 2) & 15];
    i32x4* tokes = (i32x4*)(A.ws + (dry ? WS_MISC + 7 * MiB : WS_TOKES)); f32x2* tokw = (f32x2*)(A.ws + (dry ? WS_MISC + 7 * MiB + 256 * 1024 : WS_TOKW));
    unsigned* cnt = F.ctl + CW_CNT + (dry ? 2 : layer) * 16 * 64;
    const int gw = F.vcu * NWAVES + F.wave, NGW = F.G * NWAVES;
    const bool b5 = (F.lane & 32) != 0, b4 = (F.lane & 16) != 0, b3 = (F.lane & 8) != 0, b2 = (F.lane & 4) != 0;
    f32x4 nx[LNR][4];
#pragma unroll
    for (int rr = 0; rr < LNR; ++rr) { const int m = gw + rr * NGW; if (m < NTOK) {
#pragma unroll
        for (int j = 0; j < 4; ++j) nx[rr][j] = ((const f32x4*)(xres + (size_t)m * DM))[F.lane + 64 * j]; } }
    for (int m0 = gw; m0 < NTOK; m0 += LNR * NGW) {
        f32x4 v[LNR][4]; float s[LNR];
#pragma unroll
        for (int rr = 0; rr < LNR; ++rr) { s[rr] = 0.f;
#pragma unroll
            for (int j = 0; j < 4; ++j) { v[rr][j] = nx[rr][j]; s[rr] += (v[rr][j][0] + v[rr][j][1]) + (v[rr][j][2] + v[rr][j][3]); } }
#pragma unroll
        for (int rr = 0; rr < LNR; ++rr) { const int m = m0 + (LNR + rr) * NGW; if (m < NTOK) {
#pragma unroll
            for (int j = 0; j < 4; ++j) nx[rr][j] = ((const f32x4*)(xres + (size_t)m * DM))[F.lane + 64 * j]; } }
        float mean[LNR], rstd[LNR];
#pragma unroll
        for (int rr = 0; rr < LNR; ++rr) mean[rr] = wave_sum(s[rr]) * (1.f / DM);
#pragma unroll
        for (int rr = 0; rr < LNR; ++rr) { float s2 = 0.f;
#pragma unroll
            for (int j = 0; j < 4; ++j) { v[rr][j] = v[rr][j] - mean[rr]; s2 += (v[rr][j][0] * v[rr][j][0] + v[rr][j][1] * v[rr][j][1]) + (v[rr][j][2] * v[rr][j][2] + v[rr][j][3] * v[rr][j][3]); }
            s[rr] = s2; }
#pragma unroll
        for (int rr = 0; rr < LNR; ++rr) rstd[rr] = 1.f / sqrtf(wave_sum(s[rr]) * (1.f / DM) + LN_EPS);
#pragma unroll
        for (int rr = 0; rr < LNR; ++rr) { const int m = m0 + rr * NGW; if (m < NTOK) {
            f32x4* xr = (f32x4*)(xout + (size_t)m * DM) + F.lane; u32x2* o8 = (u32x2*)(xb + (size_t)m * DM) + F.lane;
#pragma unroll
            for (int j = 0; j < 4; ++j) { const f32x4 gj = ((const f32x4*)gam)[F.lane + 64 * j], bj = ((const f32x4*)bet)[F.lane + 64 * j];
                v[rr][j] = v[rr][j] * rstd[rr] * gj + bj; xr[64 * j] = v[rr][j]; u32x2 w; w.x = cvtpk(v[rr][j][0], v[rr][j][1]); w.y = cvtpk(v[rr][j][2], v[rr][j][3]); o8[64 * j] = w; } } }
        float p[LNR][16];
#pragma unroll
        for (int e = 0; e < NE; ++e) {
            f32x4 w[4];
#pragma unroll
            for (int j = 0; j < 4; ++j) w[j] = *(const LAS f32x4*)(wrT + e * DM + 4 * F.lane + 256 * j);
#pragma unroll
            for (int rr = 0; rr < LNR; ++rr) { float acc = 0.f;
#pragma unroll
                for (int j = 0; j < 4; ++j) acc += (v[rr][j][0] * w[j][0] + v[rr][j][1] * w[j][1]) + (v[rr][j][2] * w[j][2] + v[rr][j][3] * w[j][3]);
                p[rr][e] = acc; }
            asm volatile("" ::: "memory");
        }
        float lg[LNR];
#pragma unroll
        for (int rr = 0; rr < LNR; ++rr) {
            float q8[8], q4[4], q2[2];
#pragma unroll
            for (int i = 0; i < 8; ++i) { const float keep = b5 ? p[rr][i + 8] : p[rr][i], send = b5 ? p[rr][i] : p[rr][i + 8]; q8[i] = keep + __shfl_xor(send, 32); }
#pragma unroll
            for (int i = 0; i < 4; ++i) { const float keep = b4 ? q8[i + 4] : q8[i], send = b4 ? q8[i] : q8[i + 4]; q4[i] = keep + __shfl_xor(send, 16); }
#pragma unroll
            for (int i = 0; i < 2; ++i) { const float keep = b3 ? q4[i + 2] : q4[i], send = b3 ? q4[i] : q4[i + 2]; q2[i] = keep + __shfl_xor(send, 8); }
            float l; { const float keep = b2 ? q2[1] : q2[0], send = b2 ? q2[0] : q2[1]; l = keep + __shfl_xor(send, 4); }
            l += DPPF(0.f, l, 0xB1, 0xF); l += DPPF(0.f, l, 0x4E, 0xF);
            lg[rr] = l;
        }
#pragma unroll
        for (int rr = 0; rr < LNR; ++rr) {
            const int m = m0 + rr * NGW;
            const float aff = 1.0f / (1.0f + expf(-lg[rr]));
            const float sel = aff + brv;
            float sv[16], av[16];
#pragma unroll
            for (int e = 0; e < NE; ++e) { sv[e] = rdl(sel, 4 * e); av[e] = rdl(aff, 4 * e); }
            int gbest = 0; float gscore = -3.0e38f;
#pragma unroll
            for (int g = 0; g < 4; ++g) {
                const float a0 = sv[4 * g], a1 = sv[4 * g + 1], a2 = sv[4 * g + 2], a3 = sv[4 * g + 3];
                const float t2 = fmaxf(fmaxf(fmaxf(a0 + a1, a0 + a2), fmaxf(a0 + a3, a1 + a2)), fmaxf(a1 + a3, a2 + a3));
                if (t2 > gscore) { gscore = t2; gbest = g; }
            }
            float g0 = 0.f, g1 = 0.f, g2 = 0.f, g3 = 0.f, f0 = 0.f, f1 = 0.f, f2 = 0.f, f3 = 0.f;
#pragma unroll
            for (int g = 0; g < 4; ++g) if (g == gbest) { g0 = sv[4 * g]; g1 = sv[4 * g + 1]; g2 = sv[4 * g + 2]; g3 = sv[4 * g + 3]; f0 = av[4 * g]; f1 = av[4 * g + 1]; f2 = av[4 * g + 2]; f3 = av[4 * g + 3]; }
            int i0 = 0; float b0 = g0; if (g1 > b0) { b0 = g1; i0 = 1; } if (g2 > b0) { b0 = g2; i0 = 2; } if (g3 > b0) { b0 = g3; i0 = 3; }
            int i1 = -1; float b1 = -3.0e38f;
            if (i0 != 0 && g0 > b1) { b1 = g0; i1 = 0; } if (i0 != 1 && g1 > b1) { b1 = g1; i1 = 1; } if (i0 != 2 && g2 > b1) { b1 = g2; i1 = 2; } if (i0 != 3 && g3 > b1) { b1 = g3; i1 = 3; }
            const float a_0 = i0 == 0 ? f0 : i0 == 1 ? f1 : i0 == 2 ? f2 : f3, a_1 = i1 == 0 ? f0 : i1 == 1 ? f1 : i1 == 2 ? f2 : f3;
            const float inv = 1.0f / (a_0 + a_1);
            const int e0 = gbest * 4 + i0, e1 = gbest * 4 + i1;
            if (F.lane == 0 && m < NTOK) {
                const int s0 = (int)__hip_atomic_fetch_add(cnt + 64 * e0, 1u, RLX_AGENT), s1 = (int)__hip_atomic_fetch_add(cnt + 64 * e1, 1u, RLX_AGENT);
                tokes[m] = (i32x4){e0, s0, e1, s1}; tokw[m] = (f32x2){a_0 * inv, a_1 * inv};
            }
        }
    }
}
__device__ __forceinline__ void moe_prefix(Frame& F, int layer) {
    __syncthreads();
    if (F.tid == 0) {
        unsigned* cnt = F.ctl + CW_CNT + layer * 16 * 64; int acc = 0;
        for (int e = 0; e < NE; ++e) { F.LC[LC_TSTART + e] = (unsigned)acc; const unsigned c = __hip_atomic_load(cnt + 64 * e, RLX_AGENT); acc += (int)((c + 255u) >> 8); }
        F.LC[LC_TSTART + 16] = (unsigned)acc;
    }
    __syncthreads();
}
__device__ __forceinline__ void moe_gather_phase(Frame& F, const Args& A, int layer) {
    moe_prefix(F, layer);
    const bf16_t* xb = (const bf16_t*)(A.ws + WS_H); bf16_t* xg = (bf16_t*)(A.ws + WS_ARENA);
    const i32x4* tokes = (const i32x4*)(A.ws + WS_TOKES); int* tokrow = (int*)(A.ws + WS_TOKROW);
    const int gw = F.vcu * NWAVES + F.wave, NGW = F.G * NWAVES;
    for (int m = gw; m < NTOK; m += NGW) {
        const i32x4 es = tokes[m];
        const int r0 = (int)F.LC[LC_TSTART + es[0]] * 256 + es[1], r1 = (int)F.LC[LC_TSTART + es[2]] * 256 + es[3];
        const u32x4* src = (const u32x4*)(xb + (size_t)m * DM) + F.lane;
        const u32x4 a = src[0], b = src[64];
        u32x4* d0 = (u32x4*)(xg + (size_t)r0 * DM) + F.lane; u32x4* d1 = (u32x4*)(xg + (size_t)r1 * DM) + F.lane;
        d0[0] = a; d0[64] = b; d1[0] = a; d1[64] = b;
        if (F.lane == 0) { tokrow[2 * m] = r0; tokrow[2 * m + 1] = r1; }
    }
}
__device__ __forceinline__ void ln_b_phase(Frame& F, const Args& A, int layer, bool write_bf16) {
    float* xres = A.out; bf16_t* xb = (bf16_t*)(A.ws + WS_H);
    const bf16_t* Y = (const bf16_t*)(A.ws + WS_ARENA);
    const float* gam = A.in[layer ? I_LNFG1 : I_LNFG0]; const float* bet = A.in[layer ? I_LNFB1 : I_LNFB0];
    const int* tokrow = (const int*)(A.ws + WS_TOKROW); const f32x2* tokw = (const f32x2*)(A.ws + WS_TOKW);
    const int gw = F.vcu * NWAVES + F.wave, NGW = F.G * NWAVES;
    f32x4 nx[LNR][4]; u32x2 ny0[LNR][4], ny1[LNR][4]; f32x2 nw[LNR]; int rf0[LNR], rf1[LNR];
#pragma unroll
    for (int rr = 0; rr < LNR; ++rr) { const int m = gw + rr * NGW; nw[rr] = (f32x2){0.f, 0.f}; rf0[rr] = 0; rf1[rr] = 0;
        if (m < NTOK) { const int r0 = tokrow[2 * m], r1 = tokrow[2 * m + 1]; nw[rr] = tokw[m];
#pragma unroll
            for (int j = 0; j < 4; ++j) { nx[rr][j] = ((const f32x4*)(xres + (size_t)m * DM))[F.lane + 64 * j]; ny0[rr][j] = ((const u32x2*)(Y + (size_t)r0 * DM))[F.lane + 64 * j]; ny1[rr][j] = ((const u32x2*)(Y + (size_t)r1 * DM))[F.lane + 64 * j]; } }
        const int mf = gw + (LNR + rr) * NGW; if (mf < NTOK) { rf0[rr] = tokrow[2 * mf]; rf1[rr] = tokrow[2 * mf + 1]; } }
    for (int m0 = gw; m0 < NTOK; m0 += LNR * NGW) {
        f32x4 v[LNR][4]; float s[LNR];
#pragma unroll
        for (int rr = 0; rr < LNR; ++rr) { s[rr] = 0.f; const f32x2 w = nw[rr];
#pragma unroll
            for (int j = 0; j < 4; ++j) {
                v[rr][j] = nx[rr][j] * ALPHA; const u32x2 a = ny0[rr][j], b = ny1[rr][j];
                v[rr][j][0] += w[0] * bf_lo(a.x) + w[1] * bf_lo(b.x); v[rr][j][1] += w[0] * bf_hi(a.x) + w[1] * bf_hi(b.x);
                v[rr][j][2] += w[0] * bf_lo(a.y) + w[1] * bf_lo(b.y); v[rr][j][3] += w[0] * bf_hi(a.y) + w[1] * bf_hi(b.y);
                s[rr] += (v[rr][j][0] + v[rr][j][1]) + (v[rr][j][2] + v[rr][j][3]); } }
#pragma unroll
        for (int rr = 0; rr < LNR; ++rr) { const int mn = m0 + (LNR + rr) * NGW;
            if (mn < NTOK) { nw[rr] = tokw[mn]; const int r0 = rf0[rr], r1 = rf1[rr];
#pragma unroll
                for (int j = 0; j < 4; ++j) { nx[rr][j] = ((const f32x4*)(xres + (size_t)mn * DM))[F.lane + 64 * j]; ny0[rr][j] = ((const u32x2*)(Y + (size_t)r0 * DM))[F.lane + 64 * j]; ny1[rr][j] = ((const u32x2*)(Y + (size_t)r1 * DM))[F.lane + 64 * j]; }
                const int mf = mn + LNR * NGW; if (mf < NTOK) { rf0[rr] = tokrow[2 * mf]; rf1[rr] = tokrow[2 * mf + 1]; } } }
        float mean[LNR], rstd[LNR];
#pragma unroll
        for (int rr = 0; rr < LNR; ++rr) mean[rr] = wave_sum(s[rr]) * (1.f / DM);
#pragma unroll
        for (int rr = 0; rr < LNR; ++rr) { float s2 = 0.f;
#pragma unroll
            for (int j = 0; j < 4; ++j) { v[rr][j] = v[rr][j] - mean[rr]; s2 += (v[rr][j][0] * v[rr][j][0] + v[rr][j][1] * v[rr][j][1]) + (v[rr][j][2] * v[rr][j][2] + v[rr][j][3] * v[rr][j][3]); }
            s[rr] = s2; }
#pragma unroll
        for (int rr = 0; rr < LNR; ++rr) rstd[rr] = 1.f / sqrtf(wave_sum(s[rr]) * (1.f / DM) + LN_EPS);
#pragma unroll
        for (int rr = 0; rr < LNR; ++rr) { const int m = m0 + rr * NGW; if (m < NTOK) {
            f32x4* xr = (f32x4*)(xres + (size_t)m * DM) + F.lane; u32x2* o8 = (u32x2*)(xb + (size_t)m * DM) + F.lane;
#pragma unroll
            for (int j = 0; j < 4; ++j) { const f32x4 gj = ((const f32x4*)gam)[F.lane + 64 * j], bj = ((const f32x4*)bet)[F.lane + 64 * j];
                v[rr][j] = v[rr][j] * rstd[rr] * gj + bj; xr[64 * j] = v[rr][j];
                if (write_bf16) { u32x2 w2; w2.x = cvtpk(v[rr][j][0], v[rr][j][1]); w2.y = cvtpk(v[rr][j][2], v[rr][j][3]); o8[64 * j] = w2; } } } }
    }
}
__device__ __forceinline__ void scale_phase(Frame& F, const float* src, float* dst) {
    const int gw = F.vcu * NWAVES + F.wave, NGW = F.G * NWAVES;
    for (int m = gw; m < NTOK; m += NGW) {
        const f32x4* xr = (const f32x4*)(src + (size_t)m * DM) + F.lane; f32x4* o = (f32x4*)(dst + (size_t)m * DM) + F.lane;
#pragma unroll
        for (int j = 0; j < 4; ++j) o[64 * j] = xr[64 * j] * ALPHA;
    }
}

__device__ __forceinline__ int q_next(Frame& F, int q) {
    __syncthreads();
    if (F.tid == 0) F.LC[LC_Q] = __hip_atomic_fetch_add(F.ctl + CW_QUEUE + 64 * q, 1u, RLX_AGENT);
    __syncthreads();
    return (int)F.LC[LC_Q];
}

__device__ __forceinline__ void ssm_pow_tables(Frame& F, const Args& A) {
    f32x2* apow = (f32x2*)(A.ws + WS_APOW); f32x2* ftab = (f32x2*)(A.ws + WS_FTAB);
    const int gt = F.vcu * NTHR + F.tid, NGT = F.G * NTHR;
    for (int it = gt; it < 32 * 64 * 65; it += NGT) {
        const int n = it % 65, gp = it / 65, g = gp >> 6;
        const double dt = exp((double)A.in[I_LOGDT][g]);
        const double lr = (double)A.in[I_LAMRE][gp], li = (double)A.in[I_LAMIM][gp];
        const double mag = exp(lr * dt * (double)n);
        double th = li * dt * (double)n; th -= 6.283185307179586476925 * rint(th * 0.15915494309189533577);
        const double c = cos(th), s = sin(th);
        apow[it] = (f32x2){(float)(mag * c), (float)(mag * s)};
        if (n == 1) { const double are = mag * c, aim = mag * s, nr = are - 1.0, den = lr * lr + li * li;
            ftab[gp] = (f32x2){(float)((nr * lr + aim * li) / den), (float)((aim * lr - nr * li) / den)}; }
    }
}
__device__ __forceinline__ void ssm_frag_tables(Frame& F, const Args& A) {
    const f32x2* apow = (const f32x2*)(A.ws + WS_APOW); const f32x2* ftab = (const f32x2*)(A.ws + WS_FTAB);
    const float* bre = A.in[I_BRE]; const float* bim = A.in[I_BIM]; const float* cre = A.in[I_CRE]; const float* cim = A.in[I_CIM];
    const int gt = F.vcu * NTHR + F.tid, NGT = F.G * NTHR;
    constexpr int N_KF = 32 * 64 * 64, N_WF = 32 * 8 * 32 * 64, N_VF = 32 * 64 * 4 * 64;
    for (int it = gt; it < N_KF + N_WF + N_VF; it += NGT) {
        float v[8];
        if (it < N_KF) {
            const int lane = it & 63, tau0 = (it >> 6) & 63, g = it >> 12;
            const int h = lane & 15, kq = lane >> 4, jj = kq >> 1, hb = (kq & 1) * 8, tau = tau0 - jj;
#pragma unroll
            for (int e = 0; e < 8; ++e) v[e] = 0.f;
            if (tau >= 0) {
                for (int p = 0; p < 64; ++p) {
                    const int gp = g * 64 + p; const f32x2 a = apow[gp * 65 + tau], f = ftab[gp];
                    const float cr = cre[(g * 16 + h) * 64 + p], ci = cim[(g * 16 + h) * 64 + p];
                    const float mr = cr * a[0] - ci * a[1], mi = cr * a[1] + ci * a[0];
                    const float nr = mr * f[0] - mi * f[1], ni = mr * f[1] + mi * f[0];
#pragma unroll
                    for (int e = 0; e < 8; ++e) { const float br = bre[gp * 16 + hb + e], bi = bim[gp * 16 + hb + e]; v[e] += nr * br - ni * bi; }
                }
            }
            u32x4 w; w.x = cvtpk(v[0], v[1]); w.y = cvtpk(v[2], v[3]); w.z = cvtpk(v[4], v[5]); w.w = cvtpk(v[6], v[7]);
            ((u32x4*)(A.ws + SSM_KF))[it] = w;
        } else if (it < N_KF + N_WF) {
            const int r = it - N_KF; const int lane = r & 63, js = (r >> 6) & 31, mt = (r >> 11) & 7, g = r >> 14;
            const int rr = 16 * mt + (lane & 15), ri = rr >> 6, p = rr & 63, kq = lane >> 4, j = 2 * js + (kq >> 1), hb = (kq & 1) * 8;
            const int gp = g * 64 + p; const f32x2 a = apow[gp * 65 + (63 - j)], f = ftab[gp];
            const float mr = a[0] * f[0] - a[1] * f[1], mi = a[0] * f[1] + a[1] * f[0];
#pragma unroll
            for (int e = 0; e < 8; ++e) { const float br = bre[gp * 16 + hb + e], bi = bim[gp * 16 + hb + e]; v[e] = ri == 0 ? (mr * br - mi * bi) : (mr * bi + mi * br); }
            u32x4 w; w.x = cvtpk(v[0], v[1]); w.y = cvtpk(v[2], v[3]); w.z = cvtpk(v[4], v[5]); w.w = cvtpk(v[6], v[7]);
            ((u32x4*)(A.ws + SSM_WF))[r] = w;
        } else {
            const int r = it - N_KF - N_WF; const int lane = r & 63, ks = (r >> 6) & 3, i = (r >> 8) & 63, g = r >> 14;
            const int h = lane & 15, kq = lane >> 4;
#pragma unroll
            for (int e = 0; e < 8; ++e) { const int rr = 32 * ks + 8 * kq + e, ri = rr >> 6, p = rr & 63, gp = g * 64 + p; const f32x2 a = apow[gp * 65 + i + 1];
                const float cr = cre[(g * 16 + h) * 64 + p], ci = cim[(g * 16 + h) * 64 + p];
                v[e] = ri == 0 ? (cr * a[0] - ci * a[1]) : -(cr * a[1] + ci * a[0]); }
            u32x4 w; w.x = cvtpk(v[0], v[1]); w.y = cvtpk(v[2], v[3]); w.z = cvtpk(v[4], v[5]); w.w = cvtpk(v[6], v[7]);
            ((u32x4*)(A.ws + SSM_VF))[r] = w;
        }
    }
}

constexpr int SS_KF = 0, SS_UB = 65536, SS_S = 131072, SS_XP = 147456;
__device__ __forceinline__ void ssm_unit(Frame& F, const Args& A, int b, int g) {
    const bf16_t* qkvu = (const bf16_t*)(A.ws + WS_ARENA); bf16_t* hbuf = (bf16_t*)(A.ws + WS_H);
    const int lane = F.lane, w = F.wave, fr = lane & 15, kq = lane >> 4;
    LAS unsigned char* L = F.lds;
    const u32x4* kfsrc = (const u32x4*)(A.ws + SSM_KF) + (size_t)g * 4096;
#pragma unroll
    for (int i = 0; i < 8; ++i) { const int idx = F.tid + i * NTHR; *(LAS u32x4*)(L + SS_KF + idx * 16) = kfsrc[idx]; }
#pragma unroll
    for (int i = 0; i < 8; ++i) { const int idx = F.tid + i * NTHR; const int ln = idx & 63, nt = (idx >> 6) & 1, js = idx >> 7;
        const int c = 16 * nt + (ln & 15), q4 = ln >> 4, tok = 64 * c + 2 * js + (q4 >> 1);
        *(LAS u32x4*)(L + SS_UB + idx * 16) = *(const u32x4*)(qkvu + (size_t)(b * SEQ + tok) * 2048 + 1536 + 16 * g + (q4 & 1) * 8); }
    __syncthreads();
    {
        f32x4 a0 = {0.f, 0.f, 0.f, 0.f}, a1 = {0.f, 0.f, 0.f, 0.f};
        const bf16x8* wf = (const bf16x8*)(A.ws + SSM_WF) + ((size_t)(g * 8 + w) * 32) * 64 + lane;
#pragma unroll 4
        for (int js = 0; js < 32; ++js) {
            const bf16x8 af = wf[js * 64];
            const bf16x8 b0 = *(const LAS bf16x8*)(L + SS_UB + ((js * 2 + 0) * 64 + lane) * 16), b1 = *(const LAS bf16x8*)(L + SS_UB + ((js * 2 + 1) * 64 + lane) * 16);
            a0 = __builtin_amdgcn_mfma_f32_16x16x32_bf16(af, b0, a0, 0, 0, 0); a1 = __builtin_amdgcn_mfma_f32_16x16x32_bf16(af, b1, a1, 0, 0, 0);
        }
        LAS float* S = (LAS float*)(L + SS_S);
#pragma unroll
        for (int r = 0; r < 4; ++r) { S[(16 * w + 4 * kq + r) * 32 + fr] = a0[r]; S[(16 * w + 4 * kq + r) * 32 + 16 + fr] = a1[r]; }
    }
    __syncthreads();
    if (w == 0) {
        const f32x2 a64 = ((const f32x2*)(A.ws + WS_APOW))[(g * 64 + lane) * 65 + 64];
        const LAS float* S = (const LAS float*)(L + SS_S); LAS bf16_t* Xp = (LAS bf16_t*)(L + SS_XP);
        float xr = 0.f, xi = 0.f;
        for (int c = 0; c < 32; ++c) {
            const unsigned pk = cvtpk(xr, xi);
            Xp[c * 128 + lane] = (bf16_t)(pk & 0xffffu); Xp[c * 128 + 64 + lane] = (bf16_t)(pk >> 16);
            const float sr = S[lane * 32 + c], si = S[(64 + lane) * 32 + c];
            const float nr = a64[0] * xr - a64[1] * xi + sr, ni = a64[0] * xi + a64[1] * xr + si;
            xr = nr; xi = ni;
        }
    }
    __syncthreads();
    const float* dsk = A.in[I_SSMD] + 16 * g + 4 * kq;
    const f32x4 dv = *(const f32x4*)dsk;
    for (int ii = 0; ii < 8; ++ii) {
        const int i = w + 8 * ii;
        f32x4 a0 = {0.f, 0.f, 0.f, 0.f}, a1 = {0.f, 0.f, 0.f, 0.f};
        const bf16x8* vf = (const bf16x8*)(A.ws + SSM_VF) + ((size_t)(g * 64 + i) * 4) * 64 + lane;
#pragma unroll
        for (int ks = 0; ks < 4; ++ks) {
            const bf16x8 af = vf[ks * 64];
            const bf16x8 b0 = *(const LAS bf16x8*)(L + SS_XP + (fr * 128 + 32 * ks + 8 * kq) * 2), b1 = *(const LAS bf16x8*)(L + SS_XP + ((16 + fr) * 128 + 32 * ks + 8 * kq) * 2);
            a0 = __builtin_amdgcn_mfma_f32_16x16x32_bf16(af, b0, a0, 0, 0, 0); a1 = __builtin_amdgcn_mfma_f32_16x16x32_bf16(af, b1, a1, 0, 0, 0);
        }
        const int njs = (i >> 1) + 1;
        for (int js = 0; js < njs; ++js) {
            const bf16x8 af = *(const LAS bf16x8*)(L + SS_KF + ((i - 2 * js) * 64 + lane) * 16);
            const bf16x8 b0 = *(const LAS bf16x8*)(L + SS_UB + ((js * 2 + 0) * 64 + lane) * 16), b1 = *(const LAS bf16x8*)(L + SS_UB + ((js * 2 + 1) * 64 + lane) * 16);
            a0 = __builtin_amdgcn_mfma_f32_16x16x32_bf16(af, b0, a0, 0, 0, 0); a1 = __builtin_amdgcn_mfma_f32_16x16x32_bf16(af, b1, a1, 0, 0, 0);
        }
#pragma unroll
        for (int nt = 0; nt < 2; ++nt) {
            const f32x4 acc = nt ? a1 : a0; const int tok = 64 * (16 * nt + fr) + i; const size_t row = (size_t)(b * SEQ + tok);
            const u32x2 uu = *(const u32x2*)(qkvu + row * 2048 + 1536 + 16 * g + 4 * kq);
            const float y0 = acc[0] + dv[0] * bf_lo(uu.x), y1 = acc[1] + dv[1] * bf_hi(uu.x), y2 = acc[2] + dv[2] * bf_lo(uu.y), y3 = acc[3] + dv[3] * bf_hi(uu.y);
            u32x2 o; o.x = cvtpk(gelu_tanh(y0), gelu_tanh(y1)); o.y = cvtpk(gelu_tanh(y2), gelu_tanh(y3));
            *(u32x2*)(hbuf + row * 512 + 16 * g + 4 * kq) = o;
        }
    }
}

__device__ __forceinline__ int crow(int r, int hi) { return (r & 3) + 8 * (r >> 2) + 4 * hi; }
__device__ __forceinline__ void qkt_tile(f32x16& p0, f32x16& p1, const LAS unsigned char* Ks, const bf16x8 (&qr)[4], int r32, int hi) {
    const LAS unsigned char* kb = Ks + hi * 1024 + r32 * 16;
    p0 = (f32x16){}; p1 = (f32x16){};
#pragma unroll
    for (int d0 = 0; d0 < 4; ++d0) {
        const bf16x8 b0 = *(const LAS bf16x8*)(kb + d0 * 2048), b1 = *(const LAS bf16x8*)(kb + d0 * 2048 + 512);
        p0 = __builtin_amdgcn_mfma_f32_32x32x16_bf16(b0, qr[d0], p0, 0, 0, 0); p1 = __builtin_amdgcn_mfma_f32_32x32x16_bf16(b1, qr[d0], p1, 0, 0, 0);
    }
}
__device__ __forceinline__ s16x4 vtr(const LAS unsigned char* p) { typedef short v4i16_t __attribute__((ext_vector_type(4))); return __builtin_bit_cast(s16x4, __builtin_amdgcn_ds_read_tr16_b64_v4i16((LAS v4i16_t*)p)); }
__device__ __forceinline__ void pv_tile(f32x16 (&o)[2], const LAS unsigned char* Vs, const f32x16& p0, const f32x16& p1, int lane) {
    const int hi = lane >> 5;
    const LAS unsigned char* vb = Vs + ((lane >> 4) & 1) * 32 + (lane & 3) * 8 + (4 * hi + ((lane & 15) >> 2)) * 64;
    u32x4 pw[4];
#pragma unroll
    for (int s = 0; s < 2; ++s) {
        pw[s] = (u32x4){cvtpk(p0[8 * s], p0[8 * s + 1]), cvtpk(p0[8 * s + 2], p0[8 * s + 3]), cvtpk(p0[8 * s + 4], p0[8 * s + 5]), cvtpk(p0[8 * s + 6], p0[8 * s + 7])};
        pw[2 + s] = (u32x4){cvtpk(p1[8 * s], p1[8 * s + 1]), cvtpk(p1[8 * s + 2], p1[8 * s + 3]), cvtpk(p1[8 * s + 4], p1[8 * s + 5]), cvtpk(p1[8 * s + 6], p1[8 * s + 7])};
    }
#pragma unroll
    for (int d0 = 0; d0 < 2; ++d0)
#pragma unroll
        for (int ks = 0; ks < 4; ++ks) {
            const s16x4 lo = vtr(vb + d0 * 4096 + ks * 1024), hh = vtr(vb + d0 * 4096 + ks * 1024 + 512);
            const bf16x8 vf = (bf16x8){lo[0], lo[1], lo[2], lo[3], hh[0], hh[1], hh[2], hh[3]};
            o[d0] = __builtin_amdgcn_mfma_f32_32x32x16_bf16(__builtin_bit_cast(bf16x8, pw[ks]), vf, o[d0], 0, 0, 0);
        }
}
__device__ __forceinline__ void kv_load(u32x4& kreg, u32x4& vreg, const bf16_t* Kbase, const bf16_t* Vbase, int pitch, int key0, int wave, int lane) {
    kreg = *(const u32x4*)(Kbase + (size_t)(key0 + lane) * pitch + wave * 8);
    vreg = *(const u32x4*)(Vbase + (size_t)(key0 + 16 * (wave & 3) + (lane >> 2)) * pitch + (wave >> 2) * 32 + (lane & 3) * 8);
}
__device__ __forceinline__ void kv_store(LAS unsigned char* Ks, LAS unsigned char* Vs, const u32x4& kreg, const u32x4& vreg, int wave, int lane) {
    *(LAS u32x4*)(Ks + wave * 1024 + lane * 16) = kreg; *(LAS u32x4*)(Vs + wave * 1024 + lane * 16) = vreg;
}
__device__ __forceinline__ void o_store(const f32x16 (&o)[2], bf16_t* dst, int pitch, int lane) {
    const int hi = lane >> 5, c = lane & 31;
#pragma unroll
    for (int d0 = 0; d0 < 2; ++d0)
#pragma unroll
        for (int r = 0; r < 16; ++r) { const unsigned pk = cvtpk(o[d0][r], 0.f); dst[(size_t)crow(r, hi) * pitch + 32 * d0 + c] = (bf16_t)(pk & 0xffffu); }
}

constexpr int AT_K = 0, AT_V = 8192, AT_DONE = 16384;
constexpr float SB_DONE = -110.0f;
__device__ __forceinline__ void sb_unit(Frame& F, const Args& A, int b, int h, int qb) {
    const bf16_t* qkvu = (const bf16_t*)(A.ws + WS_ARENA); bf16_t* cat = (bf16_t*)(A.ws + WS_CAT);
    const int lane = F.lane, w = F.wave, r32 = lane & 31, hi = lane >> 5;
    const int t0 = qb * 256, trow = t0 + 32 * w + r32;
    const bf16_t* Qp = qkvu + (size_t)(b * SEQ + trow) * 2048 + h * 64 + hi * 8;
    const bf16_t* Kb = qkvu + (size_t)(b * SEQ) * 2048 + 512 + h * 64; const bf16_t* Vb = qkvu + (size_t)(b * SEQ) * 2048 + 1024 + h * 64;
    bf16x8 qr[4];
#pragma unroll
    for (int d0 = 0; d0 < 4; ++d0) qr[d0] = *(const bf16x8*)(Qp + 16 * d0);
    f32x16 o[2]; o[0] = (f32x16){}; o[1] = (f32x16){};
    float carry = 0.f; bool wdone = false;
    LAS unsigned char* Ks = F.lds + AT_K; LAS unsigned char* Vs = F.lds + AT_V; volatile LAS unsigned* donec = (volatile LAS unsigned*)(F.lds + AT_DONE);
    if (F.tid == 0) donec[0] = 0u;
    u32x4 kreg, vreg;
    const int kt_hi = 4 * qb + 3;
    kv_load(kreg, vreg, Kb, Vb, 2048, 64 * kt_hi, w, lane);
    for (int kt = kt_hi; kt >= 0; --kt) {
        __syncthreads();
        if (donec[0] == 8u) break;
        kv_store(Ks, Vs, kreg, vreg, w, lane);
        if (kt > 0) kv_load(kreg, vreg, Kb, Vb, 2048, 64 * (kt - 1), w, lane);
        __syncthreads();
        if (!wdone && 64 * kt <= t0 + 32 * w + 30) {
            f32x16 p0, p1; qkt_tile(p0, p1, Ks, qr, r32, hi);
            float l0[16], l1[16];
#pragma unroll
            for (int r = 0; r < 16; ++r) {
                const int kv = 64 * kt + crow(r, hi);
                { const float z = p0[r] * 0.125f; const float sp = fmaxf(z, 0.f) + 0.6931471805599453f * __builtin_amdgcn_logf(1.0f + fast_exp(-fabsf(z))); const bool ok = kv < trow; l0[r] = ok ? -sp : 0.f; p0[r] = ok ? (z - sp) : -1.0e30f; }
                { const float z = p1[r] * 0.125f; const float sp = fmaxf(z, 0.f) + 0.6931471805599453f * __builtin_amdgcn_logf(1.0f + fast_exp(-fabsf(z))); const bool ok = (kv + 32) < trow; l1[r] = ok ? -sp : 0.f; p1[r] = ok ? (z - sp) : -1.0e30f; }
            }
            float gs[8], og[8];
#pragma unroll
            for (int rg = 0; rg < 4; ++rg) { gs[rg] = (l0[4 * rg] + l0[4 * rg + 1]) + (l0[4 * rg + 2] + l0[4 * rg + 3]); gs[4 + rg] = (l1[4 * rg] + l1[4 * rg + 1]) + (l1[4 * rg + 2] + l1[4 * rg + 3]); }
#pragma unroll
            for (int k = 0; k < 8; ++k) og[k] = __shfl_xor(gs[k], 32);
            float sfx[8]; float run = 0.f;
#pragma unroll
            for (int k = 7; k >= 0; --k) {
                const float g_even = hi ? og[k] : gs[k], g_odd = hi ? gs[k] : og[k];
                const float s_odd = run; run += g_odd; const float s_even = run; run += g_even;
                sfx[k] = hi ? s_odd : s_even;
            }
#pragma unroll
            for (int rg = 0; rg < 4; ++rg) {
                { const float base = carry + sfx[rg]; const float a3 = base, a2 = a3 + l0[4 * rg + 3], a1 = a2 + l0[4 * rg + 2], a0 = a1 + l0[4 * rg + 1];
                  p0[4 * rg] = fast_exp(p0[4 * rg] + a0); p0[4 * rg + 1] = fast_exp(p0[4 * rg + 1] + a1); p0[4 * rg + 2] = fast_exp(p0[4 * rg + 2] + a2); p0[4 * rg + 3] = fast_exp(p0[4 * rg + 3] + a3); }
                { const float base = carry + sfx[4 + rg]; const float a3 = base, a2 = a3 + l1[4 * rg + 3], a1 = a2 + l1[4 * rg + 2], a0 = a1 + l1[4 * rg + 1];
                  p1[4 * rg] = fast_exp(p1[4 * rg] + a0); p1[4 * rg + 1] = fast_exp(p1[4 * rg + 1] + a1); p1[4 * rg + 2] = fast_exp(p1[4 * rg + 2] + a2); p1[4 * rg + 3] = fast_exp(p1[4 * rg + 3] + a3); }
            }
            carry += run;
            pv_tile(o, Vs, p0, p1, lane);
            if (__all(carry < SB_DONE)) { wdone = true; if (lane == 0) __hip_atomic_fetch_add((LAS unsigned*)(F.lds + AT_DONE), 1u, __ATOMIC_RELAXED, __HIP_MEMORY_SCOPE_WORKGROUP); }
        }
    }
    o_store(o, cat + (size_t)(b * SEQ + t0 + 32 * w) * 1024 + h * 64, 1024, lane);
}

__device__ __forceinline__ void l0_mixer_phase(Frame& F, const Args& A, int qid) {
    for (int u = blockIdx.x; u < 256; u += F.G) { __syncthreads(); ssm_unit(F, A, u >> 5, u & 31); }
    for (;;) {
        const int t = q_next(F, qid);
        if (t >= 512) break;
        sb_unit(F, A, (t & 63) >> 3, t & 7, 7 - (t >> 6));
    }
}

__device__ __forceinline__ void nsa_small_tables(Frame& F, const Args& A) {
    const int gt = F.vcu * NTHR + F.tid, NGT = F.G * NTHR;
    float* rc = (float*)(A.ws + WS_ROPE); float* rs = rc + 2048 * 32;
    for (int it = gt; it < 2048 * 32; it += NGT) {
        const int pos = it >> 5, i = it & 31;
        const double inv = exp(-9.210340371976182736 * (double)i / 32.0);
        double th = (double)pos * inv; th -= 6.283185307179586476925 * rint(th * 0.15915494309189533577);
        rc[it] = (float)cos(th); rs[it] = (float)sin(th);
    }
    {
        float* part = (float*)(A.ws + WS_CBIAS) + 512;
        const int gwv = F.vcu * NWAVES + F.wave, NGWV = F.G * NWAVES;
        for (int task = gwv; task < 128; task += NGWV) {
            const int kv = task >> 6, kc = task & 63; const float* pos = A.in[kv ? I_CPV : I_CPK]; const float* w1 = A.in[kv ? I_CW1V : I_CW1K];
            f32x4 acc = {0.f, 0.f, 0.f, 0.f};
#pragma unroll 8
            for (int i = 0; i < 32; ++i) { const int kk = kc * 32 + i; const f32x4 w = ((const f32x4*)(w1 + (size_t)kk * 256))[F.lane]; acc += w * pos[kk]; }
            ((f32x4*)(part + (size_t)(kc * 2 + kv) * 256))[F.lane] = acc;
        }
    }
    bf16_t* w2t = (bf16_t*)(A.ws + WS_CW2T);
    for (int it = gt; it < 2 * 64 * 256; it += NGT) {
        const int kv = it >> 14, n = (it >> 8) & 63, k = it & 255; const float* w2 = A.in[kv ? I_CW2V : I_CW2K];
        w2t[it] = (bf16_t)(cvtpk(w2[k * 64 + n], 0.f) & 0xffffu);
    }
}

__device__ __forceinline__ void nsa_cbias_final(Frame& F, const Args& A) {
    if (blockIdx.x == 0) { float* cb = (float*)(A.ws + WS_CBIAS); const float* part = cb + 512; const int kv = F.tid >> 8, n = F.tid & 255; float s = 0.f;
        for (int kc = 0; kc < 64; ++kc) s += part[(size_t)(kc * 2 + kv) * 256 + n];
        cb[F.tid] = s; }
}
constexpr int CP_A = 0, CP_B = 2 * 64 * 144, CP_H = CP_B + 2 * 256 * 144;
__device__ __forceinline__ void cmp_unit(Frame& F, const Args& A, int kv, int rb) {
    const bf16_t* proj = (const bf16_t*)(A.ws + WS_ARENA);
    const bf16_t* w1t = (const bf16_t*)(A.ws + WS_CW1T) + (size_t)kv * 256 * 2048;
    const bf16_t* w2t = (const bf16_t*)(A.ws + WS_CW2T) + kv * 64 * 256;
    const float* cb = (const float*)(A.ws + WS_CBIAS) + kv * 256;
    bf16_t* outp = (bf16_t*)(A.ws + WS_KCMP) + (size_t)kv * (8 * 4 * 128 * 64);
    const int lane = F.lane, w = F.wave, fr = lane & 15, kq = lane >> 4, tid = F.tid;
    LAS unsigned char* L = F.lds;
    const int arow = tid >> 3, ach = tid & 7;
    const int R = rb * 64 + arow, ab = R >> 9, am = (R >> 2) & 127, ag = R & 3;
    const bf16_t* asrc = proj + (size_t)(ab * SEQ + 16 * am) * 2560 + (kv ? 1280 : 1024) + ag * 64 + ach * 8;
    const bf16_t* bsrc = w1t + (size_t)(tid >> 3) * 2048 + ach * 8;
    u32x4 areg, breg[4];
    areg = *(const u32x4*)asrc;
#pragma unroll
    for (int i = 0; i < 4; ++i) breg[i] = *(const u32x4*)(bsrc + (size_t)i * 64 * 2048);
    f32x4 acc[4][2];
#pragma unroll
    for (int m = 0; m < 4; ++m) { acc[m][0] = (f32x4){0.f, 0.f, 0.f, 0.f}; acc[m][1] = (f32x4){0.f, 0.f, 0.f, 0.f}; }
    for (int l = 0; l < 32; ++l) {
        const int buf = l & 1;
        *(LAS u32x4*)(L + CP_A + buf * 9216 + arow * 144 + ach * 16) = areg;
#pragma unroll
        for (int i = 0; i < 4; ++i) *(LAS u32x4*)(L + CP_B + buf * 36864 + ((tid >> 3) + 64 * i) * 144 + ach * 16) = breg[i];
        if (l < 31) { areg = *(const u32x4*)(asrc + (size_t)(l + 1) * 2560);
#pragma unroll
            for (int i = 0; i < 4; ++i) breg[i] = *(const u32x4*)(bsrc + (size_t)i * 64 * 2048 + (l + 1) * 64); }
        __syncthreads();
#pragma unroll
        for (int ks = 0; ks < 2; ++ks) {
            bf16x8 af[4], bfv[2];
#pragma unroll
            for (int m = 0; m < 4; ++m) af[m] = *(const LAS bf16x8*)(L + CP_A + buf * 9216 + (16 * m + fr) * 144 + (32 * ks + 8 * kq) * 2);
#pragma unroll
            for (int n = 0; n < 2; ++n) bfv[n] = *(const LAS bf16x8*)(L + CP_B + buf * 36864 + (32 * w + 16 * n + fr) * 144 + (32 * ks + 8 * kq) * 2);
#pragma unroll
            for (int m = 0; m < 4; ++m)
#pragma unroll
                for (int n = 0; n < 2; ++n) acc[m][n] = __builtin_amdgcn_mfma_f32_16x16x32_bf16(bfv[n], af[m], acc[m][n], 0, 0, 0);
        }
    }
    __syncthreads();
#pragma unroll
    for (int m = 0; m < 4; ++m)
#pragma unroll
        for (int n = 0; n < 2; ++n) { const int col = 32 * w + 16 * n + 4 * kq; const f32x4 bv = *(const f32x4*)(cb + col); const f32x4 v = acc[m][n] + bv;
            u32x2 o; o.x = cvtpk(gelu_tanh(v[0]), gelu_tanh(v[1])); o.y = cvtpk(gelu_tanh(v[2]), gelu_tanh(v[3]));
            *(LAS u32x2*)(L + CP_H + ((16 * m + fr) * 264 + col) * 2) = o; }
    __syncthreads();
    {
        const int rt = w >> 1, c0 = w & 1;
        f32x4 o0 = {0.f, 0.f, 0.f, 0.f}, o1 = {0.f, 0.f, 0.f, 0.f};
#pragma unroll
        for (int ks = 0; ks < 8; ++ks) {
            const bf16x8 af = *(const LAS bf16x8*)(L + CP_H + ((16 * rt + fr) * 264 + 32 * ks + 8 * kq) * 2);
            const bf16x8 b0 = *(const bf16x8*)(w2t + (16 * c0 + fr) * 256 + 32 * ks + 8 * kq), b1 = *(const bf16x8*)(w2t + (16 * (c0 + 2) + fr) * 256 + 32 * ks + 8 * kq);
            o0 = __builtin_amdgcn_mfma_f32_16x16x32_bf16(af, b0, o0, 0, 0, 0); o1 = __builtin_amdgcn_mfma_f32_16x16x32_bf16(af, b1, o1, 0, 0, 0);
        }
        const float* rc = (const float*)(A.ws + WS_ROPE); const float* rs = rc + 2048 * 32;
#pragma unroll
        for (int r = 0; r < 4; ++r) {
            const int Rr = rb * 64 + 16 * rt + 4 * kq + r, b = Rr >> 9, m = (Rr >> 2) & 127, g = Rr & 3, d = 16 * c0 + fr;
            float x1 = o0[r], x2 = o1[r];
            if (kv == 0) { const int pos = (16 * m + 31) & 2047; const float c = rc[pos * 32 + d], s = rs[pos * 32 + d]; const float y1 = x1 * c - x2 * s, y2 = x1 * s + x2 * c; x1 = y1; x2 = y2; }
            if (m == 127) { x1 = 0.f; x2 = 0.f; }
            bf16_t* op = outp + ((size_t)((b * 4 + g) * 128 + m)) * 64;
            op[d] = (bf16_t)(cvtpk(x1, 0.f) & 0xffffu); op[d + 32] = (bf16_t)(cvtpk(x2, 0.f) & 0xffffu);
        }
    }
}

constexpr int NA_K = 0, NA_V = 16384, NA_GS = 32768, NA_LS = 40960, NA_MASK = 49152, NA_WSF = 49152 + 512, NA_STASH = 65536;
__device__ __forceinline__ float half_max(float v) { return fmaxf(v, __shfl_xor(v, 32)); }
__device__ __forceinline__ float half_sum(float v) { return v + __shfl_xor(v, 32); }
__device__ __forceinline__ float tile_max(const f32x16& p0, const f32x16& p1) {
    float a = fmaxf(p0[0], p1[0]);
#pragma unroll
    for (int r = 1; r < 16; ++r) a = fmaxf(a, fmaxf(p0[r], p1[r]));
    return half_max(a);
}
__device__ __forceinline__ float tile_sum(const f32x16& p0, const f32x16& p1) {
    float a = 0.f, b = 0.f;
#pragma unroll
    for (int r = 0; r < 16; ++r) { a += p0[r]; b += p1[r]; }
    return half_sum(a + b);
}
__device__ __forceinline__ void o_rows_mul(f32x16 (&o)[2], LAS float* wsf, float f, int r32, int hi) {
    if (hi == 0) wsf[r32] = f;
    LDS_WAIT();
#pragma unroll
    for (int r = 0; r < 16; ++r) { const float fr_ = wsf[crow(r, hi)]; o[0][r] *= fr_; o[1][r] *= fr_; }
    LDS_WAIT();
}
__device__ __forceinline__ void o_rows_fma(f32x16 (&ot)[2], const f32x16 (&o)[2], LAS float* wsf, float f, int r32, int hi) {
    if (hi == 0) wsf[r32] = f;
    LDS_WAIT();
#pragma unroll
    for (int r = 0; r < 16; ++r) { const float fr_ = wsf[crow(r, hi)]; ot[0][r] += o[0][r] * fr_; ot[1][r] += o[1][r] * fr_; }
    LDS_WAIT();
}
template <bool MASKED, class MaskF>
__device__ __forceinline__ void flash_step(f32x16 (&o)[2], float& m_run, float& l_run, f32x16& p0, f32x16& p1, bool rowok, const MaskF& ok, LAS float* wsf, const LAS unsigned char* Vs, int lane, int r32, int hi) {
    if (MASKED) {
#pragma unroll
        for (int r = 0; r < 16; ++r) { p0[r] = ok(r, 0) ? p0[r] : -1.0e30f; p1[r] = ok(r, 1) ? p1[r] : -1.0e30f; }
    }
    float mx = tile_max(p0, p1); mx = rowok ? mx : -1.0e30f;
    const float m_new = fmaxf(m_run, mx);
    if (!__all(m_new == m_run)) { const float alpha = __builtin_amdgcn_exp2f(m_run - m_new); l_run *= alpha; o_rows_mul(o, wsf, alpha, r32, hi); m_run = m_new; }
    const float msub = rowok ? m_run : 3.0e38f;
#pragma unroll
    for (int r = 0; r < 16; ++r) { p0[r] = __builtin_amdgcn_exp2f(p0[r] - msub); p1[r] = __builtin_amdgcn_exp2f(p1[r] - msub); }
    if (MASKED) {
#pragma unroll
        for (int r = 0; r < 16; ++r) { p0[r] = ok(r, 0) ? p0[r] : 0.f; p1[r] = ok(r, 1) ? p1[r] : 0.f; }
    }
    l_run += tile_sum(p0, p1);
    pv_tile(o, Vs, p0, p1, lane);
}

__device__ __forceinline__ void nsa_unit(Frame& F, const Args& A, int b, int g, int qt) {
    const bf16_t* proj = (const bf16_t*)(A.ws + WS_ARENA); bf16_t* cat = (bf16_t*)(A.ws + WS_CAT);
    const bf16_t* kc = (const bf16_t*)(A.ws + WS_KCMP) + (size_t)((b * 4 + g) * 128) * 64; const bf16_t* vc = kc + (size_t)(8 * 4 * 128 * 64);
    const float* gate = (const float*)(A.ws + WS_GATE);
    const int lane = (int)__builtin_amdgcn_mbcnt_hi(~0u, __builtin_amdgcn_mbcnt_lo(~0u, 0u)), w = F.wave, r32 = lane & 31, hi = lane >> 5, tid = w * 64 + lane;
    const int t0 = qt * 64, tl = r32 >> 2, hr = r32 & 3, tok = t0 + 8 * w + tl;
    const size_t qrow = (size_t)(b * SEQ + tok);
    LAS unsigned char* L = F.lds;
    LAS float* wsf = (LAS float*)(L + NA_WSF) + w * 32;
    bf16x8 qr[4];
#pragma unroll
    for (int d0 = 0; d0 < 4; ++d0) qr[d0] = *(const bf16x8*)(proj + qrow * 2560 + (g * 4 + hr) * 64 + 16 * d0 + 8 * hi);
    const float g0 = gate[qrow * 48 + (g * 4 + hr) * 3 + 0], g1 = gate[qrow * 48 + (g * 4 + hr) * 3 + 1], g2 = gate[qrow * 48 + (g * 4 + hr) * 3 + 2];
    LAS float* stash = (LAS float*)(L + NA_STASH) + w * 2048;
    u32x4 kreg, vreg;
    const bf16_t* Ksb = proj + (size_t)(b * SEQ) * 2560 + 1536 + g * 64; const bf16_t* Vsb = proj + (size_t)(b * SEQ) * 2560 + 1792 + g * 64;
    const bf16_t* Kwb = proj + (size_t)(b * SEQ) * 2560 + 2048 + g * 64; const bf16_t* Vwb = proj + (size_t)(b * SEQ) * 2560 + 2304 + g * 64;
    const bool two = t0 >= 1024;
    __syncthreads();
    kv_load(kreg, vreg, kc, vc, 64, 0, w, lane); kv_store(L + NA_K, L + NA_V, kreg, vreg, w, lane);
    if (two) { kv_load(kreg, vreg, kc, vc, 64, 64, w, lane); kv_store(L + NA_K + 8192, L + NA_V + 8192, kreg, vreg, w, lane); }
    __syncthreads();
    {
        f32x16 ot[2]; ot[0] = (f32x16){}; ot[1] = (f32x16){};
        f32x16 pa0, pa1, pb0, pb1; pb0 = (f32x16){}; pb1 = (f32x16){};
        qkt_tile(pa0, pa1, L + NA_K, qr, r32, hi);
        if (two) qkt_tile(pb0, pb1, L + NA_K + 8192, qr, r32, hi);
        const int mv = tok >= 31 ? ((tok - 31) >> 4) : -1;
        float mx = -1.0e30f;
#pragma unroll
        for (int r = 0; r < 16; ++r) { const int m = crow(r, hi);
            pa0[r] = (m <= mv) ? pa0[r] : -1.0e30f; pa1[r] = (m + 32 <= mv) ? pa1[r] : -1.0e30f; pb0[r] = (m + 64 <= mv) ? pb0[r] : -1.0e30f; pb1[r] = (m + 96 <= mv) ? pb1[r] : -1.0e30f;
            mx = fmaxf(fmaxf(mx, fmaxf(pa0[r], pa1[r])), fmaxf(pb0[r], pb1[r])); }
        mx = half_max(mx);
        float sum = 0.f;
#pragma unroll
        for (int r = 0; r < 16; ++r) { const int m = crow(r, hi);
            pa0[r] = (m <= mv) ? __builtin_amdgcn_exp2f(pa0[r] - mx) : 0.f; pa1[r] = (m + 32 <= mv) ? __builtin_amdgcn_exp2f(pa1[r] - mx) : 0.f;
            pb0[r] = (m + 64 <= mv) ? __builtin_amdgcn_exp2f(pb0[r] - mx) : 0.f; pb1[r] = (m + 96 <= mv) ? __builtin_amdgcn_exp2f(pb1[r] - mx) : 0.f;
            sum += (pa0[r] + pa1[r]) + (pb0[r] + pb1[r]); }
        sum = half_sum(sum);
        const float inv = sum > 0.f ? 1.0f / sum : 0.f;
#pragma unroll
        for (int r = 0; r < 16; ++r) { pa0[r] *= inv; pa1[r] *= inv; pb0[r] *= inv; pb1[r] *= inv; }
        LAS float* Gs = (LAS float*)(L + NA_GS); LAS float* Ls = (LAS float*)(L + NA_LS);
#pragma unroll
        for (int rg = 0; rg < 4; ++rg) {
            float gv[4], lv[4];
            gv[0] = (pa0[4 * rg] + pa0[4 * rg + 1]) + (pa0[4 * rg + 2] + pa0[4 * rg + 3]); lv[0] = pa0[4 * rg + 3];
            gv[1] = (pa1[4 * rg] + pa1[4 * rg + 1]) + (pa1[4 * rg + 2] + pa1[4 * rg + 3]); lv[1] = pa1[4 * rg + 3];
            gv[2] = (pb0[4 * rg] + pb0[4 * rg + 1]) + (pb0[4 * rg + 2] + pb0[4 * rg + 3]); lv[2] = pb0[4 * rg + 3];
            gv[3] = (pb1[4 * rg] + pb1[4 * rg + 1]) + (pb1[4 * rg + 2] + pb1[4 * rg + 3]); lv[3] = pb1[4 * rg + 3];
#pragma unroll
            for (int k = 0; k < 4; ++k) { gv[k] += DPPF(0.f, gv[k], 0xB1, 0xF); gv[k] += DPPF(0.f, gv[k], 0x4E, 0xF); lv[k] += DPPF(0.f, lv[k], 0xB1, 0xF); lv[k] += DPPF(0.f, lv[k], 0x4E, 0xF);
                if (hr == 0) { const int np = 8 * k + 2 * rg + hi; Gs[(8 * w + tl) * 32 + np] = gv[k]; Ls[(8 * w + tl) * 32 + np] = lv[k]; } }
        }
#pragma unroll
        for (int r = 0; r < 16; ++r) { pa0[r] *= g0; pa1[r] *= g0; pb0[r] *= g0; pb1[r] *= g0; }
        pv_tile(ot, L + NA_V, pa0, pa1, lane);
        if (two) pv_tile(ot, L + NA_V + 8192, pb0, pb1, lane);
#pragma unroll
        for (int d0 = 0; d0 < 2; ++d0)
#pragma unroll
            for (int r = 0; r < 16; ++r) stash[(d0 * 16 + r) * 64 + lane] = ot[d0][r];
    }
    kv_load(kreg, vreg, Ksb, Vsb, 2560, 0, w, lane);
    __syncthreads();
    if (tid < 64) {
        const LAS float* Gs = (const LAS float*)(L + NA_GS) + tid * 32; const LAS float* Ls = (const LAS float*)(L + NA_LS) + tid * 32;
        const int t = t0 + tid, cur = t >> 6;
        float sc[32];
#pragma unroll
        for (int n = 0; n < 32; ++n) { const float imp = Gs[n] + (n > 0 ? Ls[n - 1] : 0.f); const bool forced = (n == 0) || (n == cur) || (n == cur - 1);
            sc[n] = (n <= cur) ? (imp + (forced ? 1.0e4f : 0.f)) : -1.0e30f; }
        unsigned mask = 0u;
        for (int k = 0; k < 8; ++k) {
            float best = -3.0e38f; int bi = 0;
#pragma unroll
            for (int n = 0; n < 32; ++n) { const bool take = sc[n] > best; best = take ? sc[n] : best; bi = take ? n : bi; }
            if (bi <= cur) mask |= 1u << bi;
#pragma unroll
            for (int n = 0; n < 32; ++n) sc[n] = (n == bi) ? -3.0e38f : sc[n];
        }
        ((LAS unsigned*)(L + NA_MASK))[tid] = mask;
    }
    __syncthreads();
    const unsigned mymask = ((const LAS unsigned*)(L + NA_MASK))[8 * w + tl];
    unsigned ormask = 0u;
    { const LAS unsigned* mk = (const LAS unsigned*)(L + NA_MASK);
#pragma unroll 8
      for (int i = 0; i < 64; ++i) ormask |= mk[i]; }
    ormask = (unsigned)__builtin_amdgcn_readfirstlane((int)ormask);
    {
        f32x16 o[2]; o[0] = (f32x16){}; o[1] = (f32x16){}; float m_run = -1.0e30f, l_run = 0.f;
        unsigned rem = ormask; int slot = 0;
        int n = __builtin_ctz(rem); rem &= rem - 1;
        kv_store(L + NA_K, L + NA_V, kreg, vreg, w, lane);
        int n1 = -1; if (rem) { n1 = __builtin_ctz(rem); rem &= rem - 1; kv_load(kreg, vreg, Ksb, Vsb, 2560, 64 * n1, w, lane); }
        __syncthreads();
        for (;;) {
            int n2 = -1;
            if (n1 >= 0) { kv_store(L + NA_K + 8192 * (slot ^ 1), L + NA_V + 8192 * (slot ^ 1), kreg, vreg, w, lane);
                if (rem) { n2 = __builtin_ctz(rem); rem &= rem - 1; kv_load(kreg, vreg, Ksb, Vsb, 2560, 64 * n2, w, lane); } }
            else { kv_load(kreg, vreg, Kwb, Vwb, 2560, 64 * (qt >= 8 ? qt - 8 : 0), w, lane); }
            f32x16 p0, p1; qkt_tile(p0, p1, L + NA_K + 8192 * slot, qr, r32, hi);
            const bool sel = (mymask >> n) & 1u; const int kbase = 64 * n + 4 * hi;
            auto ok = [&](int r, int blk) { const int kvp = kbase + (r & 3) + 8 * (r >> 2) + 32 * blk; return kvp <= tok; };
            if (n == qt) flash_step<true>(o, m_run, l_run, p0, p1, sel, ok, wsf, L + NA_V + 8192 * slot, lane, r32, hi);
            else flash_step<false>(o, m_run, l_run, p0, p1, sel, ok, wsf, L + NA_V + 8192 * slot, lane, r32, hi);
            __syncthreads();
            if (n1 < 0) break;
            n = n1; n1 = n2; slot ^= 1;
        }
        if (hi == 0) wsf[r32] = g1 / l_run;
        LDS_WAIT();
#pragma unroll
        for (int d0 = 0; d0 < 2; ++d0)
#pragma unroll
            for (int r = 0; r < 16; ++r) stash[(d0 * 16 + r) * 64 + lane] += o[d0][r] * wsf[crow(r, hi)];
        LDS_WAIT();
    }
    {
        f32x16 o[2]; o[0] = (f32x16){}; o[1] = (f32x16){}; float m_run = -1.0e30f, l_run = 0.f;
        const int n_lo = qt >= 8 ? qt - 8 : 0;
        int slot = 0;
        kv_store(L + NA_K, L + NA_V, kreg, vreg, w, lane);
        if (n_lo < qt) kv_load(kreg, vreg, Kwb, Vwb, 2560, 64 * (n_lo + 1), w, lane);
        __syncthreads();
        for (int n = n_lo; n <= qt; ++n) {
            if (n < qt) { kv_store(L + NA_K + 8192 * (slot ^ 1), L + NA_V + 8192 * (slot ^ 1), kreg, vreg, w, lane);
                if (n + 2 <= qt) kv_load(kreg, vreg, Kwb, Vwb, 2560, 64 * (n + 2), w, lane); }
            f32x16 p0, p1; qkt_tile(p0, p1, L + NA_K + 8192 * slot, qr, r32, hi);
            const int kbase = 64 * n + 4 * hi;
            auto ok = [&](int r, int blk) { const int kvp = kbase + (r & 3) + 8 * (r >> 2) + 32 * blk; return (kvp <= tok) && (kvp > tok - 512); };
            if (n == qt || n == qt - 8) flash_step<true>(o, m_run, l_run, p0, p1, true, ok, wsf, L + NA_V + 8192 * slot, lane, r32, hi);
            else flash_step<false>(o, m_run, l_run, p0, p1, true, ok, wsf, L + NA_V + 8192 * slot, lane, r32, hi);
            __syncthreads();
            slot ^= 1;
        }
        if (hi == 0) wsf[r32] = g2 / l_run;
        LDS_WAIT();
#pragma unroll
        for (int d0 = 0; d0 < 2; ++d0)
#pragma unroll
            for (int r = 0; r < 16; ++r) { const int row = crow(r, hi); const size_t orow = (size_t)(b * SEQ + t0 + 8 * w + (row >> 2));
                const float val = stash[(d0 * 16 + r) * 64 + lane] + o[d0][r] * wsf[row];
                cat[orow * 1024 + (g * 4 + (row & 3)) * 64 + 32 * d0 + r32] = (bf16_t)(cvtpk(val, 0.f) & 0xffffu); }
        LDS_WAIT();
    }
}

#ifndef PROBE_PHASE
#define PROBE_PHASE -1
#endif
#define REPS(k) ((PROBE_PHASE == (k)) ? 3 : 1)
constexpr int N_PHASES = 19;

__global__ void __launch_bounds__(NTHR, 2) mega_fwd(Args args) {
    extern __shared__ __attribute__((aligned(16))) unsigned char lds_raw[];
    Frame F;
    F.lds = (LAS unsigned char*)lds_raw;
    F.LC = (volatile LAS unsigned*)(F.lds + LDSCTL_OFF);
    F.tid = threadIdx.x; F.lane = F.tid & 63; F.wave = __builtin_amdgcn_readfirstlane(F.tid >> 6);
    F.G = gridDim.x; { const int bx = blockIdx.x; F.vcu = (F.G % 8 == 0) ? (bx % 8) * (F.G / 8) + bx / 8 : bx; }
    F.ctl = (unsigned*)(args.ws + WS_CTL);
    for (int u = F.tid; u < 256; u += NTHR) F.LC[u] = 0u;
    __syncthreads();
    XcdBarrier bar = xcd_barrier_post(F.ctl + CW_BAR, F.LC + LC_BAR);
    const int lo = args.ph_lo, hi = args.ph_hi;
#define IN(k) (lo <= (k) && (k) < hi)
#define SEAM(k) do { if (IN(k) && IN((k) + 1)) xcd_barrier(bar); } while (0)
    unsigned char* ws = args.ws;

#define PH(k, ...) do { if (IN(k)) { { const int rep_ = 0; (void)rep_; __VA_ARGS__; } \
        if (PROBE_PHASE == (k)) { xcd_barrier(bar); { const int rep_ = 1; (void)rep_; __VA_ARGS__; } xcd_barrier(bar); { const int rep_ = 2; (void)rep_; __VA_ARGS__; } } } SEAM(k); } while (0)
    PH(0, { ssm_pow_tables(F, args); nsa_small_tables(F, args); p0_prologue(F, args); });
    PH(1, {
        ssm_frag_tables(F, args); nsa_cbias_final(F, args);
        pg8::Gemm g{(const bf16_t*)(ws + WS_H), (const bf16_t*)(ws + WS_W0T), 1024}; pg8::StaticOrder S; S.init(NTOK, 2048, F.G, (int)blockIdx.x);
        pg8::EpiBf16 E{(bf16_t*)(ws + WS_ARENA), 2048};
        pg8::gemm_phase(F.lds, g, S, E); });
    PH(2, { l0_mixer_phase(F, args, 2 * rep_); });
    PH(3, {
        pg8::Gemm g{(const bf16_t*)(ws + WS_H), (const bf16_t*)(ws + WS_WGLUT), 512}; pg8::StaticOrder S; S.init(NTOK, 512, F.G, (int)blockIdx.x);
        pg8::EpiGlu E{(const bf16_t*)(ws + WS_H), 512, (bf16_t*)(ws + WS_CAT) + 512, 1024};
        pg8::gemm_phase(F.lds, g, S, E); });
    PH(4, {
        pg8::Gemm g{(const bf16_t*)(ws + WS_CAT), (const bf16_t*)(ws + WS_WOUT0T), 1024}; pg8::StaticOrder S; S.init(NTOK, 1024, F.G, (int)blockIdx.x);
        pg8::EpiResid E{args.in[I_X], args.out, 1024};
        pg8::gemm_phase(F.lds, g, S, E); });
#define MOE_BLOCK(layer, pb) do { \
        if (PROBE_PHASE == 100 + (pb) && IN(pb)) { ln_a_phase(F, args, layer, true); xcd_barrier(bar); ln_a_phase(F, args, layer, true); xcd_barrier(bar); } \
        PH(pb, { ln_a_phase(F, args, layer); }); \
        PH(pb + 1, { moe_gather_phase(F, args, layer); }); \
        PH(pb + 2, { \
            moe_prefix(F, layer); \
            pg8::Gemm g{(const bf16_t*)(ws + WS_ARENA), (const bf16_t*)(ws + WS_WEXP + layer * WEXP_LAYER), 1024}; \
            pg8::MoeOrder S{(const LAS int*)(F.LC + LC_TSTART), F.G, (int)blockIdx.x}; \
            pg8::EpiSwiGLU E{(bf16_t*)(ws + WS_H), DE}; \
            pg8::gemm_phase(F.lds, g, S, E); }); \
        PH(pb + 3, { \
            moe_prefix(F, layer); \
            pg8::Gemm g{(const bf16_t*)(ws + WS_H), (const bf16_t*)(ws + WS_WEXP + layer * WEXP_LAYER + WEXP_W2), 512}; \
            pg8::MoeOrder S{(const LAS int*)(F.LC + LC_TSTART), F.G, (int)blockIdx.x}; \
            pg8::EpiBf16 E{(bf16_t*)(ws + WS_ARENA), DM}; \
            pg8::gemm_phase(F.lds, g, S, E); }); \
        PH(pb + 4, { ln_b_phase(F, args, layer, layer == 0); }); \
    } while (0)
    MOE_BLOCK(0, 5);
    PH(10, {
        pg8::Gemm g{(const bf16_t*)(ws + WS_H), (const bf16_t*)(ws + WS_WIN1T), 1024}; pg8::StaticOrder S; S.init(NTOK, 2816, F.G, (int)blockIdx.x);
        pg8::EpiRope E{(bf16_t*)(ws + WS_ARENA), (float*)(ws + WS_GATE), (const float*)(ws + WS_ROPE), (const float*)(ws + WS_ROPE) + 2048 * 32};
        pg8::gemm_phase(F.lds, g, S, E); });
    PH(11, { for (int u = blockIdx.x; u < 128; u += F.G) { __syncthreads(); cmp_unit(F, args, u >> 6, u & 63); } });
    PH(12, { for (;;) { const int t = q_next(F, 1 + 2 * rep_); if (t >= 1024) break; nsa_unit(F, args, (t & 31) >> 2, t & 3, 31 - (t >> 5)); } });
    PH(13, {
        pg8::Gemm g{(const bf16_t*)(ws + WS_CAT), (const bf16_t*)(ws + WS_WOUT1T), 1024}; pg8::StaticOrder S; S.init(NTOK, 1024, F.G, (int)blockIdx.x);
        pg8::EpiResid E{args.out, args.out, 1024};
        pg8::gemm_phase(F.lds, g, S, E); });
    MOE_BLOCK(1, 14);
#undef IN
#undef SEAM
}

extern "C" void kernel_launch(void* const* d_in, const int* in_sizes, int n_in, void* d_out, int out_size, void* d_ws, size_t ws_size, hipStream_t stream) {
    static int grid = 0;
    if (grid == 0) {
        if (n_in != 36 || out_size != NTOK * DM || ws_size < WS_END) { fprintf(stderr, "kernel_launch: unexpected shapes (n_in %d out %d ws %zu)\n", n_in, out_size, ws_size); grid = -1; return; }
        int dev = 0, cus = 0, per_cu = 0;
        if (hipGetDevice(&dev) != hipSuccess || hipDeviceGetAttribute(&cus, hipDeviceAttributeMultiprocessorCount, dev) != hipSuccess) { grid = -1; return; }
        if (hipFuncSetAttribute((const void*)mega_fwd, hipFuncAttributeMaxDynamicSharedMemorySize, LDS_BYTES) != hipSuccess) { fprintf(stderr, "kernel_launch: hipFuncSetAttribute failed\n"); grid = -1; return; }
        if (hipOccupancyMaxActiveBlocksPerMultiprocessor(&per_cu, (const void*)mega_fwd, NTHR, LDS_BYTES) != hipSuccess || per_cu < 1) { fprintf(stderr, "kernel_launch: occupancy query says %d\n", per_cu); }
        (void)hipGetLastError();
        grid = cus;
    }
    if (grid < 0) return;
    (void)hipMemsetAsync((char*)d_ws + WS_CTL, 0, CTL_ZERO_BYTES, stream);
    Args a{};
    for (int i = 0; i < 36; ++i) a.in[i] = (const float*)d_in[i];
    a.out = (float*)d_out; a.ws = (unsigned char*)d_ws; a.ph_lo = 0; a.ph_hi = N_PHASES;
    hipLaunchKernelGGL(mega_fwd, dim3(grid), dim3(NTHR), LDS_BYTES, stream, a);
}
```

```cpp
#include <hip/hip_runtime.h>
#include <cstdio>
#include <cstdint>

#define GAS __attribute__((address_space(1)))
#define LAS __attribute__((address_space(3)))
typedef unsigned short bf16_t;
typedef short bf16x8 __attribute__((ext_vector_type(8)));
typedef short s16x4 __attribute__((ext_vector_type(4)));
typedef float f32x2 __attribute__((ext_vector_type(2)));
typedef float f32x4 __attribute__((ext_vector_type(4)));
typedef float f32x16 __attribute__((ext_vector_type(16)));
typedef unsigned u32x2 __attribute__((ext_vector_type(2)));
typedef unsigned u32x4 __attribute__((ext_vector_type(4)));
typedef int i32x4 __attribute__((ext_vector_type(4)));
typedef __bf16 bf16x2_t __attribute__((ext_vector_type(2)));

constexpr int NB = 8, SEQ = 2048, DM = 1024, NTOK = NB * SEQ;
constexpr int NE = 16, DE = 512;
constexpr float ALPHA = 1.41421356237309515f;
constexpr float LN_EPS = 1e-5f;
constexpr int NWAVES = 8, NTHR = 512;
constexpr int MOE_ROWS = 36864;

constexpr size_t MiB = 1u << 20;
constexpr size_t WS_CTL = 0, CTL_ZERO_BYTES = 1 * MiB;
constexpr size_t WS_MISC = 1 * MiB;
constexpr size_t WS_TOKES = WS_MISC;
constexpr size_t WS_TOKW = WS_TOKES + 256 * 1024;
constexpr size_t WS_TOKROW = WS_TOKW + 128 * 1024;
constexpr size_t WS_APOW = WS_MISC + 512 * 1024;
constexpr size_t WS_FTAB = WS_APOW + 1088 * 1024;
constexpr size_t WS_ROPE = WS_FTAB + 64 * 1024;
constexpr size_t WS_GATE = WS_ROPE + 512 * 1024;
constexpr size_t WS_KCMP = WS_GATE + 3 * MiB;
constexpr size_t WS_CBIAS = WS_KCMP + 1024 * 1024;
constexpr size_t WS_CW2T = WS_CBIAS + 256 * 1024;
constexpr size_t WS_LIST = WS_MISC + 6656 * 1024;
constexpr size_t WS_SSMTAB = 9 * MiB;
constexpr size_t SSM_KF = WS_SSMTAB, SSM_WF = WS_SSMTAB + 2 * MiB, SSM_VF = WS_SSMTAB + 10 * MiB;
constexpr size_t WS_WDENSE = 27 * MiB;
constexpr size_t WS_W0T = WS_WDENSE;
constexpr size_t WS_WGLUT = WS_W0T + 4 * MiB;
constexpr size_t WS_WOUT0T = WS_WGLUT + 512 * 1024;
constexpr size_t WS_WIN1T = WS_WOUT0T + 2 * MiB;
constexpr size_t WS_WOUT1T = WS_WIN1T + 5632 * 1024;
constexpr size_t WS_CW1T = WS_WOUT1T + 2 * MiB;
constexpr size_t WS_WEXP = 43 * MiB;
constexpr size_t WEXP_LAYER = 48 * MiB, WEXP_W2 = 32 * MiB;
constexpr size_t WS_ARENA = 139 * MiB;
constexpr size_t WS_CAT = 219 * MiB;
constexpr size_t WS_H = 251 * MiB;
constexpr size_t WS_END = 287 * MiB;
constexpr int CW_BAR = 4096;
constexpr int CW_CNT = 8192;
constexpr int CW_QUEUE = 16384;

constexpr int RING_BYTES = 131072;
constexpr int LDSCTL_OFF = 163840 - 1024;
constexpr int LC_BAR = 0;
constexpr int LC_Q = 4;
constexpr int LC_TSTART = 16;
constexpr int LC_CNTS = 64;
constexpr int LDS_BYTES = 163840;

__device__ __forceinline__ unsigned cvtpk(float lo, float hi) { f32x2 v = {lo, hi}; bf16x2_t b = __builtin_convertvector(v, bf16x2_t); return __builtin_bit_cast(unsigned, b); }
__device__ __forceinline__ float bf_lo(unsigned u) { return __uint_as_float(u << 16); }
__device__ __forceinline__ float bf_hi(unsigned u) { return __uint_as_float(u & 0xffff0000u); }
#define DPPF(oldv, src, ctrl, rmask) __builtin_bit_cast(float, __builtin_amdgcn_update_dpp(__builtin_bit_cast(int, (float)(oldv)), __builtin_bit_cast(int, (float)(src)), (ctrl), (rmask), 0xF, false))
__device__ __forceinline__ float wave_sum(float v) {
    v += DPPF(0.f, v, 0xB1, 0xF); v += DPPF(0.f, v, 0x4E, 0xF); v += DPPF(0.f, v, 0x141, 0xF); v += DPPF(0.f, v, 0x140, 0xF);
    v += DPPF(0.f, v, 0x142, 0xA); v += DPPF(0.f, v, 0x143, 0xC);
    return __builtin_bit_cast(float, __builtin_amdgcn_readlane(__builtin_bit_cast(int, v), 63));
}
__device__ __forceinline__ float fast_exp(float x) { return __builtin_amdgcn_exp2f(x * 1.4426950408889634f); }
__device__ __forceinline__ float fast_sigmoid(float x) { return __builtin_amdgcn_rcpf(1.0f + fast_exp(-x)); }
__device__ __forceinline__ float gelu_tanh(float x) {
    const float u = 0.7978845608028654f * (x + 0.044715f * x * x * x);
    return x * fast_sigmoid(2.0f * u);
}
#define LDS_WAIT() asm volatile("s_waitcnt lgkmcnt(0)" ::: "memory")
#define VM_WAIT() asm volatile("s_waitcnt vmcnt(0)" ::: "memory")
#define RLX_AGENT __ATOMIC_RELAXED, __HIP_MEMORY_SCOPE_AGENT

namespace pg8 {
constexpr int BM = 256, BK = 64, HALF = 128, HTB = HALF * BK * 2, STAGE_BYTES = 8 * HTB, NXCD = 8, WGM = 8;
__host__ __device__ __forceinline__ int lds_byte(int r, int c) { const int st = (r >> 4) * 2 + (c >> 5), rr = r & 15, cc = c & 31, ob = rr * 64 + cc * 2; return st * 1024 + (ob ^ (((ob >> 9) & 1) << 5)); }
__host__ __device__ __forceinline__ void stage_rc(int b, int& R, int& C) { const int st = b / 1024, sb = b % 1024, swz = sb ^ (((sb >> 9) & 1) << 5); R = (st >> 1) * 16 + swz / 64; C = (st & 1) * 32 + (swz % 64) / 2; }
__host__ __device__ __forceinline__ int perm32(int rho) { const int n = rho >> 4, i = rho & 15; return 8 * (i >> 2) + 4 * n + (i & 3); }

struct Unit { int pm, pn, pb; };
struct Gemm { const bf16_t* A; const bf16_t* Bt; int K; };

struct StaticOrder {
    int nM, nN, nwg, G, c;
    __device__ void init(int M, int N, int G_, int c_) { nM = M / BM; nN = N / BM; nwg = nM * nN; G = G_; c = c_; }
    __device__ bool next(int i, Unit& u) const {
        const long L = (long)i * G + c; if (L >= nwg) return false;
        int wgid = (int)L; { const int q = nwg / NXCD, r = nwg % NXCD, xcd = wgid % NXCD, off = wgid / NXCD; wgid = (xcd < r ? xcd * (q + 1) : r * (q + 1) + (xcd - r) * q) + off; }
        const int nig = WGM * nN, gid = wgid / nig, fm = gid * WGM, gsz = (nM - fm) < WGM ? (nM - fm) : WGM;
        u.pm = fm + ((wgid % nig) % gsz); u.pn = (wgid % nig) / gsz; u.pb = u.pn; return true;
    }
    __device__ __forceinline__ unsigned a_row_off(const Unit& u, int R, int K) const { return (unsigned)(u.pm * BM + R) * (unsigned)K * 2u; }
};
struct MoeOrder {
    const LAS int* tstart; int G, c;
    __device__ bool next(int i, Unit& u) const {
        const int total = tstart[16] * 4; const long L = (long)i * G + c; if (L >= total) return false;
        const int rt = (int)L >> 2, pn = (int)L & 3; int e = 0;
#pragma unroll
        for (int k = 1; k < 16; ++k) e += (rt >= tstart[k]) ? 1 : 0;
        u.pm = rt; u.pn = pn; u.pb = e * 4 + pn; return true;
    }
    __device__ __forceinline__ unsigned a_row_off(const Unit& u, int R, int K) const { return (unsigned)(u.pm * BM + R) * (unsigned)K * 2u; }
};
struct MoeGatherOrder {
    const LAS int* tstart; const LAS int* cnts; const int* list; int G, c;
    __device__ bool next(int i, Unit& u) const {
        const int total = tstart[16] * 4; const long L = (long)i * G + c; if (L >= total) return false;
        const int rt = (int)L >> 2, pn = (int)L & 3; int e = 0;
#pragma unroll
        for (int k = 1; k < 16; ++k) e += (rt >= tstart[k]) ? 1 : 0;
        u.pm = rt; u.pn = pn; u.pb = e * 4 + pn; return true;
    }
    __device__ __forceinline__ unsigned a_row_off(const Unit& u, int R, int K) const {
        const int e = u.pb >> 2, slot = (u.pm - tstart[e]) * BM + R; const int tok = slot < cnts[e] ? list[e * NTOK + slot] : 0;
        return (unsigned)tok * (unsigned)K * 2u;
    }
};

template <class Epi, class Sched>
__device__ __forceinline__ void gemm_phase(LAS unsigned char* lds, const Gemm g, const Sched& S, const Epi& E) {
    const int tid = threadIdx.x, wid = __builtin_amdgcn_readfirstlane(tid >> 6), lane = tid & 63, wr = wid >> 2, wc = wid & 3, fr = lane & 15, fq = lane >> 4;
    const int K = g.K, nt = K / BK;
    unsigned voffB[2]; int RA[2], CA[2];
#pragma unroll
    for (int i = 0; i < 2; ++i) { int R, C; stage_rc(tid * 16 + i * 8192, R, C); const int Rb = Epi::PERM ? ((R & ~31) + perm32(R & 31)) : R;
        RA[i] = R; CA[i] = C; voffB[i] = (unsigned)(Rb * K + C) * 2u; }
    unsigned ao[2][2], nao[2][2];
#define PG8_AOFF(dst, u) do { _Pragma("unroll") for (int hh_ = 0; hh_ < 2; ++hh_) _Pragma("unroll") for (int i_ = 0; i_ < 2; ++i_) dst[hh_][i_] = S.a_row_off(u, hh_ * HALF + RA[i_], K) + (unsigned)CA[i_] * 2u; } while (0)
#define PG8_STAGE_A(bufoff, AO, kbyte) do { _Pragma("unroll") for (int _i = 0; _i < 2; ++_i) \
        __builtin_amdgcn_global_load_lds((const unsigned*)((const char*)g.A + (AO)[_i] + (kbyte)), (LAS unsigned*)(lds + (bufoff) + ldsw + _i * 8192), 16, 0, 0); } while (0)
    const size_t kstep = (size_t)(BK * 2);
    const size_t hstep = (size_t)HALF * K * 2;
    const size_t tstep = 2 * hstep;
    const unsigned ldsw = (unsigned)wid * 1024u;
    const int aoff = lds_byte(wr * 64 + fr, fq * 8), boff = lds_byte(wc * 32 + fr, fq * 8);
#define PG8_SA(b, h) (((b) * 2 + (h)) * HTB)
#define PG8_SB(b, h) ((4 + (b) * 2 + (h)) * HTB)
#define PG8_STAGE(bufoff, gbase, voff) do { _Pragma("unroll") for (int _i = 0; _i < 2; ++_i) \
        __builtin_amdgcn_global_load_lds((const unsigned*)((const char*)(gbase) + (voff)[_i]), (LAS unsigned*)(lds + (bufoff) + ldsw + _i * 8192), 16, 0, 0); } while (0)
#define PG8_LDA(dst, b, h) do { _Pragma("unroll") for (int m = 0; m < 4; ++m) _Pragma("unroll") for (int k = 0; k < 2; ++k) dst[m][k] = *(const LAS bf16x8*)(lds + PG8_SA(b, h) + aoff + m * 2048 + k * 1024); } while (0)
#define PG8_LDB(dst, b, h) do { _Pragma("unroll") for (int n = 0; n < 2; ++n) _Pragma("unroll") for (int k = 0; k < 2; ++k) dst[n][k] = *(const LAS bf16x8*)(lds + PG8_SB(b, h) + boff + n * 2048 + k * 1024); } while (0)
#define PG8_MMA(ai, bj, At, Bt) do { __builtin_amdgcn_s_setprio(1); _Pragma("unroll") for (int m = 0; m < 4; ++m) _Pragma("unroll") for (int n = 0; n < 2; ++n) _Pragma("unroll") for (int k = 0; k < 2; ++k) \
        acc[ai][bj][m][n] = __builtin_amdgcn_mfma_f32_16x16x32_bf16(Bt[n][k], At[m][k], acc[ai][bj][m][n], 0, 0, 0); __builtin_amdgcn_s_setprio(0); } while (0)
#define PG8_WAIT_V(n) asm volatile("s_waitcnt vmcnt(" #n ")" ::: "memory")
#define PG8_WAIT_L(n) asm volatile("s_waitcnt lgkmcnt(" #n ")" ::: "memory")
#define PG8_BAR __builtin_amdgcn_s_barrier()
#define PG8_SCHED __builtin_amdgcn_sched_barrier(0)
    Unit cur, nxt; int ui = 0;
    if (!S.next(0, cur)) return;
    f32x4 acc[2][2][4][2];
#pragma unroll
    for (int a = 0; a < 2; ++a)
#pragma unroll
        for (int b = 0; b < 2; ++b)
#pragma unroll
            for (int m = 0; m < 4; ++m)
#pragma unroll
                for (int n = 0; n < 2; ++n) acc[a][b][m][n] = (f32x4){0.f, 0.f, 0.f, 0.f};
    bf16x8 At[4][2], B0[2][2], B1[2][2];
    const char* cB = (const char*)g.Bt + (size_t)cur.pb * tstep;
    PG8_AOFF(ao, cur);
    PG8_STAGE(PG8_SB(0, 0), cB, voffB); PG8_STAGE(PG8_SB(0, 1), cB + hstep, voffB); PG8_STAGE_A(PG8_SA(0, 0), ao[0], 0); PG8_STAGE_A(PG8_SA(0, 1), ao[1], 0);
    if (wr == 1) PG8_BAR;
    PG8_WAIT_V(2); PG8_BAR;
    PG8_STAGE(PG8_SB(1, 0), cB + kstep, voffB); PG8_STAGE_A(PG8_SA(1, 0), ao[0], kstep); PG8_STAGE(PG8_SB(1, 1), cB + hstep + kstep, voffB);
    PG8_WAIT_V(6); PG8_BAR;
    for (;;) {
        const bool has_next = S.next(ui + 1, nxt);
        const char* nB = has_next ? (const char*)g.Bt + (size_t)nxt.pb * tstep : cB;
        if (has_next) { PG8_AOFF(nao, nxt); } else {
#pragma unroll
            for (int hh_ = 0; hh_ < 2; ++hh_)
#pragma unroll
                for (int i_ = 0; i_ < 2; ++i_) nao[hh_][i_] = ao[hh_][i_]; }
        for (int t = 0; t < nt; t += 2) {
            const bool last = (t == nt - 2);
            const size_t k1 = (size_t)(t + 1) * kstep, k2 = last ? 0 : (size_t)(t + 2) * kstep, k3 = k2 + kstep;
            unsigned a2o[2][2];
#pragma unroll
            for (int hh_ = 0; hh_ < 2; ++hh_)
#pragma unroll
                for (int i_ = 0; i_ < 2; ++i_) a2o[hh_][i_] = last ? nao[hh_][i_] : ao[hh_][i_];
            const char* b2 = last ? nB : cB + (size_t)(t + 2) * kstep;
            const char* b3 = b2 + kstep;
            PG8_LDB(B0, 0, 0); PG8_LDB(B1, 0, 1); PG8_SCHED; PG8_LDA(At, 0, 0); PG8_STAGE_A(PG8_SA(1, 1), ao[1], k1);
            PG8_WAIT_V(8); PG8_WAIT_L(0); PG8_BAR; PG8_MMA(0, 0, At, B0); PG8_MMA(0, 1, At, B1); PG8_BAR; PG8_SCHED;
            PG8_LDA(At, 0, 1); PG8_STAGE(PG8_SB(0, 0), b2, voffB); PG8_STAGE(PG8_SB(0, 1), b2 + hstep, voffB); PG8_STAGE_A(PG8_SA(0, 0), a2o[0], k2);
            PG8_WAIT_V(8); PG8_WAIT_L(0); PG8_BAR; PG8_MMA(1, 0, At, B0); PG8_MMA(1, 1, At, B1); PG8_BAR; PG8_SCHED;
            PG8_LDB(B0, 1, 0); PG8_LDB(B1, 1, 1); PG8_SCHED; PG8_LDA(At, 1, 0); PG8_STAGE_A(PG8_SA(0, 1), a2o[1], k2);
            PG8_WAIT_V(8); PG8_WAIT_L(0); PG8_BAR; PG8_MMA(0, 0, At, B0); PG8_MMA(0, 1, At, B1); PG8_BAR; PG8_SCHED;
            PG8_LDA(At, 1, 1); PG8_STAGE(PG8_SB(1, 0), b3, voffB); PG8_STAGE(PG8_SB(1, 1), b3 + hstep, voffB); PG8_STAGE_A(PG8_SA(1, 0), a2o[0], k3);
            PG8_WAIT_V(8); PG8_WAIT_L(0); PG8_BAR; PG8_MMA(1, 0, At, B0); PG8_MMA(1, 1, At, B1); PG8_BAR; PG8_SCHED;
        }
        if (wr == 0) PG8_BAR;
        E(acc, cur, wr, wc, fr, fq);
        if (!has_next) break;
#pragma unroll
        for (int a = 0; a < 2; ++a)
#pragma unroll
            for (int b = 0; b < 2; ++b)
#pragma unroll
                for (int m = 0; m < 4; ++m)
#pragma unroll
                    for (int n = 0; n < 2; ++n) acc[a][b][m][n] = (f32x4){0.f, 0.f, 0.f, 0.f};
        cur = nxt; cB = nB; ++ui;
#pragma unroll
        for (int hh_ = 0; hh_ < 2; ++hh_)
#pragma unroll
            for (int i_ = 0; i_ < 2; ++i_) ao[hh_][i_] = nao[hh_][i_];
        if (wr == 1) PG8_BAR;
    }
    PG8_WAIT_V(0);
    PG8_BAR;
#undef PG8_SA
#undef PG8_SB
#undef PG8_STAGE
#undef PG8_STAGE_A
#undef PG8_AOFF
#undef PG8_LDA
#undef PG8_LDB
#undef PG8_MMA
#undef PG8_WAIT_V
#undef PG8_WAIT_L
#undef PG8_BAR
#undef PG8_SCHED
}

struct EpiBf16 {
    static constexpr bool PERM = true;
    bf16_t* O; int ldc;
    __device__ __forceinline__ void operator()(const f32x4 (&acc)[2][2][4][2], const Unit& u, int wr, int wc, int fr, int fq) const {
        const int row0 = u.pm * BM + wr * 64 + fr, col0 = u.pn * BM + wc * 32 + 8 * fq;
#pragma unroll
        for (int ai = 0; ai < 2; ++ai)
#pragma unroll
            for (int m = 0; m < 4; ++m) { bf16_t* rowp = O + (size_t)(row0 + ai * HALF + m * 16) * ldc + col0;
#pragma unroll
                for (int bj = 0; bj < 2; ++bj) { const f32x4 v0 = acc[ai][bj][m][0], v1 = acc[ai][bj][m][1];
                    u32x4 w; w.x = cvtpk(v0[0], v0[1]); w.y = cvtpk(v0[2], v0[3]); w.z = cvtpk(v1[0], v1[1]); w.w = cvtpk(v1[2], v1[3]);
                    *(u32x4*)(rowp + bj * HALF) = w; } }
    }
};
struct EpiSwiGLU {
    static constexpr bool PERM = true;
    bf16_t* O; int ldc;
    __device__ __forceinline__ void operator()(const f32x4 (&acc)[2][2][4][2], const Unit& u, int wr, int wc, int fr, int fq) const {
        const int row0 = u.pm * BM + wr * 64 + fr, col0 = u.pn * HALF + wc * 32 + 8 * fq;
#pragma unroll
        for (int ai = 0; ai < 2; ++ai)
#pragma unroll
            for (int m = 0; m < 4; ++m) { bf16_t* rowp = O + (size_t)(row0 + ai * HALF + m * 16) * ldc + col0;
                float h[8];
#pragma unroll
                for (int n = 0; n < 2; ++n)
#pragma unroll
                    for (int i = 0; i < 4; ++i) { const float a = acc[ai][0][m][n][i], b = acc[ai][1][m][n][i]; h[n * 4 + i] = a * fast_sigmoid(a) * b; }
                u32x4 w; w.x = cvtpk(h[0], h[1]); w.y = cvtpk(h[2], h[3]); w.z = cvtpk(h[4], h[5]); w.w = cvtpk(h[6], h[7]);
                *(u32x4*)rowp = w; }
    }
};
struct EpiResid {
    static constexpr bool PERM = false;
    const float* resid; float* out; int ldc;
    __device__ __forceinline__ void operator()(const f32x4 (&acc)[2][2][4][2], const Unit& u, int wr, int wc, int fr, int fq) const {
        const int row0 = u.pm * BM + wr * 64 + fr, col0 = u.pn * BM + wc * 32 + 4 * fq;
#pragma unroll
        for (int ai = 0; ai < 2; ++ai)
#pragma unroll
            for (int m = 0; m < 4; ++m) { const size_t off = (size_t)(row0 + ai * HALF + m * 16) * ldc + col0;
#pragma unroll
                for (int bj = 0; bj < 2; ++bj)
#pragma unroll
                    for (int n = 0; n < 2; ++n) { const f32x4 r = *(const f32x4*)(resid + off + bj * HALF + n * 16); *(f32x4*)(out + off + bj * HALF + n * 16) = r * ALPHA + acc[ai][bj][m][n]; } }
    }
};
struct EpiResidBf {
    static constexpr bool PERM = false;
    const bf16_t* resid; float* out; int ldc;
    __device__ __forceinline__ void operator()(const f32x4 (&acc)[2][2][4][2], const Unit& u, int wr, int wc, int fr, int fq) const {
        const int row0 = u.pm * BM + wr * 64 + fr, col0 = u.pn * BM + wc * 32 + 4 * fq;
#pragma unroll
        for (int ai = 0; ai < 2; ++ai)
#pragma unroll
            for (int m = 0; m < 4; ++m) { const size_t off = (size_t)(row0 + ai * HALF + m * 16) * ldc + col0;
#pragma unroll
                for (int bj = 0; bj < 2; ++bj)
#pragma unroll
                    for (int n = 0; n < 2; ++n) { const u32x2 r = *(const u32x2*)(resid + off + bj * HALF + n * 16);
                        const f32x4 rv = {bf_lo(r.x), bf_hi(r.x), bf_lo(r.y), bf_hi(r.y)}; *(f32x4*)(out + off + bj * HALF + n * 16) = rv * ALPHA + acc[ai][bj][m][n]; } }
    }
};
struct EpiGlu {
    static constexpr bool PERM = true;
    const bf16_t* h; int ldh; bf16_t* O; int ldc;
    __device__ __forceinline__ void operator()(const f32x4 (&acc)[2][2][4][2], const Unit& u, int wr, int wc, int fr, int fq) const {
        const int row0 = u.pm * BM + wr * 64 + fr, col0 = u.pn * BM + wc * 32 + 8 * fq;
#pragma unroll
        for (int ai = 0; ai < 2; ++ai)
#pragma unroll
            for (int m = 0; m < 4; ++m) { const size_t row = (size_t)(row0 + ai * HALF + m * 16);
#pragma unroll
                for (int bj = 0; bj < 2; ++bj) { const int col = col0 + bj * HALF; const u32x4 hv = *(const u32x4*)(h + row * ldh + col);
                    const f32x4 v0 = acc[ai][bj][m][0], v1 = acc[ai][bj][m][1];
                    u32x4 w; w.x = cvtpk(bf_lo(hv.x) * fast_sigmoid(v0[0]), bf_hi(hv.x) * fast_sigmoid(v0[1])); w.y = cvtpk(bf_lo(hv.y) * fast_sigmoid(v0[2]), bf_hi(hv.y) * fast_sigmoid(v0[3]));
                    w.z = cvtpk(bf_lo(hv.z) * fast_sigmoid(v1[0]), bf_hi(hv.z) * fast_sigmoid(v1[1])); w.w = cvtpk(bf_lo(hv.w) * fast_sigmoid(v1[2]), bf_hi(hv.w) * fast_sigmoid(v1[3]));
                    *(u32x4*)(O + row * ldc + col) = w; } }
    }
};
struct EpiRope {
    static constexpr bool PERM = false;
    bf16_t* O; float* gate; const float* rc; const float* rs;
    __device__ __forceinline__ void operator()(const f32x4 (&acc)[2][2][4][2], const Unit& u, int wr, int wc, int fr, int fq) const {
        const int row0 = u.pm * BM + wr * 64 + fr;
        if (u.pn < 10) {
            const bool rope = (u.pn < 4) || (u.pn == 6) || (u.pn == 8); const float sc = u.pn < 4 ? 0.18033688011112042f : 1.0f;
            const int j = (wc & 1) * 16 + fq * 4;
#pragma unroll
            for (int ai = 0; ai < 2; ++ai)
#pragma unroll
                for (int m = 0; m < 4; ++m) { const int row = row0 + ai * HALF + m * 16, pos = row & 2047;
                    f32x4 c4 = {1.f, 1.f, 1.f, 1.f}, s4 = {0.f, 0.f, 0.f, 0.f};
                    if (rope) { c4 = *(const f32x4*)(rc + pos * 32 + j); s4 = *(const f32x4*)(rs + pos * 32 + j); }
#pragma unroll
                    for (int bj = 0; bj < 2; ++bj) { const int head = bj * 2 + (wc >> 1); const f32x4 x1 = acc[ai][bj][m][0], x2 = acc[ai][bj][m][1];
                        const f32x4 y1 = (x1 * c4 - x2 * s4) * sc, y2 = (x1 * s4 + x2 * c4) * sc;
                        bf16_t* op = O + (size_t)row * 2560 + u.pn * 256 + head * 64 + j;
                        u32x2 w1; w1.x = cvtpk(y1[0], y1[1]); w1.y = cvtpk(y1[2], y1[3]); *(u32x2*)op = w1;
                        u32x2 w2; w2.x = cvtpk(y2[0], y2[1]); w2.y = cvtpk(y2[2], y2[3]); *(u32x2*)(op + 32) = w2; } }
        } else {
#pragma unroll
            for (int ai = 0; ai < 2; ++ai)
#pragma unroll
                for (int m = 0; m < 4; ++m) { const int row = row0 + ai * HALF + m * 16;
#pragma unroll
                    for (int n = 0; n < 2; ++n) { const int c = 32 * wc + 16 * n + 4 * fq; const f32x4 v = acc[ai][0][m][n];
                        if (c < 48) *(f32x4*)(gate + (size_t)row * 48 + c) = (f32x4){fast_sigmoid(v[0]), fast_sigmoid(v[1]), fast_sigmoid(v[2]), fast_sigmoid(v[3])}; } }
        }
    }
};
}

#define XB_TMO      128
#define XB_XCNT(j)  (256  + 64 * (j))
#define XB_XSUB(j)  (1280 + 64 * (j))
#define XB_XGEN(j)  (2304 + 64 * (j))
#define XB_TOP      3328
#define XB_TOPGEN   3392
#define XCD_BAR_WORDS 3456
#define XB_SPIN_CAP (1u << 22)
__device__ __forceinline__ unsigned xb_ld(unsigned* p)              { return __hip_atomic_load(p, __ATOMIC_RELAXED, __HIP_MEMORY_SCOPE_AGENT); }
__device__ __forceinline__ unsigned xb_add(unsigned* p, unsigned v) { return __hip_atomic_fetch_add(p, v, __ATOMIC_RELAXED, __HIP_MEMORY_SCOPE_AGENT); }
__device__ __forceinline__ unsigned xb_xcc_id() { return (unsigned)__builtin_amdgcn_s_getreg((3 << 11) | 20) & 0xFu; }
#define XB_SPIN(cond, bar) do { unsigned _sp = 0; while (cond) { __builtin_amdgcn_s_sleep(1); \
    if ((++_sp & 255u) == 0u) { if (xb_ld(&(bar)[XB_TMO])) break; if (_sp > XB_SPIN_CAP) { atomicAdd(&(bar)[XB_TMO], 1u); break; } } } } while (0)
struct XcdBarrier { unsigned* bar; unsigned x; volatile LAS unsigned* st; };
__device__ __forceinline__ XcdBarrier xcd_barrier_post(unsigned* bar, volatile LAS unsigned* st) {
    XcdBarrier b; b.bar = bar; b.x = xb_xcc_id(); b.st = st;
    if (threadIdx.x == 0) (void)xb_add(&bar[XB_XCNT(b.x)], 1u);
    return b;
}
__device__ __forceinline__ void xcd_barrier_complete(unsigned* bar, unsigned x, unsigned& nloc, unsigned& nx) {
    const unsigned G = gridDim.x * gridDim.y * gridDim.z;
    unsigned sum, cnt, mine, sp = 0u;
    for (;;) {
        sum = 0u; cnt = 0u; mine = 0u;
#pragma unroll
        for (unsigned j = 0; j < 16; ++j) { const unsigned c = xb_ld(&bar[XB_XCNT(j)]); sum += c; cnt += (c > 0u) ? 1u : 0u; mine = (j == x) ? c : mine; }
        if (sum == G) break;
        __builtin_amdgcn_s_sleep(1);
        if ((++sp & 255u) == 0u) { if (xb_ld(&bar[XB_TMO])) break; if (sp > XB_SPIN_CAP) { atomicAdd(&bar[XB_TMO], 1u); break; } }
    }
    nloc = mine > 0u ? mine : 1u; nx = cnt > 0u ? cnt : 1u;
}
__device__ __forceinline__ void xcd_barrier(const XcdBarrier& b) {
    asm volatile("s_waitcnt vmcnt(0)" ::: "memory");
    __syncthreads();
    if (threadIdx.x == 0) {
        unsigned* bar = b.bar;
        __builtin_amdgcn_s_waitcnt(0);
        unsigned nloc = b.st[0], nx = b.st[1];
        if (nloc == 0u) { xcd_barrier_complete(bar, b.x, nloc, nx); b.st[0] = nloc; b.st[1] = nx; }
        const unsigned old = xb_add(&bar[XB_XSUB(b.x)], 1u);
        const unsigned gen = old / nloc;
        if (old + 1u == (gen + 1u) * nloc) {
            __builtin_amdgcn_fence(__ATOMIC_RELEASE, "agent");
            asm volatile("s_waitcnt vmcnt(0)" ::: "memory");
            const unsigned og = xb_add(&bar[XB_TOP], 1u);
            const unsigned tg = og / nx;
            if (og + 1u == (tg + 1u) * nx) xb_add(&bar[XB_TOPGEN], 1u);
            else XB_SPIN(xb_ld(&bar[XB_TOPGEN]) == tg, bar);
            __builtin_amdgcn_fence(__ATOMIC_ACQUIRE, "agent");
            xb_add(&bar[XB_XGEN(b.x)], 1u);
            asm volatile("s_waitcnt vmcnt(0)" ::: "memory");
        } else {
            XB_SPIN(xb_ld(&bar[XB_XGEN(b.x)]) == gen, bar);
            __builtin_amdgcn_fence(__ATOMIC_ACQUIRE, "agent");
            asm volatile("s_waitcnt vmcnt(0)" ::: "memory");
        }
    }
    __syncthreads();
}

struct Args { const float* in[36]; float* out; unsigned char* ws; int ph_lo, ph_hi; };
struct Frame {
    LAS unsigned char* lds;
    volatile LAS unsigned* LC;
    unsigned* ctl;
    int tid, lane, wave, vcu, G;
};
enum { I_X = 0, I_WIN0, I_LAMRE, I_LAMIM, I_LOGDT, I_BRE, I_BIM, I_CRE, I_CIM, I_SSMD, I_WGLU, I_WOUT0, I_LNMG0, I_LNMB0, I_LNFG0, I_LNFB0, I_W1_0, I_W3_0, I_W2_0,
       I_WIN1, I_CPK, I_CW1K, I_CW2K, I_CPV, I_CW1V, I_CW2V, I_WOUT1, I_LNMG1, I_LNMB1, I_LNFG1, I_LNFB1, I_W1_1, I_W3_1, I_W2_1, I_WR, I_BR };

__device__ __forceinline__ void p0_item_load(float (&v)[32], const float* W, int ldw, int ncols_valid, int nblk, int item, int lane) {
    const int kb = item / nblk, nb = item % nblk, k0 = 64 * kb, n0 = 32 * nb;
    const int nsrc = (n0 + (lane & 31)) < ncols_valid ? (n0 + (lane & 31)) : (ncols_valid - 1);
    const float* p = W + (size_t)(k0 + (lane >> 5)) * ldw + nsrc;
#pragma unroll
    for (int i = 0; i < 32; ++i) v[i] = p[(size_t)(2 * i) * ldw];
}
template <class RowMap>
__device__ __forceinline__ void p0_item_store(const float (&v)[32], int K, int nblk, bf16_t* WT, const RowMap& rm, LAS float* scr, int item, int lane) {
    const int kb = item / nblk, nb = item % nblk, k0 = 64 * kb, n0 = 32 * nb;
#pragma unroll
    for (int i = 0; i < 32; ++i) scr[(2 * i + (lane >> 5)) * 33 + (lane & 31)] = v[i];
    LDS_WAIT(); asm volatile("" ::: "memory");
    const int c = lane & 7;
#pragma unroll
    for (int j = 0; j < 4; ++j) { const int n = (lane >> 3) + 8 * j; const LAS float* s = scr + (8 * c) * 33 + n;
        u32x4 o; o.x = cvtpk(s[0 * 33], s[1 * 33]); o.y = cvtpk(s[2 * 33], s[3 * 33]); o.z = cvtpk(s[4 * 33], s[5 * 33]); o.w = cvtpk(s[6 * 33], s[7 * 33]);
        *(u32x4*)(WT + (size_t)rm(n0 + n) * K + k0 + 8 * c) = o; }
    LDS_WAIT(); asm volatile("" ::: "memory");
}
struct RmId { int off; __device__ __forceinline__ int operator()(int n) const { return off + n; } };
struct RmW13 { int half; __device__ __forceinline__ int operator()(int n) const { return (n >> 7) * 256 + half * 128 + (n & 127); } };
struct RmRope {
    __device__ __forceinline__ int operator()(int n) const {
        if (n >= 2560) return n;
        const int tile = n >> 8, o = n & 255, head = o >> 6, half = (o >> 5) & 1, j = o & 31;
        const int bj = head >> 1, wc = (head & 1) * 2 + (j >> 4), fq = (j >> 2) & 3, i = j & 3;
        return tile * 256 + 128 * bj + 32 * wc + 16 * half + 4 * fq + i;
    }
};

struct P0Item { const float* W; bf16_t* WT; int K, ldw, ncv, nblk, rmk, rmarg, it; };
__device__ __forceinline__ P0Item p0_decode(const Args& A, int it) {
    constexpr int IT_W0 = (1024 / 64) * (2048 / 32), IT_GLU = (512 / 64) * (512 / 32), IT_SQ = (1024 / 64) * (1024 / 32), IT_IN1 = (1024 / 64) * (2816 / 32), IT_CW1 = (2048 / 64) * (256 / 32);
    constexpr int IT_E13 = (1024 / 64) * (512 / 32), IT_E2 = (512 / 64) * (1024 / 32), IT_EXPL = 16 * (2 * IT_E13 + IT_E2);
    unsigned char* ws = A.ws; P0Item d; int r = it;
    if (r < IT_W0) { d = {A.in[I_WIN0], (bf16_t*)(ws + WS_W0T), 1024, 2048, 2048, 64, 0, 0, r}; return d; } r -= IT_W0;
    if (r < IT_GLU) { d = {A.in[I_WGLU], (bf16_t*)(ws + WS_WGLUT), 512, 512, 512, 16, 0, 0, r}; return d; } r -= IT_GLU;
    if (r < IT_SQ) { d = {A.in[I_WOUT0], (bf16_t*)(ws + WS_WOUT0T), 1024, 1024, 1024, 32, 0, 0, r}; return d; } r -= IT_SQ;
    if (r < IT_IN1) { d = {A.in[I_WIN1], (bf16_t*)(ws + WS_WIN1T), 1024, 2608, 2608, 88, 2, 0, r}; return d; } r -= IT_IN1;
    if (r < IT_SQ) { d = {A.in[I_WOUT1], (bf16_t*)(ws + WS_WOUT1T), 1024, 1024, 1024, 32, 0, 0, r}; return d; } r -= IT_SQ;
    if (r < IT_CW1) { d = {A.in[I_CW1K], (bf16_t*)(ws + WS_CW1T), 2048, 256, 256, 8, 0, 0, r}; return d; } r -= IT_CW1;
    if (r < IT_CW1) { d = {A.in[I_CW1V], (bf16_t*)(ws + WS_CW1T) + 256 * 2048, 2048, 256, 256, 8, 0, 0, r}; return d; } r -= IT_CW1;
    const int layer = r / IT_EXPL; r -= layer * IT_EXPL;
    const int e = r / (2 * IT_E13 + IT_E2); r -= e * (2 * IT_E13 + IT_E2);
    bf16_t* w13t = (bf16_t*)(ws + WS_WEXP + layer * WEXP_LAYER) + (size_t)e * 1024 * 1024;
    bf16_t* w2t = (bf16_t*)(ws + WS_WEXP + layer * WEXP_LAYER + WEXP_W2) + (size_t)e * 1024 * 512;
    const float* w1 = A.in[layer ? I_W1_1 : I_W1_0] + (size_t)e * 1024 * 512;
    const float* w3 = A.in[layer ? I_W3_1 : I_W3_0] + (size_t)e * 1024 * 512;
    const float* w2 = A.in[layer ? I_W2_1 : I_W2_0] + (size_t)e * 512 * 1024;
    if (r < IT_E13) { d = {w1, w13t, 1024, 512, 512, 16, 1, 0, r}; return d; } r -= IT_E13;
    if (r < IT_E13) { d = {w3, w13t, 1024, 512, 512, 16, 1, 1, r}; return d; } r -= IT_E13;
    d = {w2, w2t, 512, 1024, 1024, 32, 0, 0, r}; return d;
}
__device__ __forceinline__ void p0_prologue(Frame& F, const Args& A) {
    LAS float* scr = (LAS float*)(F.lds + F.wave * 16384);
    const int gw = F.vcu * NWAVES + F.wave, NGW = F.G * NWAVES;
    constexpr int IT_DENSE = 1024 + 128 + 512 + 1408 + 512 + 2 * 256, NITEMS = IT_DENSE + 2 * 16 * (2 * 256 + 256);
    float v[32];
    P0Item cur = p0_decode(A, gw < NITEMS ? gw : 0);
    if (gw < NITEMS) p0_item_load(v, cur.W, cur.ldw, cur.ncv, cur.nblk, cur.it, F.lane);
    for (int it = gw; it < NITEMS; it += NGW) {
        float u[32];
#pragma unroll
        for (int i = 0; i < 32; ++i) u[i] = v[i];
        const P0Item d = cur;
        if (it + NGW < NITEMS) { cur = p0_decode(A, it + NGW); p0_item_load(v, cur.W, cur.ldw, cur.ncv, cur.nblk, cur.it, F.lane); }
        if (d.rmk == 0) p0_item_store(u, d.K, d.nblk, d.WT, RmId{0}, scr, d.it, F.lane);
        else if (d.rmk == 1) p0_item_store(u, d.K, d.nblk, d.WT, RmW13{d.rmarg}, scr, d.it, F.lane);
        else p0_item_store(u, d.K, d.nblk, d.WT, RmRope{}, scr, d.it, F.lane);
    }
    bf16_t* xb = (bf16_t*)(A.ws + WS_H);
    for (int m = gw; m < NTOK; m += 2 * NGW) {
        const f32x4* xr0 = (const f32x4*)(A.in[I_X] + (size_t)m * DM) + F.lane; const f32x4* xr1 = (const f32x4*)(A.in[I_X] + (size_t)(m + NGW) * DM) + F.lane;
        u32x2* o0 = (u32x2*)(xb + (size_t)m * DM) + F.lane; u32x2* o1 = (u32x2*)(xb + (size_t)(m + NGW) * DM) + F.lane;
        f32x4 a[4], b[4];
#pragma unroll
        for (int j = 0; j < 4; ++j) { a[j] = xr0[64 * j]; if (m + NGW < NTOK) b[j] = xr1[64 * j]; }
#pragma unroll
        for (int j = 0; j < 4; ++j) { u32x2 w; w.x = cvtpk(a[j][0], a[j][1]); w.y = cvtpk(a[j][2], a[j][3]); o0[64 * j] = w;
            if (m + NGW < NTOK) { u32x2 w2; w2.x = cvtpk(b[j][0], b[j][1]); w2.y = cvtpk(b[j][2], b[j][3]); o1[64 * j] = w2; } }
    }
}

__device__ __forceinline__ float rdl(float v, int l) { return __builtin_bit_cast(float, __builtin_amdgcn_readlane(__builtin_bit_cast(int, v), l)); }
constexpr int LNR = 2;
__device__ __forceinline__ void ln_a_phase(Frame& F, const Args& A, int layer, bool dry = false) {
    const float* xres = A.out; bf16_t* xb = (bf16_t*)(A.ws + (dry ? WS_H : WS_CAT));
    const float* gam = A.in[layer ? I_LNMG1 : I_LNMG0]; const float* bet = A.in[layer ? I_LNMB1 : I_LNMB0];
    const float* wr = A.in[I_WR]; const float* br = A.in[I_BR];
    LAS float* wrT = (LAS float*)F.lds;
    for (int i = F.tid; i < DM * NE; i += NTHR) { const int k = i >> 4, e = i & 15; wrT[e * DM + k] = wr[i]; }
    if (F.tid < 128) ((volatile LAS int*)(F.lds + 65536))[F.tid] = -1;
    __syncthreads();
    const float brv = br[(F.lane >> 2) & 15];
    i32x4* tokes = (i32x4*)(A.ws + (dry ? WS_MISC + 7 * MiB : WS_TOKES)); f32x2* tokw = (f32x2*)(A.ws + (dry ? WS_MISC + 7 * MiB + 256 * 1024 : WS_TOKW));
    unsigned* cnt = F.ctl + CW_CNT + (dry ? 2 : layer) * 16 * 64;
    int* list = (int*)(A.ws + WS_LIST); volatile LAS int* RE = (volatile LAS int*)(F.lds + 65536); volatile LAS int* RTOK = RE + 128; volatile LAS int* BASE = RE + 192; int nrow = 0;
    const int gw = F.vcu * NWAVES + F.wave, NGW = F.G * NWAVES;
    const bool b5 = (F.lane & 32) != 0, b4 = (F.lane & 16) != 0, b3 = (F.lane & 8) != 0, b2 = (F.lane & 4) != 0;
    f32x4 nx[LNR][4];
#pragma unroll
    for (int rr = 0; rr < LNR; ++rr) { const int m = gw + rr * NGW; if (m < NTOK) {
#pragma unroll
        for (int j = 0; j < 4; ++j) nx[rr][j] = ((const f32x4*)(xres + (size_t)m * DM))[F.lane + 64 * j]; } }
    for (int m0 = gw; m0 < NTOK; m0 += LNR * NGW) {
        f32x4 v[LNR][4]; float s[LNR];
#pragma unroll
        for (int rr = 0; rr < LNR; ++rr) { s[rr] = 0.f;
#pragma unroll
            for (int j = 0; j < 4; ++j) { v[rr][j] = nx[rr][j]; s[rr] += (v[rr][j][0] + v[rr][j][1]) + (v[rr][j][2] + v[rr][j][3]); } }
#pragma unroll
        for (int rr = 0; rr < LNR; ++rr) { const int m = m0 + (LNR + rr) * NGW; if (m < NTOK) {
#pragma unroll
            for (int j = 0; j < 4; ++j) nx[rr][j] = ((const f32x4*)(xres + (size_t)m * DM))[F.lane + 64 * j]; } }
        float mean[LNR], rstd[LNR];
#pragma unroll
        for (int rr = 0; rr < LNR; ++rr) mean[rr] = wave_sum(s[rr]) * (1.f / DM);
#pragma unroll
        for (int rr = 0; rr < LNR; ++rr) { float s2 = 0.f;
#pragma unroll
            for (int j = 0; j < 4; ++j) { v[rr][j] = v[rr][j] - mean[rr]; s2 += (v[rr][j][0] * v[rr][j][0] + v[rr][j][1] * v[rr][j][1]) + (v[rr][j][2] * v[rr][j][2] + v[rr][j][3] * v[rr][j][3]); }
            s[rr] = s2; }
#pragma unroll
        for (int rr = 0; rr < LNR; ++rr) rstd[rr] = 1.f / sqrtf(wave_sum(s[rr]) * (1.f / DM) + LN_EPS);
#pragma unroll
        for (int rr = 0; rr < LNR; ++rr) { const int m = m0 + rr * NGW; if (m < NTOK) {
            u32x2* o8 = (u32x2*)(xb + (size_t)m * DM) + F.lane;
#pragma unroll
            for (int j = 0; j < 4; ++j) { const f32x4 gj = ((const f32x4*)gam)[F.lane + 64 * j], bj = ((const f32x4*)bet)[F.lane + 64 * j];
                v[rr][j] = v[rr][j] * rstd[rr] * gj + bj; u32x2 w; w.x = cvtpk(v[rr][j][0], v[rr][j][1]); w.y = cvtpk(v[rr][j][2], v[rr][j][3]); o8[64 * j] = w; } } }
        float p[LNR][16];
#pragma unroll
        for (int e = 0; e < NE; ++e) {
            f32x4 w[4];
#pragma unroll
            for (int j = 0; j < 4; ++j) w[j] = *(const LAS f32x4*)(wrT + e * DM + 4 * F.lane + 256 * j);
#pragma unroll
            for (int rr = 0; rr < LNR; ++rr) { float acc = 0.f;
#pragma unroll
                for (int j = 0; j < 4; ++j) acc += (v[rr][j][0] * w[j][0] + v[rr][j][1] * w[j][1]) + (v[rr][j][2] * w[j][2] + v[rr][j][3] * w[j][3]);
                p[rr][e] = acc; }
            asm volatile("" ::: "memory");
        }
        float lg[LNR];
#pragma unroll
        for (int rr = 0; rr < LNR; ++rr) {
            float q8[8], q4[4], q2[2];
#pragma unroll
            for (int i = 0; i < 8; ++i) { const float keep = b5 ? p[rr][i + 8] : p[rr][i], send = b5 ? p[rr][i] : p[rr][i + 8]; q8[i] = keep + __shfl_xor(send, 32); }
#pragma unroll
            for (int i = 0; i < 4; ++i) { const float keep = b4 ? q8[i + 4] : q8[i], send = b4 ? q8[i] : q8[i + 4]; q4[i] = keep + __shfl_xor(send, 16); }
#pragma unroll
            for (int i = 0; i < 2; ++i) { const float keep = b3 ? q4[i + 2] : q4[i], send = b3 ? q4[i] : q4[i + 2]; q2[i] = keep + __shfl_xor(send, 8); }
            float l; { const float keep = b2 ? q2[1] : q2[0], send = b2 ? q2[0] : q2[1]; l = keep + __shfl_xor(send, 4); }
            l += DPPF(0.f, l, 0xB1, 0xF); l += DPPF(0.f, l, 0x4E, 0xF);
            lg[rr] = l;
        }
#pragma unroll
        for (int rr = 0; rr < LNR; ++rr) {
            const int m = m0 + rr * NGW;
            const float aff = 1.0f / (1.0f + expf(-lg[rr]));
            const float sel = aff + brv;
            float sv[16], av[16];
#pragma unroll
            for (int e = 0; e < NE; ++e) { sv[e] = rdl(sel, 4 * e); av[e] = rdl(aff, 4 * e); }
            int gbest = 0; float gscore = -3.0e38f;
#pragma unroll
            for (int g = 0; g < 4; ++g) {
                const float a0 = sv[4 * g], a1 = sv[4 * g + 1], a2 = sv[4 * g + 2], a3 = sv[4 * g + 3];
                const float t2 = fmaxf(fmaxf(fmaxf(a0 + a1, a0 + a2), fmaxf(a0 + a3, a1 + a2)), fmaxf(a1 + a3, a2 + a3));
                if (t2 > gscore) { gscore = t2; gbest = g; }
            }
            float g0 = 0.f, g1 = 0.f, g2 = 0.f, g3 = 0.f, f0 = 0.f, f1 = 0.f, f2 = 0.f, f3 = 0.f;
#pragma unroll
            for (int g = 0; g < 4; ++g) if (g == gbest) { g0 = sv[4 * g]; g1 = sv[4 * g + 1]; g2 = sv[4 * g + 2]; g3 = sv[4 * g + 3]; f0 = av[4 * g]; f1 = av[4 * g + 1]; f2 = av[4 * g + 2]; f3 = av[4 * g + 3]; }
            int i0 = 0; float b0 = g0; if (g1 > b0) { b0 = g1; i0 = 1; } if (g2 > b0) { b0 = g2; i0 = 2; } if (g3 > b0) { b0 = g3; i0 = 3; }
            int i1 = -1; float b1 = -3.0e38f;
            if (i0 != 0 && g0 > b1) { b1 = g0; i1 = 0; } if (i0 != 1 && g1 > b1) { b1 = g1; i1 = 1; } if (i0 != 2 && g2 > b1) { b1 = g2; i1 = 2; } if (i0 != 3 && g3 > b1) { b1 = g3; i1 = 3; }
            const float a_0 = i0 == 0 ? f0 : i0 == 1 ? f1 : i0 == 2 ? f2 : f3, a_1 = i1 == 0 ? f0 : i1 == 1 ? f1 : i1 == 2 ? f2 : f3;
            const float inv = 1.0f / (a_0 + a_1);
            const int e0 = gbest * 4 + i0, e1 = gbest * 4 + i1;
            if (F.lane == 0 && m < NTOK) {
                const int lr = F.wave * 8 + nrow * LNR + rr;
                RE[2 * lr] = e0; RE[2 * lr + 1] = e1; RTOK[lr] = m; tokw[m] = (f32x2){a_0 * inv, a_1 * inv};
            }
        }
        ++nrow;
    }
    __syncthreads();
    if (F.tid < NE) { int c = 0; for (int j = 0; j < 128; ++j) c += (RE[j] == F.tid) ? 1 : 0;
        BASE[F.tid] = c ? (int)__hip_atomic_fetch_add(cnt + 64 * F.tid, (unsigned)c, RLX_AGENT) : 0; }
    __syncthreads();
    if (F.tid < 128 && RE[F.tid] >= 0) { const int j = F.tid, e = RE[j]; int rank = 0; for (int k = 0; k < j; ++k) rank += (RE[k] == e) ? 1 : 0;
        const int slot = BASE[e] + rank, tokn = RTOK[j >> 1];
        list[e * NTOK + slot] = tokn; ((int*)tokes)[tokn * 4 + (j & 1) * 2] = e; ((int*)tokes)[tokn * 4 + (j & 1) * 2 + 1] = slot; }
}
__device__ __forceinline__ void moe_prefix(Frame& F, int layer) {
    __syncthreads();
    if (F.tid == 0) {
        unsigned* cnt = F.ctl + CW_CNT + layer * 16 * 64; int acc = 0;
        for (int e = 0; e < NE; ++e) { F.LC[LC_TSTART + e] = (unsigned)acc; const unsigned c = __hip_atomic_load(cnt + 64 * e, RLX_AGENT); F.LC[LC_CNTS + e] = c; acc += (int)((c + 255u) >> 8); }
        F.LC[LC_TSTART + 16] = (unsigned)acc;
    }
    __syncthreads();
}
__device__ __forceinline__ void moe_gather_phase(Frame& F, const Args& A, int layer) {
    moe_prefix(F, layer);
    const bf16_t* xb = (const bf16_t*)(A.ws + WS_CAT); bf16_t* xg = (bf16_t*)(A.ws + WS_ARENA);
    const i32x4* tokes = (const i32x4*)(A.ws + WS_TOKES); int* tokrow = (int*)(A.ws + WS_TOKROW);
    const int gw = F.vcu * NWAVES + F.wave, NGW = F.G * NWAVES;
    for (int m = gw; m < NTOK; m += NGW) {
        const i32x4 es = tokes[m];
        const int r0 = (int)F.LC[LC_TSTART + es[0]] * 256 + es[1], r1 = (int)F.LC[LC_TSTART + es[2]] * 256 + es[3];
        const u32x4* src = (const u32x4*)(xb + (size_t)m * DM) + F.lane;
        const u32x4 a = src[0], b = src[64];
        u32x4* d0 = (u32x4*)(xg + (size_t)r0 * DM) + F.lane; u32x4* d1 = (u32x4*)(xg + (size_t)r1 * DM) + F.lane;
        d0[0] = a; d0[64] = b; d1[0] = a; d1[64] = b;
        if (F.lane == 0) { tokrow[2 * m] = r0; tokrow[2 * m + 1] = r1; }
    }
}
__device__ __forceinline__ void ln_b_phase(Frame& F, const Args& A, int layer, bool write_bf16) {
    float* xout = A.out; bf16_t* xb = (bf16_t*)(A.ws + WS_H); const bf16_t* xin = (const bf16_t*)(A.ws + WS_CAT);
    const bf16_t* Y = (const bf16_t*)(A.ws + WS_ARENA);
    const float* gam = A.in[layer ? I_LNFG1 : I_LNFG0]; const float* bet = A.in[layer ? I_LNFB1 : I_LNFB0];
    const i32x4* tokes = (const i32x4*)(A.ws + WS_TOKES); const f32x2* tokw = (const f32x2*)(A.ws + WS_TOKW);
    moe_prefix(F, layer);
#define TOKROWS(m_, r0_, r1_) do { const i32x4 es_ = tokes[m_]; r0_ = (int)F.LC[LC_TSTART + es_[0]] * 256 + es_[1]; r1_ = (int)F.LC[LC_TSTART + es_[2]] * 256 + es_[3]; } while (0)
    const int gw = F.vcu * NWAVES + F.wave, NGW = F.G * NWAVES;
    u32x2 nx[LNR][4], ny0[LNR][4], ny1[LNR][4]; f32x2 nw[LNR]; int rf0[LNR], rf1[LNR];
#pragma unroll
    for (int rr = 0; rr < LNR; ++rr) { const int m = gw + rr * NGW; nw[rr] = (f32x2){0.f, 0.f}; rf0[rr] = 0; rf1[rr] = 0;
        if (m < NTOK) { int r0, r1; TOKROWS(m, r0, r1); nw[rr] = tokw[m];
#pragma unroll
            for (int j = 0; j < 4; ++j) { nx[rr][j] = ((const u32x2*)(xin + (size_t)m * DM))[F.lane + 64 * j]; ny0[rr][j] = ((const u32x2*)(Y + (size_t)r0 * DM))[F.lane + 64 * j]; ny1[rr][j] = ((const u32x2*)(Y + (size_t)r1 * DM))[F.lane + 64 * j]; } }
        const int mf = gw + (LNR + rr) * NGW; if (mf < NTOK) { TOKROWS(mf, rf0[rr], rf1[rr]); } }
    for (int m0 = gw; m0 < NTOK; m0 += LNR * NGW) {
        f32x4 v[LNR][4]; float s[LNR];
#pragma unroll
        for (int rr = 0; rr < LNR; ++rr) { s[rr] = 0.f; const f32x2 w = nw[rr];
#pragma unroll
            for (int j = 0; j < 4; ++j) {
                const u32x2 x = nx[rr][j], a = ny0[rr][j], b = ny1[rr][j];
                v[rr][j][0] = ALPHA * bf_lo(x.x) + w[0] * bf_lo(a.x) + w[1] * bf_lo(b.x); v[rr][j][1] = ALPHA * bf_hi(x.x) + w[0] * bf_hi(a.x) + w[1] * bf_hi(b.x);
                v[rr][j][2] = ALPHA * bf_lo(x.y) + w[0] * bf_lo(a.y) + w[1] * bf_lo(b.y); v[rr][j][3] = ALPHA * bf_hi(x.y) + w[0] * bf_hi(a.y) + w[1] * bf_hi(b.y);
                s[rr] += (v[rr][j][0] + v[rr][j][1]) + (v[rr][j][2] + v[rr][j][3]); } }
#pragma unroll
        for (int rr = 0; rr < LNR; ++rr) { const int mn = m0 + (LNR + rr) * NGW;
            if (mn < NTOK) { nw[rr] = tokw[mn]; const int r0 = rf0[rr], r1 = rf1[rr];
#pragma unroll
                for (int j = 0; j < 4; ++j) { nx[rr][j] = ((const u32x2*)(xin + (size_t)mn * DM))[F.lane + 64 * j]; ny0[rr][j] = ((const u32x2*)(Y + (size_t)r0 * DM))[F.lane + 64 * j]; ny1[rr][j] = ((const u32x2*)(Y + (size_t)r1 * DM))[F.lane + 64 * j]; }
                const int mf = mn + LNR * NGW; if (mf < NTOK) { TOKROWS(mf, rf0[rr], rf1[rr]); } } }
        float mean[LNR], rstd[LNR];
#pragma unroll
        for (int rr = 0; rr < LNR; ++rr) mean[rr] = wave_sum(s[rr]) * (1.f / DM);
#pragma unroll
        for (int rr = 0; rr < LNR; ++rr) { float s2 = 0.f;
#pragma unroll
            for (int j = 0; j < 4; ++j) { v[rr][j] = v[rr][j] - mean[rr]; s2 += (v[rr][j][0] * v[rr][j][0] + v[rr][j][1] * v[rr][j][1]) + (v[rr][j][2] * v[rr][j][2] + v[rr][j][3] * v[rr][j][3]); }
            s[rr] = s2; }
#pragma unroll
        for (int rr = 0; rr < LNR; ++rr) rstd[rr] = 1.f / sqrtf(wave_sum(s[rr]) * (1.f / DM) + LN_EPS);
#pragma unroll
        for (int rr = 0; rr < LNR; ++rr) { const int m = m0 + rr * NGW; if (m < NTOK) {
            f32x4* xr = (f32x4*)(xout + (size_t)m * DM) + F.lane; u32x2* o8 = (u32x2*)(xb + (size_t)m * DM) + F.lane;
#pragma unroll
            for (int j = 0; j < 4; ++j) { const f32x4 gj = ((const f32x4*)gam)[F.lane + 64 * j], bj = ((const f32x4*)bet)[F.lane + 64 * j];
                v[rr][j] = v[rr][j] * rstd[rr] * gj + bj;
                if (write_bf16) { u32x2 w2; w2.x = cvtpk(v[rr][j][0], v[rr][j][1]); w2.y = cvtpk(v[rr][j][2], v[rr][j][3]); o8[64 * j] = w2; }
                else xr[64 * j] = v[rr][j]; } } }
    }
#undef TOKROWS
}
__device__ __forceinline__ void scale_phase(Frame& F, const float* src, float* dst) {
    const int gw = F.vcu * NWAVES + F.wave, NGW = F.G * NWAVES;
    for (int m = gw; m < NTOK; m += NGW) {
        const f32x4* xr = (const f32x4*)(src + (size_t)m * DM) + F.lane; f32x4* o = (f32x4*)(dst + (size_t)m * DM) + F.lane;
#pragma unroll
        for (int j = 0; j < 4; ++j) o[64 * j] = xr[64 * j] * ALPHA;
    }
}

__device__ __forceinline__ int q_next(Frame& F, int q) {
    __syncthreads();
    if (F.tid == 0) F.LC[LC_Q] = __hip_atomic_fetch_add(F.ctl + CW_QUEUE + 64 * q, 1u, RLX_AGENT);
    __syncthreads();
    return (int)F.LC[LC_Q];
}

__device__ __forceinline__ void ssm_pow_tables(Frame& F, const Args& A) {
    f32x2* apow = (f32x2*)(A.ws + WS_APOW); f32x2* ftab = (f32x2*)(A.ws + WS_FTAB);
    const int gt = F.vcu * NTHR + F.tid, NGT = F.G * NTHR;
    for (int it = gt; it < 32 * 64 * 65; it += NGT) {
        const int n = it % 65, gp = it / 65, g = gp >> 6;
        const double dt = exp((double)A.in[I_LOGDT][g]);
        const double lr = (double)A.in[I_LAMRE][gp], li = (double)A.in[I_LAMIM][gp];
        const double mag = exp(lr * dt * (double)n);
        double th = li * dt * (double)n; th -= 6.283185307179586476925 * rint(th * 0.15915494309189533577);
        const double c = cos(th), s = sin(th);
        apow[it] = (f32x2){(float)(mag * c), (float)(mag * s)};
        if (n == 1) { const double are = mag * c, aim = mag * s, nr = are - 1.0, den = lr * lr + li * li;
            ftab[gp] = (f32x2){(float)((nr * lr + aim * li) / den), (float)((aim * lr - nr * li) / den)}; }
    }
}
__device__ __forceinline__ void ssm_frag_tables(Frame& F, const Args& A) {
    const f32x2* apow = (const f32x2*)(A.ws + WS_APOW); const f32x2* ftab = (const f32x2*)(A.ws + WS_FTAB);
    const float* bre = A.in[I_BRE]; const float* bim = A.in[I_BIM]; const float* cre = A.in[I_CRE]; const float* cim = A.in[I_CIM];
    const int gt = F.vcu * NTHR + F.tid, NGT = F.G * NTHR;
    constexpr int N_KF = 32 * 64 * 64, N_WF = 32 * 8 * 32 * 64, N_VF = 32 * 64 * 4 * 64;
    for (int it = gt; it < N_KF + N_WF + N_VF; it += NGT) {
        float v[8];
        if (it < N_KF) {
            const int lane = it & 63, tau0 = (it >> 6) & 63, g = it >> 12;
            const int h = lane & 15, kq = lane >> 4, jj = kq >> 1, hb = (kq & 1) * 8, tau = tau0 - jj;
#pragma unroll
            for (int e = 0; e < 8; ++e) v[e] = 0.f;
            if (tau >= 0) {
                for (int p = 0; p < 64; ++p) {
                    const int gp = g * 64 + p; const f32x2 a = apow[gp * 65 + tau], f = ftab[gp];
                    const float cr = cre[(g * 16 + h) * 64 + p], ci = cim[(g * 16 + h) * 64 + p];
                    const float mr = cr * a[0] - ci * a[1], mi = cr * a[1] + ci * a[0];
                    const float nr = mr * f[0] - mi * f[1], ni = mr * f[1] + mi * f[0];
#pragma unroll
                    for (int e = 0; e < 8; ++e) { const float br = bre[gp * 16 + hb + e], bi = bim[gp * 16 + hb + e]; v[e] += nr * br - ni * bi; }
                }
            }
            u32x4 w; w.x = cvtpk(v[0], v[1]); w.y = cvtpk(v[2], v[3]); w.z = cvtpk(v[4], v[5]); w.w = cvtpk(v[6], v[7]);
            ((u32x4*)(A.ws + SSM_KF))[it] = w;
        } else if (it < N_KF + N_WF) {
            const int r = it - N_KF; const int lane = r & 63, js = (r >> 6) & 31, mt = (r >> 11) & 7, g = r >> 14;
            const int rr = 16 * mt + (lane & 15), ri = rr >> 6, p = rr & 63, kq = lane >> 4, j = 2 * js + (kq >> 1), hb = (kq & 1) * 8;
            const int gp = g * 64 + p; const f32x2 a = apow[gp * 65 + (63 - j)], f = ftab[gp];
            const float mr = a[0] * f[0] - a[1] * f[1], mi = a[0] * f[1] + a[1] * f[0];
#pragma unroll
            for (int e = 0; e < 8; ++e) { const float br = bre[gp * 16 + hb + e], bi = bim[gp * 16 + hb + e]; v[e] = ri == 0 ? (mr * br - mi * bi) : (mr * bi + mi * br); }
            u32x4 w; w.x = cvtpk(v[0], v[1]); w.y = cvtpk(v[2], v[3]); w.z = cvtpk(v[4], v[5]); w.w = cvtpk(v[6], v[7]);
            ((u32x4*)(A.ws + SSM_WF))[r] = w;
        } else {
            const int r = it - N_KF - N_WF; const int lane = r & 63, ks = (r >> 6) & 3, i = (r >> 8) & 63, g = r >> 14;
            const int h = lane & 15, kq = lane >> 4;
#pragma unroll
            for (int e = 0; e < 8; ++e) { const int rr = 32 * ks + 8 * kq + e, ri = rr >> 6, p = rr & 63, gp = g * 64 + p; const f32x2 a = apow[gp * 65 + i + 1];
                const float cr = cre[(g * 16 + h) * 64 + p], ci = cim[(g * 16 + h) * 64 + p];
                v[e] = ri == 0 ? (cr * a[0] - ci * a[1]) : -(cr * a[1] + ci * a[0]); }
            u32x4 w; w.x = cvtpk(v[0], v[1]); w.y = cvtpk(v[2], v[3]); w.z = cvtpk(v[4], v[5]); w.w = cvtpk(v[6], v[7]);
            ((u32x4*)(A.ws + SSM_VF))[r] = w;
        }
    }
}

constexpr int SS_KF = 0, SS_UB = 65536, SS_S = 131072, SS_XP = 147456;
__device__ __forceinline__ void ssm_unit(Frame& F, const Args& A, int b, int g) {
    const bf16_t* qkvu = (const bf16_t*)(A.ws + WS_ARENA); bf16_t* hbuf = (bf16_t*)(A.ws + WS_H);
    const int lane = F.lane, w = F.wave, fr = lane & 15, kq = lane >> 4;
    LAS unsigned char* L = F.lds;
    const u32x4* kfsrc = (const u32x4*)(A.ws + SSM_KF) + (size_t)g * 4096;
#pragma unroll
    for (int i = 0; i < 8; ++i) { const int idx = F.tid + i * NTHR; *(LAS u32x4*)(L + SS_KF + idx * 16) = kfsrc[idx]; }
#pragma unroll
    for (int i = 0; i < 8; ++i) { const int idx = F.tid + i * NTHR; const int ln = idx & 63, nt = (idx >> 6) & 1, js = idx >> 7;
        const int c = 16 * nt + (ln & 15), q4 = ln >> 4, tok = 64 * c + 2 * js + (q4 >> 1);
        *(LAS u32x4*)(L + SS_UB + idx * 16) = *(const u32x4*)(qkvu + (size_t)(b * SEQ + tok) * 2048 + 1536 + 16 * g + (q4 & 1) * 8); }
    __syncthreads();
    {
        f32x4 a0 = {0.f, 0.f, 0.f, 0.f}, a1 = {0.f, 0.f, 0.f, 0.f};
        const bf16x8* wf = (const bf16x8*)(A.ws + SSM_WF) + ((size_t)(g * 8 + w) * 32) * 64 + lane;
#pragma unroll 4
        for (int js = 0; js < 32; ++js) {
            const bf16x8 af = wf[js * 64];
            const bf16x8 b0 = *(const LAS bf16x8*)(L + SS_UB + ((js * 2 + 0) * 64 + lane) * 16), b1 = *(const LAS bf16x8*)(L + SS_UB + ((js * 2 + 1) * 64 + lane) * 16);
            a0 = __builtin_amdgcn_mfma_f32_16x16x32_bf16(af, b0, a0, 0, 0, 0); a1 = __builtin_amdgcn_mfma_f32_16x16x32_bf16(af, b1, a1, 0, 0, 0);
        }
        LAS float* S = (LAS float*)(L + SS_S);
#pragma unroll
        for (int r = 0; r < 4; ++r) { S[(16 * w + 4 * kq + r) * 32 + fr] = a0[r]; S[(16 * w + 4 * kq + r) * 32 + 16 + fr] = a1[r]; }
    }
    __syncthreads();
    if (w == 0) {
        const f32x2 a64 = ((const f32x2*)(A.ws + WS_APOW))[(g * 64 + lane) * 65 + 64];
        const LAS float* S = (const LAS float*)(L + SS_S); LAS bf16_t* Xp = (LAS bf16_t*)(L + SS_XP);
        float xr = 0.f, xi = 0.f;
        for (int c = 0; c < 32; ++c) {
            const unsigned pk = cvtpk(xr, xi);
            Xp[c * 128 + lane] = (bf16_t)(pk & 0xffffu); Xp[c * 128 + 64 + lane] = (bf16_t)(pk >> 16);
            const float sr = S[lane * 32 + c], si = S[(64 + lane) * 32 + c];
            const float nr = a64[0] * xr - a64[1] * xi + sr, ni = a64[0] * xi + a64[1] * xr + si;
            xr = nr; xi = ni;
        }
    }
    __syncthreads();
    const float* dsk = A.in[I_SSMD] + 16 * g + 4 * kq;
    const f32x4 dv = *(const f32x4*)dsk;
    for (int ii = 0; ii < 8; ++ii) {
        const int i = w + 8 * ii;
        f32x4 a0 = {0.f, 0.f, 0.f, 0.f}, a1 = {0.f, 0.f, 0.f, 0.f};
        const bf16x8* vf = (const bf16x8*)(A.ws + SSM_VF) + ((size_t)(g * 64 + i) * 4) * 64 + lane;
#pragma unroll
        for (int ks = 0; ks < 4; ++ks) {
            const bf16x8 af = vf[ks * 64];
            const bf16x8 b0 = *(const LAS bf16x8*)(L + SS_XP + (fr * 128 + 32 * ks + 8 * kq) * 2), b1 = *(const LAS bf16x8*)(L + SS_XP + ((16 + fr) * 128 + 32 * ks + 8 * kq) * 2);
            a0 = __builtin_amdgcn_mfma_f32_16x16x32_bf16(af, b0, a0, 0, 0, 0); a1 = __builtin_amdgcn_mfma_f32_16x16x32_bf16(af, b1, a1, 0, 0, 0);
        }
        const int njs = (i >> 1) + 1;
        for (int js = 0; js < njs; ++js) {
            const bf16x8 af = *(const LAS bf16x8*)(L + SS_KF + ((i - 2 * js) * 64 + lane) * 16);
            const bf16x8 b0 = *(const LAS bf16x8*)(L + SS_UB + ((js * 2 + 0) * 64 + lane) * 16), b1 = *(const LAS bf16x8*)(L + SS_UB + ((js * 2 + 1) * 64 + lane) * 16);
            a0 = __builtin_amdgcn_mfma_f32_16x16x32_bf16(af, b0, a0, 0, 0, 0); a1 = __builtin_amdgcn_mfma_f32_16x16x32_bf16(af, b1, a1, 0, 0, 0);
        }
#pragma unroll
        for (int nt = 0; nt < 2; ++nt) {
            const f32x4 acc = nt ? a1 : a0; const int tok = 64 * (16 * nt + fr) + i; const size_t row = (size_t)(b * SEQ + tok);
            const u32x2 uu = *(const u32x2*)(qkvu + row * 2048 + 1536 + 16 * g + 4 * kq);
            const float y0 = acc[0] + dv[0] * bf_lo(uu.x), y1 = acc[1] + dv[1] * bf_hi(uu.x), y2 = acc[2] + dv[2] * bf_lo(uu.y), y3 = acc[3] + dv[3] * bf_hi(uu.y);
            u32x2 o; o.x = cvtpk(gelu_tanh(y0), gelu_tanh(y1)); o.y = cvtpk(gelu_tanh(y2), gelu_tanh(y3));
            *(u32x2*)(hbuf + row * 512 + 16 * g + 4 * kq) = o;
        }
    }
}

__device__ __forceinline__ int crow(int r, int hi) { return (r & 3) + 8 * (r >> 2) + 4 * hi; }
__device__ __forceinline__ void qkt_tile(f32x16& p0, f32x16& p1, const LAS unsigned char* Ks, const bf16x8 (&qr)[4], int r32, int hi) {
    const LAS unsigned char* kb = Ks + hi * 1024 + r32 * 16;
    p0 = (f32x16){}; p1 = (f32x16){};
#pragma unroll
    for (int d0 = 0; d0 < 4; ++d0) {
        const bf16x8 b0 = *(const LAS bf16x8*)(kb + d0 * 2048), b1 = *(const LAS bf16x8*)(kb + d0 * 2048 + 512);
        p0 = __builtin_amdgcn_mfma_f32_32x32x16_bf16(b0, qr[d0], p0, 0, 0, 0); p1 = __builtin_amdgcn_mfma_f32_32x32x16_bf16(b1, qr[d0], p1, 0, 0, 0);
    }
}
__device__ __forceinline__ s16x4 vtr(const LAS unsigned char* p) { typedef short v4i16_t __attribute__((ext_vector_type(4))); return __builtin_bit_cast(s16x4, __builtin_amdgcn_ds_read_tr16_b64_v4i16((LAS v4i16_t*)p)); }
__device__ __forceinline__ void pv_tile(f32x16 (&o)[2], const LAS unsigned char* Vs, const f32x16& p0, const f32x16& p1, int lane) {
    const int hi = lane >> 5;
    const LAS unsigned char* vb = Vs + ((lane >> 4) & 1) * 32 + (lane & 3) * 8 + (4 * hi + ((lane & 15) >> 2)) * 64;
    u32x4 pw[4];
#pragma unroll
    for (int s = 0; s < 2; ++s) {
        pw[s] = (u32x4){cvtpk(p0[8 * s], p0[8 * s + 1]), cvtpk(p0[8 * s + 2], p0[8 * s + 3]), cvtpk(p0[8 * s + 4], p0[8 * s + 5]), cvtpk(p0[8 * s + 6], p0[8 * s + 7])};
        pw[2 + s] = (u32x4){cvtpk(p1[8 * s], p1[8 * s + 1]), cvtpk(p1[8 * s + 2], p1[8 * s + 3]), cvtpk(p1[8 * s + 4], p1[8 * s + 5]), cvtpk(p1[8 * s + 6], p1[8 * s + 7])};
    }
#pragma unroll
    for (int d0 = 0; d0 < 2; ++d0)
#pragma unroll
        for (int ks = 0; ks < 4; ++ks) {
            const s16x4 lo = vtr(vb + d0 * 4096 + ks * 1024), hh = vtr(vb + d0 * 4096 + ks * 1024 + 512);
            const bf16x8 vf = (bf16x8){lo[0], lo[1], lo[2], lo[3], hh[0], hh[1], hh[2], hh[3]};
            o[d0] = __builtin_amdgcn_mfma_f32_32x32x16_bf16(__builtin_bit_cast(bf16x8, pw[ks]), vf, o[d0], 0, 0, 0);
        }
}
__device__ __forceinline__ void kv_load(u32x4& kreg, u32x4& vreg, const bf16_t* Kbase, const bf16_t* Vbase, int pitch, int key0, int wave, int lane) {
    kreg = *(const u32x4*)(Kbase + (size_t)(key0 + lane) * pitch + wave * 8);
    vreg = *(const u32x4*)(Vbase + (size_t)(key0 + 16 * (wave & 3) + (lane >> 2)) * pitch + (wave >> 2) * 32 + (lane & 3) * 8);
}
__device__ __forceinline__ void kv_store(LAS unsigned char* Ks, LAS unsigned char* Vs, const u32x4& kreg, const u32x4& vreg, int wave, int lane) {
    *(LAS u32x4*)(Ks + wave * 1024 + lane * 16) = kreg; *(LAS u32x4*)(Vs + wave * 1024 + lane * 16) = vreg;
}
__device__ __forceinline__ void o_store(const f32x16 (&o)[2], bf16_t* dst, int pitch, int lane) {
    const int hi = lane >> 5, c = lane & 31;
#pragma unroll
    for (int d0 = 0; d0 < 2; ++d0)
#pragma unroll
        for (int r = 0; r < 16; ++r) { const unsigned pk = cvtpk(o[d0][r], 0.f); dst[(size_t)crow(r, hi) * pitch + 32 * d0 + c] = (bf16_t)(pk & 0xffffu); }
}

constexpr int AT_K = 0, AT_V = 8192, AT_DONE = 16384;
constexpr float SB_DONE = -110.0f;
__device__ __forceinline__ void sb_unit(Frame& F, const Args& A, int b, int h, int qb) {
    const bf16_t* qkvu = (const bf16_t*)(A.ws + WS_ARENA); bf16_t* cat = (bf16_t*)(A.ws + WS_CAT);
    const int lane = F.lane, w = F.wave, r32 = lane & 31, hi = lane >> 5;
    const int t0 = qb * 256, trow = t0 + 32 * w + r32;
    const bf16_t* Qp = qkvu + (size_t)(b * SEQ + trow) * 2048 + h * 64 + hi * 8;
    const bf16_t* Kb = qkvu + (size_t)(b * SEQ) * 2048 + 512 + h * 64; const bf16_t* Vb = qkvu + (size_t)(b * SEQ) * 2048 + 1024 + h * 64;
    bf16x8 qr[4];
#pragma unroll
    for (int d0 = 0; d0 < 4; ++d0) qr[d0] = *(const bf16x8*)(Qp + 16 * d0);
    f32x16 o[2]; o[0] = (f32x16){}; o[1] = (f32x16){};
    float carry = 0.f; bool wdone = false;
    LAS unsigned char* Ks = F.lds + AT_K; LAS unsigned char* Vs = F.lds + AT_V; volatile LAS unsigned* donec = (volatile LAS unsigned*)(F.lds + AT_DONE);
    if (F.tid == 0) donec[0] = 0u;
    u32x4 kreg, vreg;
    const int kt_hi = 4 * qb + 3;
    kv_load(kreg, vreg, Kb, Vb, 2048, 64 * kt_hi, w, lane);
    for (int kt = kt_hi; kt >= 0; --kt) {
        __syncthreads();
        if (donec[0] == 8u) break;
        kv_store(Ks, Vs, kreg, vreg, w, lane);
        if (kt > 0) kv_load(kreg, vreg, Kb, Vb, 2048, 64 * (kt - 1), w, lane);
        __syncthreads();
        if (!wdone && 64 * kt <= t0 + 32 * w + 30) {
            f32x16 p0, p1; qkt_tile(p0, p1, Ks, qr, r32, hi);
            float l0[16], l1[16];
#pragma unroll
            for (int r = 0; r < 16; ++r) {
                const int kv = 64 * kt + crow(r, hi);
                { const float z = p0[r] * 0.125f; const float sp = fmaxf(z, 0.f) + 0.6931471805599453f * __builtin_amdgcn_logf(1.0f + fast_exp(-fabsf(z))); const bool ok = kv < trow; l0[r] = ok ? -sp : 0.f; p0[r] = ok ? (z - sp) : -1.0e30f; }
                { const float z = p1[r] * 0.125f; const float sp = fmaxf(z, 0.f) + 0.6931471805599453f * __builtin_amdgcn_logf(1.0f + fast_exp(-fabsf(z))); const bool ok = (kv + 32) < trow; l1[r] = ok ? -sp : 0.f; p1[r] = ok ? (z - sp) : -1.0e30f; }
            }
            float gs[8], og[8];
#pragma unroll
            for (int rg = 0; rg < 4; ++rg) { gs[rg] = (l0[4 * rg] + l0[4 * rg + 1]) + (l0[4 * rg + 2] + l0[4 * rg + 3]); gs[4 + rg] = (l1[4 * rg] + l1[4 * rg + 1]) + (l1[4 * rg + 2] + l1[4 * rg + 3]); }
#pragma unroll
            for (int k = 0; k < 8; ++k) og[k] = __shfl_xor(gs[k], 32);
            float sfx[8]; float run = 0.f;
#pragma unroll
            for (int k = 7; k >= 0; --k) {
                const float g_even = hi ? og[k] : gs[k], g_odd = hi ? gs[k] : og[k];
                const float s_odd = run; run += g_odd; const float s_even = run; run += g_even;
                sfx[k] = hi ? s_odd : s_even;
            }
#pragma unroll
            for (int rg = 0; rg < 4; ++rg) {
                { const float base = carry + sfx[rg]; const float a3 = base, a2 = a3 + l0[4 * rg + 3], a1 = a2 + l0[4 * rg + 2], a0 = a1 + l0[4 * rg + 1];
                  p0[4 * rg] = fast_exp(p0[4 * rg] + a0); p0[4 * rg + 1] = fast_exp(p0[4 * rg + 1] + a1); p0[4 * rg + 2] = fast_exp(p0[4 * rg + 2] + a2); p0[4 * rg + 3] = fast_exp(p0[4 * rg + 3] + a3); }
                { const float base = carry + sfx[4 + rg]; const float a3 = base, a2 = a3 + l1[4 * rg + 3], a1 = a2 + l1[4 * rg + 2], a0 = a1 + l1[4 * rg + 1];
                  p1[4 * rg] = fast_exp(p1[4 * rg] + a0); p1[4 * rg + 1] = fast_exp(p1[4 * rg + 1] + a1); p1[4 * rg + 2] = fast_exp(p1[4 * rg + 2] + a2); p1[4 * rg + 3] = fast_exp(p1[4 * rg + 3] + a3); }
            }
            carry += run;
            pv_tile(o, Vs, p0, p1, lane);
            if (__all(carry < SB_DONE)) { wdone = true; if (lane == 0) __hip_atomic_fetch_add((LAS unsigned*)(F.lds + AT_DONE), 1u, __ATOMIC_RELAXED, __HIP_MEMORY_SCOPE_WORKGROUP); }
        }
    }
    o_store(o, cat + (size_t)(b * SEQ + t0 + 32 * w) * 1024 + h * 64, 1024, lane);
}

__device__ __forceinline__ void l0_mixer_phase(Frame& F, const Args& A, int qid) {
    for (int u = blockIdx.x; u < 256; u += F.G) { __syncthreads(); ssm_unit(F, A, u >> 5, u & 31); }
    for (;;) {
        const int t = q_next(F, qid);
        if (t >= 512) break;
        sb_unit(F, A, (t & 63) >> 3, t & 7, 7 - (t >> 6));
    }
}

__device__ __forceinline__ void nsa_small_tables(Frame& F, const Args& A) {
    const int gt = F.vcu * NTHR + F.tid, NGT = F.G * NTHR;
    float* rc = (float*)(A.ws + WS_ROPE); float* rs = rc + 2048 * 32;
    for (int it = gt; it < 2048 * 32; it += NGT) {
        const int pos = it >> 5, i = it & 31;
        const double inv = exp(-9.210340371976182736 * (double)i / 32.0);
        double th = (double)pos * inv; th -= 6.283185307179586476925 * rint(th * 0.15915494309189533577);
        rc[it] = (float)cos(th); rs[it] = (float)sin(th);
    }
    {
        float* part = (float*)(A.ws + WS_CBIAS) + 512;
        const int gwv = F.vcu * NWAVES + F.wave, NGWV = F.G * NWAVES;
        for (int task = gwv; task < 128; task += NGWV) {
            const int kv = task >> 6, kc = task & 63; const float* pos = A.in[kv ? I_CPV : I_CPK]; const float* w1 = A.in[kv ? I_CW1V : I_CW1K];
            f32x4 acc = {0.f, 0.f, 0.f, 0.f};
#pragma unroll 8
            for (int i = 0; i < 32; ++i) { const int kk = kc * 32 + i; const f32x4 w = ((const f32x4*)(w1 + (size_t)kk * 256))[F.lane]; acc += w * pos[kk]; }
            ((f32x4*)(part + (size_t)(kc * 2 + kv) * 256))[F.lane] = acc;
        }
    }
    bf16_t* w2t = (bf16_t*)(A.ws + WS_CW2T);
    for (int it = gt; it < 2 * 64 * 256; it += NGT) {
        const int kv = it >> 14, n = (it >> 8) & 63, k = it & 255; const float* w2 = A.in[kv ? I_CW2V : I_CW2K];
        w2t[it] = (bf16_t)(cvtpk(w2[k * 64 + n], 0.f) & 0xffffu);
    }
}

__device__ __forceinline__ void nsa_cbias_final(Frame& F, const Args& A) {
    if (blockIdx.x == 0) { float* cb = (float*)(A.ws + WS_CBIAS); const float* part = cb + 512; const int kv = F.tid >> 8, n = F.tid & 255; float s = 0.f;
        for (int kc = 0; kc < 64; ++kc) s += part[(size_t)(kc * 2 + kv) * 256 + n];
        cb[F.tid] = s; }
}
constexpr int CP_A = 0, CP_B = 2 * 64 * 144, CP_H = CP_B + 2 * 256 * 144;
__device__ __forceinline__ void cmp_unit(Frame& F, const Args& A, int kv, int rb) {
    const bf16_t* proj = (const bf16_t*)(A.ws + WS_ARENA);
    const bf16_t* w1t = (const bf16_t*)(A.ws + WS_CW1T) + (size_t)kv * 256 * 2048;
    const bf16_t* w2t = (const bf16_t*)(A.ws + WS_CW2T) + kv * 64 * 256;
    const float* cb = (const float*)(A.ws + WS_CBIAS) + kv * 256;
    bf16_t* outp = (bf16_t*)(A.ws + WS_KCMP) + (size_t)kv * (8 * 4 * 128 * 64);
    const int lane = F.lane, w = F.wave, fr = lane & 15, kq = lane >> 4, tid = F.tid;
    LAS unsigned char* L = F.lds;
    const int arow = tid >> 3, ach = tid & 7;
    const int R = rb * 64 + arow, ab = R >> 9, am = (R >> 2) & 127, ag = R & 3;
    const bf16_t* asrc = proj + (size_t)(ab * SEQ + 16 * am) * 2560 + (kv ? 1280 : 1024) + ag * 64 + ach * 8;
    const bf16_t* bsrc = w1t + (size_t)(tid >> 3) * 2048 + ach * 8;
    u32x4 areg, breg[4];
    areg = *(const u32x4*)asrc;
#pragma unroll
    for (int i = 0; i < 4; ++i) breg[i] = *(const u32x4*)(bsrc + (size_t)i * 64 * 2048);
    f32x4 acc[4][2];
#pragma unroll
    for (int m = 0; m < 4; ++m) { acc[m][0] = (f32x4){0.f, 0.f, 0.f, 0.f}; acc[m][1] = (f32x4){0.f, 0.f, 0.f, 0.f}; }
    for (int l = 0; l < 32; ++l) {
        const int buf = l & 1;
        *(LAS u32x4*)(L + CP_A + buf * 9216 + arow * 144 + ach * 16) = areg;
#pragma unroll
        for (int i = 0; i < 4; ++i) *(LAS u32x4*)(L + CP_B + buf * 36864 + ((tid >> 3) + 64 * i) * 144 + ach * 16) = breg[i];
        if (l < 31) { areg = *(const u32x4*)(asrc + (size_t)(l + 1) * 2560);
#pragma unroll
            for (int i = 0; i < 4; ++i) breg[i] = *(const u32x4*)(bsrc + (size_t)i * 64 * 2048 + (l + 1) * 64); }
        __syncthreads();
#pragma unroll
        for (int ks = 0; ks < 2; ++ks) {
            bf16x8 af[4], bfv[2];
#pragma unroll
            for (int m = 0; m < 4; ++m) af[m] = *(const LAS bf16x8*)(L + CP_A + buf * 9216 + (16 * m + fr) * 144 + (32 * ks + 8 * kq) * 2);
#pragma unroll
            for (int n = 0; n < 2; ++n) bfv[n] = *(const LAS bf16x8*)(L + CP_B + buf * 36864 + (32 * w + 16 * n + fr) * 144 + (32 * ks + 8 * kq) * 2);
#pragma unroll
            for (int m = 0; m < 4; ++m)
#pragma unroll
                for (int n = 0; n < 2; ++n) acc[m][n] = __builtin_amdgcn_mfma_f32_16x16x32_bf16(bfv[n], af[m], acc[m][n], 0, 0, 0);
        }
    }
    __syncthreads();
#pragma unroll
    for (int m = 0; m < 4; ++m)
#pragma unroll
        for (int n = 0; n < 2; ++n) { const int col = 32 * w + 16 * n + 4 * kq; const f32x4 bv = *(const f32x4*)(cb + col); const f32x4 v = acc[m][n] + bv;
            u32x2 o; o.x = cvtpk(gelu_tanh(v[0]), gelu_tanh(v[1])); o.y = cvtpk(gelu_tanh(v[2]), gelu_tanh(v[3]));
            *(LAS u32x2*)(L + CP_H + ((16 * m + fr) * 264 + col) * 2) = o; }
    __syncthreads();
    {
        const int rt = w >> 1, c0 = w & 1;
        f32x4 o0 = {0.f, 0.f, 0.f, 0.f}, o1 = {0.f, 0.f, 0.f, 0.f};
#pragma unroll
        for (int ks = 0; ks < 8; ++ks) {
            const bf16x8 af = *(const LAS bf16x8*)(L + CP_H + ((16 * rt + fr) * 264 + 32 * ks + 8 * kq) * 2);
            const bf16x8 b0 = *(const bf16x8*)(w2t + (16 * c0 + fr) * 256 + 32 * ks + 8 * kq), b1 = *(const bf16x8*)(w2t + (16 * (c0 + 2) + fr) * 256 + 32 * ks + 8 * kq);
            o0 = __builtin_amdgcn_mfma_f32_16x16x32_bf16(af, b0, o0, 0, 0, 0); o1 = __builtin_amdgcn_mfma_f32_16x16x32_bf16(af, b1, o1, 0, 0, 0);
        }
        const float* rc = (const float*)(A.ws + WS_ROPE); const float* rs = rc + 2048 * 32;
#pragma unroll
        for (int r = 0; r < 4; ++r) {
            const int Rr = rb * 64 + 16 * rt + 4 * kq + r, b = Rr >> 9, m = (Rr >> 2) & 127, g = Rr & 3, d = 16 * c0 + fr;
            float x1 = o0[r], x2 = o1[r];
            if (kv == 0) { const int pos = (16 * m + 31) & 2047; const float c = rc[pos * 32 + d], s = rs[pos * 32 + d]; const float y1 = x1 * c - x2 * s, y2 = x1 * s + x2 * c; x1 = y1; x2 = y2; }
            if (m == 127) { x1 = 0.f; x2 = 0.f; }
            bf16_t* op = outp + ((size_t)((b * 4 + g) * 128 + m)) * 64;
            op[d] = (bf16_t)(cvtpk(x1, 0.f) & 0xffffu); op[d + 32] = (bf16_t)(cvtpk(x2, 0.f) & 0xffffu);
        }
    }
}

constexpr int NA_K = 0, NA_V = 16384, NA_GS = 32768, NA_LS = 40960, NA_MASK = 49152, NA_WSF = 49152 + 512, NA_SCHED = 49152 + 512 + 1024, NA_STASH = 65536;
__device__ __forceinline__ float half_max(float v) { return fmaxf(v, __shfl_xor(v, 32)); }
__device__ __forceinline__ float half_sum(float v) { return v + __shfl_xor(v, 32); }
__device__ __forceinline__ float tile_max(const f32x16& p0, const f32x16& p1) {
    float a = fmaxf(p0[0], p1[0]);
#pragma unroll
    for (int r = 1; r < 16; ++r) a = fmaxf(a, fmaxf(p0[r], p1[r]));
    return half_max(a);
}
__device__ __forceinline__ float tile_sum(const f32x16& p0, const f32x16& p1) {
    float a = 0.f, b = 0.f;
#pragma unroll
    for (int r = 0; r < 16; ++r) { a += p0[r]; b += p1[r]; }
    return half_sum(a + b);
}
__device__ __forceinline__ void o_rows_mul(f32x16 (&o)[2], LAS float* wsf, float f, int r32, int hi) {
    if (hi == 0) wsf[r32] = f;
    LDS_WAIT();
#pragma unroll
    for (int r = 0; r < 16; ++r) { const float fr_ = wsf[crow(r, hi)]; o[0][r] *= fr_; o[1][r] *= fr_; }
    LDS_WAIT();
}
__device__ __forceinline__ void o_rows_fma(f32x16 (&ot)[2], const f32x16 (&o)[2], LAS float* wsf, float f, int r32, int hi) {
    if (hi == 0) wsf[r32] = f;
    LDS_WAIT();
#pragma unroll
    for (int r = 0; r < 16; ++r) { const float fr_ = wsf[crow(r, hi)]; ot[0][r] += o[0][r] * fr_; ot[1][r] += o[1][r] * fr_; }
    LDS_WAIT();
}
constexpr float FL_THR = 8.0f;
__device__ __forceinline__ float max3f(float a, float b, float c) { float r; asm("v_max3_f32 %0, %1, %2, %3" : "=v"(r) : "v"(a), "v"(b), "v"(c)); return r; }
__device__ __forceinline__ float max2f(float a, float b) { float r; asm("v_max_f32_e32 %0, %1, %2" : "=v"(r) : "v"(a), "v"(b)); return r; }
__device__ __forceinline__ float rowmax32(const f32x16& p0, const f32x16& p1) {
    float a = max3f(p0[0], p0[1], p1[0]), b = max3f(p0[2], p0[3], p1[1]); a = max3f(a, p1[2], p1[3]);
#pragma unroll
    for (int r = 4; r < 16; r += 4) { a = max3f(a, p0[r], p0[r + 1]); b = max3f(b, p0[r + 2], p0[r + 3]); a = max3f(a, p1[r], p1[r + 1]); b = max3f(b, p1[r + 2], p1[r + 3]); }
    const float m = max2f(a, b);
    auto rr = __builtin_amdgcn_permlane32_swap(__float_as_uint(m), __float_as_uint(m), false, false);
    return max2f(__uint_as_float(rr[0]), __uint_as_float(rr[1]));
}
__device__ __forceinline__ float rowsum32(const f32x16& p0, const f32x16& p1) {
    float a = 0.f, b = 0.f;
#pragma unroll
    for (int r = 0; r < 16; ++r) { a += p0[r]; b += p1[r]; }
    const float t = a + b;
    auto rr = __builtin_amdgcn_permlane32_swap(__float_as_uint(t), __float_as_uint(t), false, false);
    return __uint_as_float(rr[0]) + __uint_as_float(rr[1]);
}
template <bool MASKED, bool NOPV = false, class MaskF>
__device__ __forceinline__ void flash3(f32x16 (&o)[2], float& mref, float& l_run, bool& hasref, const LAS unsigned char* Ks, const LAS unsigned char* Vs, const bf16x8 (&qr)[4],
                                       bool rowok, const MaskF& ok, LAS float* wsf, int lane, int r32, int hi) {
    const float c0 = rowok ? -mref : -1.0e30f;
    f32x16 p0, p1;
#pragma unroll
    for (int r = 0; r < 16; ++r) { p0[r] = c0; p1[r] = c0; }
    { const LAS unsigned char* kb = Ks + hi * 1024 + r32 * 16;
#pragma unroll
      for (int d0 = 0; d0 < 4; ++d0) { const bf16x8 b0 = *(const LAS bf16x8*)(kb + d0 * 2048), b1 = *(const LAS bf16x8*)(kb + d0 * 2048 + 512);
          p0 = __builtin_amdgcn_mfma_f32_32x32x16_bf16(b0, qr[d0], p0, 0, 0, 0); p1 = __builtin_amdgcn_mfma_f32_32x32x16_bf16(b1, qr[d0], p1, 0, 0, 0); } }
    asm volatile("s_nop 15\n\ts_nop 7" : "+v"(p0), "+v"(p1));
    if (MASKED) {
#pragma unroll
        for (int r = 0; r < 16; ++r) { p0[r] = ok(r, 0) ? p0[r] : -1.0e30f; p1[r] = ok(r, 1) ? p1[r] : -1.0e30f; }
    }
    const float mx = rowmax32(p0, p1);
    const bool valid = mx > -1.0e29f;
    if (__any((mx > FL_THR) || (valid && !hasref))) {
        const float delta = valid ? (hasref ? fmaxf(mx, 0.f) : mx) : 0.f;
        hasref = hasref || valid;
        mref += delta;
        const float f = __builtin_amdgcn_exp2f(-delta);
        l_run *= f;
        o_rows_mul(o, wsf, f, r32, hi);
#pragma unroll
        for (int r = 0; r < 16; ++r) { p0[r] -= delta; p1[r] -= delta; }
    }
#pragma unroll
    for (int r = 0; r < 16; ++r) { p0[r] = __builtin_amdgcn_exp2f(p0[r]); p1[r] = __builtin_amdgcn_exp2f(p1[r]); }
    l_run += rowsum32(p0, p1);
    if (!NOPV) pv_tile(o, Vs, p0, p1, lane); else { o[0][0] += p0[3] + p1[5]; }
}

template <int MODE>
__device__ __forceinline__ void nsa_unit(Frame& F, const Args& A, int b, int g, int qt) {
    const bf16_t* proj = (const bf16_t*)(A.ws + WS_ARENA); bf16_t* cat = MODE == 0 ? (bf16_t*)(A.ws + WS_CAT) : (bf16_t*)A.out;
    const bf16_t* kc = (const bf16_t*)(A.ws + WS_KCMP) + (size_t)((b * 4 + g) * 128) * 64; const bf16_t* vc = kc + (size_t)(8 * 4 * 128 * 64);
    const float* gate = (const float*)(A.ws + WS_GATE);
    const int lane = (int)__builtin_amdgcn_mbcnt_hi(~0u, __builtin_amdgcn_mbcnt_lo(~0u, 0u)), w = F.wave, r32 = lane & 31, hi = lane >> 5, tid = w * 64 + lane;
    const int t0 = qt * 64, tl = r32 >> 2, hr = r32 & 3, tok = t0 + 8 * w + tl;
    const size_t qrow = (size_t)(b * SEQ + tok);
    LAS unsigned char* L = F.lds;
    LAS float* wsf = (LAS float*)(L + NA_WSF) + w * 32;
    bf16x8 qr[4];
#pragma unroll
    for (int d0 = 0; d0 < 4; ++d0) qr[d0] = *(const bf16x8*)(proj + qrow * 2560 + (g * 4 + hr) * 64 + 16 * d0 + 8 * hi);
    const float g0 = gate[qrow * 48 + (g * 4 + hr) * 3 + 0], g1 = gate[qrow * 48 + (g * 4 + hr) * 3 + 1], g2 = gate[qrow * 48 + (g * 4 + hr) * 3 + 2];
    LAS float* stash = (LAS float*)(L + NA_STASH) + w * 2048;
    u32x4 kreg, vreg;
    const bf16_t* Ksb = proj + (size_t)(b * SEQ) * 2560 + 1536 + g * 64; const bf16_t* Vsb = proj + (size_t)(b * SEQ) * 2560 + 1792 + g * 64;
    const bf16_t* Kwb = proj + (size_t)(b * SEQ) * 2560 + 2048 + g * 64; const bf16_t* Vwb = proj + (size_t)(b * SEQ) * 2560 + 2304 + g * 64;
    const bool two = t0 >= 1024;
    __syncthreads();
    { u32x4 k2, v2; kv_load(kreg, vreg, kc, vc, 64, 0, w, lane); if (two) kv_load(k2, v2, kc, vc, 64, 64, w, lane);
      kv_store(L + NA_K, L + NA_V, kreg, vreg, w, lane); if (two) kv_store(L + NA_K + 8192, L + NA_V + 8192, k2, v2, w, lane); }
    __syncthreads();
    {
        f32x16 ot[2]; ot[0] = (f32x16){}; ot[1] = (f32x16){};
        f32x16 pa0, pa1, pb0, pb1; pb0 = (f32x16){}; pb1 = (f32x16){};
        qkt_tile(pa0, pa1, L + NA_K, qr, r32, hi);
        if (two) qkt_tile(pb0, pb1, L + NA_K + 8192, qr, r32, hi);
        const int mv = tok >= 31 ? ((tok - 31) >> 4) : -1;
        float mx = -1.0e30f;
#pragma unroll
        for (int r = 0; r < 16; ++r) { const int m = crow(r, hi);
            pa0[r] = (m <= mv) ? pa0[r] : -1.0e30f; pa1[r] = (m + 32 <= mv) ? pa1[r] : -1.0e30f; pb0[r] = (m + 64 <= mv) ? pb0[r] : -1.0e30f; pb1[r] = (m + 96 <= mv) ? pb1[r] : -1.0e30f;
            mx = fmaxf(fmaxf(mx, fmaxf(pa0[r], pa1[r])), fmaxf(pb0[r], pb1[r])); }
        mx = half_max(mx);
        float sum = 0.f;
#pragma unroll
        for (int r = 0; r < 16; ++r) { const int m = crow(r, hi);
            pa0[r] = (m <= mv) ? __builtin_amdgcn_exp2f(pa0[r] - mx) : 0.f; pa1[r] = (m + 32 <= mv) ? __builtin_amdgcn_exp2f(pa1[r] - mx) : 0.f;
            pb0[r] = (m + 64 <= mv) ? __builtin_amdgcn_exp2f(pb0[r] - mx) : 0.f; pb1[r] = (m + 96 <= mv) ? __builtin_amdgcn_exp2f(pb1[r] - mx) : 0.f;
            sum += (pa0[r] + pa1[r]) + (pb0[r] + pb1[r]); }
        sum = half_sum(sum);
        const float inv = sum > 0.f ? 1.0f / sum : 0.f;
#pragma unroll
        for (int r = 0; r < 16; ++r) { pa0[r] *= inv; pa1[r] *= inv; pb0[r] *= inv; pb1[r] *= inv; }
        LAS float* Gs = (LAS float*)(L + NA_GS); LAS float* Ls = (LAS float*)(L + NA_LS);
#pragma unroll
        for (int rg = 0; rg < 4; ++rg) {
            float gv[4], lv[4];
            gv[0] = (pa0[4 * rg] + pa0[4 * rg + 1]) + (pa0[4 * rg + 2] + pa0[4 * rg + 3]); lv[0] = pa0[4 * rg + 3];
            gv[1] = (pa1[4 * rg] + pa1[4 * rg + 1]) + (pa1[4 * rg + 2] + pa1[4 * rg + 3]); lv[1] = pa1[4 * rg + 3];
            gv[2] = (pb0[4 * rg] + pb0[4 * rg + 1]) + (pb0[4 * rg + 2] + pb0[4 * rg + 3]); lv[2] = pb0[4 * rg + 3];
            gv[3] = (pb1[4 * rg] + pb1[4 * rg + 1]) + (pb1[4 * rg + 2] + pb1[4 * rg + 3]); lv[3] = pb1[4 * rg + 3];
#pragma unroll
            for (int k = 0; k < 4; ++k) { gv[k] += DPPF(0.f, gv[k], 0xB1, 0xF); gv[k] += DPPF(0.f, gv[k], 0x4E, 0xF); lv[k] += DPPF(0.f, lv[k], 0xB1, 0xF); lv[k] += DPPF(0.f, lv[k], 0x4E, 0xF);
                if (hr == 0) { const int np = 8 * k + 2 * rg + hi; Gs[(8 * w + tl) * 32 + np] = gv[k]; Ls[(8 * w + tl) * 32 + np] = lv[k]; } }
        }
#pragma unroll
        for (int r = 0; r < 16; ++r) { pa0[r] *= g0; pa1[r] *= g0; pb0[r] *= g0; pb1[r] *= g0; }
        pv_tile(ot, L + NA_V, pa0, pa1, lane);
        if (two) pv_tile(ot, L + NA_V + 8192, pb0, pb1, lane);
#pragma unroll
        for (int d0 = 0; d0 < 2; ++d0)
#pragma unroll
            for (int r = 0; r < 16; ++r) stash[(d0 * 16 + r) * 64 + lane] = ot[d0][r];
    }
    __syncthreads();
    {
        const int st = lane >> 3, sj = lane & 7, stok = 8 * w + st;
        const LAS float* Gs = (const LAS float*)(L + NA_GS) + stok * 32; const LAS float* Ls = (const LAS float*)(L + NA_LS) + stok * 32;
        const int cur = qt;
        float sc[4];
#pragma unroll
        for (int k = 0; k < 4; ++k) { const int n = 4 * sj + k; const float imp = Gs[n] + (n > 0 ? Ls[n - 1] : 0.f); const bool forced = (n == 0) || (n == cur) || (n == cur - 1);
            sc[k] = (n <= cur) ? (imp + (forced ? 1.0e4f : 0.f)) : -1.0e30f; }
        unsigned mask = 0u;
#pragma unroll
        for (int rnd = 0; rnd < 8; ++rnd) {
            float best = sc[0]; int bi = 4 * sj;
#pragma unroll
            for (int k = 1; k < 4; ++k) { const bool take = sc[k] > best; best = take ? sc[k] : best; bi = take ? 4 * sj + k : bi; }
#pragma unroll
            for (int off = 1; off < 8; off <<= 1) { const float ob = __shfl_xor(best, off); const int oi = __shfl_xor(bi, off); const bool take = (ob > best) || (ob == best && oi < bi); best = take ? ob : best; bi = take ? oi : bi; }
            if (bi <= cur) mask |= 1u << bi;
#pragma unroll
            for (int k = 0; k < 4; ++k) sc[k] = (4 * sj + k == bi) ? -3.0e38f : sc[k];
        }
        if (sj == 0) ((LAS unsigned*)(L + NA_MASK))[stok] = mask;
    }
    __syncthreads();
    const unsigned mymask = ((const LAS unsigned*)(L + NA_MASK))[8 * w + tl];
    unsigned ormask = 0u;
    { const LAS unsigned* mk = (const LAS unsigned*)(L + NA_MASK);
#pragma unroll 8
      for (int i = 0; i < 64; ++i) ormask |= mk[i]; }
    ormask = (unsigned)__builtin_amdgcn_readfirstlane((int)ormask);
    const int n_lo = qt >= 8 ? qt - 8 : 0;
    const int nsel = __builtin_popcount(ormask), NS = nsel + (qt - n_lo + 1);
    LAS unsigned short* sched = (LAS unsigned short*)(L + NA_SCHED);
    if (tid == 0) { unsigned rem = ormask; int c = 0; while (rem) { sched[c++] = (unsigned short)__builtin_ctz(rem); rem &= rem - 1; } for (int n = n_lo; n <= qt; ++n) sched[c++] = (unsigned short)(n | 256); sched[c] = 0; sched[c + 1] = 0; sched[c + 2] = 0; sched[c + 3] = 0; }
    __syncthreads();
    u32x4 kr0, vr0, kr1, vr1, kr2, vr2;
#define NSA_LOAD(KR, VR, idx) do { const unsigned e_ = sched[idx]; const int n_ = (int)(e_ & 255u); const bool win_ = (e_ & 256u) != 0u; \
        kv_load(KR, VR, win_ ? Kwb : Ksb, win_ ? Vwb : Vsb, 2560, 64 * n_, w, lane); } while (0)
    NSA_LOAD(kreg, vreg, 0);
    if (1 < NS) NSA_LOAD(kr0, vr0, 1);
    if (2 < NS) NSA_LOAD(kr1, vr1, 2);
    if (3 < NS) NSA_LOAD(kr2, vr2, 3);
    kv_store(L + NA_K, L + NA_V, kreg, vreg, w, lane);
    __syncthreads();
    f32x16 o[2]; o[0] = (f32x16){}; o[1] = (f32x16){}; float m_run = 0.f, l_run = 0.f; bool hasref = false;
    int slot = 0;
#define NSA_STEP(KR, VR) { \
        if (i + 1 < NS) kv_store(L + NA_K + 8192 * (slot ^ 1), L + NA_V + 8192 * (slot ^ 1), KR, VR, w, lane); \
        if (i + 4 < NS) NSA_LOAD(KR, VR, i + 4); \
        const unsigned e = sched[i]; const int n = (int)(e & 255u); const bool win = (e & 256u) != 0u; \
        if (i == nsel) {                                             \
            if (hi == 0) wsf[r32] = g1 / l_run; \
            LDS_WAIT(); \
            _Pragma("unroll") for (int d0 = 0; d0 < 2; ++d0) _Pragma("unroll") for (int r = 0; r < 16; ++r) { stash[(d0 * 16 + r) * 64 + lane] += o[d0][r] * wsf[crow(r, hi)]; o[d0][r] = 0.f; } \
            LDS_WAIT(); \
            m_run = 0.f; l_run = 0.f; hasref = false; \
        } \
        const bool rowok = win ? true : (((mymask >> n) & 1u) != 0u); \
        const int kbase = 64 * n + 4 * hi, lowlim = win ? tok - 512 : -1; \
        auto ok = [&](int r, int blk) { const int kvp = kbase + (r & 3) + 8 * (r >> 2) + 32 * blk; return (kvp <= tok) && (kvp > lowlim); }; \
        const bool need_mask = (n == qt) || (win && n == qt - 8); \
        if (MODE != 2) { \
        if (need_mask) flash3<true, MODE == 3>(o, m_run, l_run, hasref, L + NA_K + 8192 * slot, L + NA_V + 8192 * slot, qr, rowok, ok, wsf, lane, r32, hi); \
        else flash3<false, MODE == 3>(o, m_run, l_run, hasref, L + NA_K + 8192 * slot, L + NA_V + 8192 * slot, qr, rowok, ok, wsf, lane, r32, hi); \
        } else { l_run += 1.0f; } \
        __syncthreads(); \
        slot ^= 1; ++i; }
    for (int i = 0; i < NS;) {
        NSA_STEP(kr0, vr0)
        if (i >= NS) break;
        NSA_STEP(kr1, vr1)
        if (i >= NS) break;
        NSA_STEP(kr2, vr2)
    }
#undef NSA_STEP
#undef NSA_LOAD
    if (hi == 0) wsf[r32] = g2 / l_run;
    LDS_WAIT();
#pragma unroll
    for (int d0 = 0; d0 < 2; ++d0)
#pragma unroll
        for (int r = 0; r < 16; ++r) { const int row = crow(r, hi); const size_t orow = (size_t)(b * SEQ + t0 + 8 * w + (row >> 2));
            const float val = stash[(d0 * 16 + r) * 64 + lane] + o[d0][r] * wsf[row];
            cat[orow * 1024 + (g * 4 + (row & 3)) * 64 + 32 * d0 + r32] = (bf16_t)(cvtpk(val, 0.f) & 0xffffu); }
    LDS_WAIT();
}

#ifndef PROBE_PHASE
#define PROBE_PHASE -1
#endif
#define REPS(k) ((PROBE_PHASE == (k)) ? 3 : 1)
constexpr int N_PHASES = 19;

__global__ void __launch_bounds__(NTHR, 2) mega_fwd(Args args) {
    extern __shared__ __attribute__((aligned(16))) unsigned char lds_raw[];
    Frame F;
    F.lds = (LAS unsigned char*)lds_raw;
    F.LC = (volatile LAS unsigned*)(F.lds + LDSCTL_OFF);
    F.tid = threadIdx.x; F.lane = F.tid & 63; F.wave = __builtin_amdgcn_readfirstlane(F.tid >> 6);
    F.G = gridDim.x; { const int bx = blockIdx.x; F.vcu = (F.G % 8 == 0) ? (bx % 8) * (F.G / 8) + bx / 8 : bx; }
    F.ctl = (unsigned*)(args.ws + WS_CTL);
    for (int u = F.tid; u < 256; u += NTHR) F.LC[u] = 0u;
    __syncthreads();
    XcdBarrier bar = xcd_barrier_post(F.ctl + CW_BAR, F.LC + LC_BAR);
    const int lo = args.ph_lo, hi = args.ph_hi;
#define IN(k) (lo <= (k) && (k) < hi)
#define SEAM(k) do { if (IN(k) && IN((k) + 1)) xcd_barrier(bar); } while (0)
    unsigned char* ws = args.ws;

#define PH(k, ...) do { if (IN(k)) { { const int rep_ = 0; (void)rep_; __VA_ARGS__; } \
        if (PROBE_PHASE == (k)) { xcd_barrier(bar); { const int rep_ = 1; (void)rep_; __VA_ARGS__; } xcd_barrier(bar); { const int rep_ = 2; (void)rep_; __VA_ARGS__; } } } SEAM(k); } while (0)
    PH(0, { ssm_pow_tables(F, args); nsa_small_tables(F, args); p0_prologue(F, args); });
    PH(1, {
        ssm_frag_tables(F, args); nsa_cbias_final(F, args);
        pg8::Gemm g{(const bf16_t*)(ws + WS_H), (const bf16_t*)(ws + WS_W0T), 1024}; pg8::StaticOrder S; S.init(NTOK, 2048, F.G, (int)blockIdx.x);
        pg8::EpiBf16 E{(bf16_t*)(ws + WS_ARENA), 2048};
        pg8::gemm_phase(F.lds, g, S, E); });
    PH(2, { l0_mixer_phase(F, args, 2 * rep_); });
    PH(3, {
        pg8::Gemm g{(const bf16_t*)(ws + WS_H), (const bf16_t*)(ws + WS_WGLUT), 512}; pg8::StaticOrder S; S.init(NTOK, 512, F.G, (int)blockIdx.x);
        pg8::EpiGlu E{(const bf16_t*)(ws + WS_H), 512, (bf16_t*)(ws + WS_CAT) + 512, 1024};
        pg8::gemm_phase(F.lds, g, S, E); });
    PH(4, {
        pg8::Gemm g{(const bf16_t*)(ws + WS_CAT), (const bf16_t*)(ws + WS_WOUT0T), 1024}; pg8::StaticOrder S; S.init(NTOK, 1024, F.G, (int)blockIdx.x);
        pg8::EpiResid E{args.in[I_X], args.out, 1024};
        pg8::gemm_phase(F.lds, g, S, E); });
#define MOE_BLOCK(layer, pb) do { \
        PH(pb, { ln_a_phase(F, args, layer); }); \
        PH(pb + 2, { \
            moe_prefix(F, layer); \
            pg8::Gemm g{(const bf16_t*)(ws + WS_CAT), (const bf16_t*)(ws + WS_WEXP + layer * WEXP_LAYER), 1024}; \
            pg8::MoeGatherOrder S{(const LAS int*)(F.LC + LC_TSTART), (const LAS int*)(F.LC + LC_CNTS), (const int*)(ws + WS_LIST), F.G, (int)blockIdx.x}; \
            pg8::EpiSwiGLU E{(bf16_t*)(ws + WS_H), DE}; \
            pg8::gemm_phase(F.lds, g, S, E); }); \
        PH(pb + 3, { \
            moe_prefix(F, layer); \
            pg8::Gemm g{(const bf16_t*)(ws + WS_H), (const bf16_t*)(ws + WS_WEXP + layer * WEXP_LAYER + WEXP_W2), 512}; \
            pg8::MoeOrder S{(const LAS int*)(F.LC + LC_TSTART), F.G, (int)blockIdx.x}; \
            pg8::EpiBf16 E{(bf16_t*)(ws + WS_ARENA), DM}; \
            pg8::gemm_phase(F.lds, g, S, E); }); \
        PH(pb + 4, { ln_b_phase(F, args, layer, layer == 0); }); \
    } while (0)
    MOE_BLOCK(0, 5);
    PH(10, {
        pg8::Gemm g{(const bf16_t*)(ws + WS_H), (const bf16_t*)(ws + WS_WIN1T), 1024}; pg8::StaticOrder S; S.init(NTOK, 2816, F.G, (int)blockIdx.x);
        pg8::EpiRope E{(bf16_t*)(ws + WS_ARENA), (float*)(ws + WS_GATE), (const float*)(ws + WS_ROPE), (const float*)(ws + WS_ROPE) + 2048 * 32};
        pg8::gemm_phase(F.lds, g, S, E); });
    PH(11, { for (int u = blockIdx.x; u < 128; u += F.G) { __syncthreads(); cmp_unit(F, args, u >> 6, u & 63); } });
    if (PROBE_PHASE >= 200 && PROBE_PHASE < 204 && IN(12)) { for (int rp = 0; rp < 2; ++rp) { for (;;) { const int t = q_next(F, 3 + 2 * rp); if (t >= 1024) break; nsa_unit<(PROBE_PHASE >= 200 && PROBE_PHASE < 204) ? PROBE_PHASE - 200 + (PROBE_PHASE == 200) : 1>(F, args, (t & 31) >> 2, t & 3, 31 - (t >> 5)); } xcd_barrier(bar); } }
    PH(12, { for (;;) { const int t = q_next(F, 1 + 2 * rep_); if (t >= 1024) break; nsa_unit<0>(F, args, (t & 31) >> 2, t & 3, 31 - (t >> 5)); } });
    PH(13, {
        pg8::Gemm g{(const bf16_t*)(ws + WS_CAT), (const bf16_t*)(ws + WS_WOUT1T), 1024}; pg8::StaticOrder S; S.init(NTOK, 1024, F.G, (int)blockIdx.x);
        pg8::EpiResidBf E{(const bf16_t*)(ws + WS_H), args.out, 1024};
        pg8::gemm_phase(F.lds, g, S, E); });
    MOE_BLOCK(1, 14);
#undef IN
#undef SEAM
}

extern "C" void kernel_launch(void* const* d_in, const int* in_sizes, int n_in, void* d_out, int out_size, void* d_ws, size_t ws_size, hipStream_t stream) {
    static int grid = 0;
    if (grid == 0) {
        if (n_in != 36 || out_size != NTOK * DM || ws_size < WS_END) { fprintf(stderr, "kernel_launch: unexpected shapes (n_in %d out %d ws %zu)\n", n_in, out_size, ws_size); grid = -1; return; }
        int dev = 0, cus = 0, per_cu = 0;
        if (hipGetDevice(&dev) != hipSuccess || hipDeviceGetAttribute(&cus, hipDeviceAttributeMultiprocessorCount, dev) != hipSuccess) { grid = -1; return; }
        if (hipFuncSetAttribute((const void*)mega_fwd, hipFuncAttributeMaxDynamicSharedMemorySize, LDS_BYTES) != hipSuccess) { fprintf(stderr, "kernel_launch: hipFuncSetAttribute failed\n"); grid = -1; return; }
        if (hipOccupancyMaxActiveBlocksPerMultiprocessor(&per_cu, (const void*)mega_fwd, NTHR, LDS_BYTES) != hipSuccess || per_cu < 1) { fprintf(stderr, "kernel_launch: occupancy query says %d\n", per_cu); }
        (void)hipGetLastError();
        grid = cus;
    }
    if (grid < 0) return;
    (void)hipMemsetAsync((char*)d_ws + WS_CTL, 0, CTL_ZERO_BYTES, stream);
    Args a{};
    for (int i = 0; i < 36; ++i) a.in[i] = (const float*)d_in[i];
    a.out = (float*)d_out; a.ws = (unsigned char*)d_ws; a.ph_lo = 0; a.ph_hi = N_PHASES;
    hipLaunchKernelGGL(mega_fwd, dim3(grid), dim3(NTHR), LDS_BYTES, stream, a);
}
```
